# Optimizing an MI355X kernel written in HIP

```python
import jax, jax.numpy as jnp
from jax import lax
import numpy as np

D_MODEL = 1024
BATCH = 4
SEQ = 4096
DEPTH = 2

CHUNK = 64
BRANCH_WIDTH = D_MODEL // 2
N_BRANCHES = 3
SB_HEADS = 8
SB_HEAD_DIM = BRANCH_WIDTH // SB_HEADS
SB_BLOCK = 128
SGU_LEN = 128
SGU_GROUPS = 4
SGU_GROUP_DIM = BRANCH_WIDTH // SGU_GROUPS
CONV_WIDTH = 3
MEM_TOKENS = 256
XA_HEADS = 4
XA_HEAD_DIM = D_MODEL // XA_HEADS
FFN_HIDDEN = ((8 * D_MODEL // 3 + 255) // 256) * 256

W_QKV = 3 * BRANCH_WIDTH
W_SGU = 2 * BRANCH_WIDTH
W_CONV = 3 * BRANCH_WIDTH
W_GATES = N_BRANCHES * D_MODEL
IN_COLS = W_QKV + W_SGU + W_CONV + W_GATES
SPLIT_IDX = [BRANCH_WIDTH, 2 * BRANCH_WIDTH, W_QKV,
             W_QKV + W_SGU,
             W_QKV + W_SGU + BRANCH_WIDTH, W_QKV + W_SGU + 2 * BRANCH_WIDTH,
             W_QKV + W_SGU + W_CONV]

kernel_name = "hybrid_stickbreak_gmlp_shortconv_block"


def rms_norm(x, g, eps=1e-6):
    xf = x.astype(jnp.float32)
    y = xf * lax.rsqrt(jnp.mean(xf * xf, axis=-1, keepdims=True) + eps)
    return (y * g.astype(jnp.float32)).astype(x.dtype)


def layer_norm(x, g, b, eps=1e-5):
    xf = x.astype(jnp.float32)
    mu = jnp.mean(xf, axis=-1, keepdims=True)
    xc = xf - mu
    y = xc * lax.rsqrt(jnp.mean(xc * xc, axis=-1, keepdims=True) + eps)
    return (y * g.astype(jnp.float32) + b.astype(jnp.float32)).astype(x.dtype)


def stick_breaking_attention(q, k, v):
    seq = q.shape[2]
    scale = SB_HEAD_DIM ** -0.5
    outs = []
    for i in range(seq // SB_BLOCK):
        q0 = i * SB_BLOCK
        kend = q0 + SB_BLOCK
        qb = q[:, :, q0:kend].astype(jnp.float32)
        kb = k[:, :, :kend].astype(jnp.float32)
        z = jnp.einsum("bhqd,bhkd->bhqk", qb, kb) * scale
        t_pos = q0 + jnp.arange(SB_BLOCK)[:, None]
        s_pos = jnp.arange(kend)[None, :]
        valid = s_pos < t_pos
        log_1m = jnp.where(valid, jax.nn.log_sigmoid(-z), 0.0)
        log_a = jax.nn.log_sigmoid(z) + lax.cumsum(log_1m, axis=3, reverse=True) - log_1m
        a = jnp.where(valid, jnp.exp(log_a), 0.0)
        outs.append(jnp.einsum("bhqk,bhkd->bhqd", a.astype(v.dtype), v[:, :, :kend]))
    return jnp.concatenate(outs, axis=2)


def spatial_gating(z, ln_g, ln_b, w_s, b_s):
    bsz, seq, _ = z.shape
    u, v = jnp.split(z, 2, axis=-1)
    v = layer_norm(v, ln_g, ln_b)
    v = v.reshape(bsz, seq // SGU_LEN, SGU_LEN, SGU_GROUPS, SGU_GROUP_DIM)
    pos = jnp.arange(SGU_LEN)
    allowed = (pos[:, None] // CHUNK) >= (pos[None, :] // CHUNK)
    w = jnp.where(allowed[None], w_s, 0.0).astype(v.dtype)
    vm = jnp.einsum("gts,bnsgc->bntgc", w, v) + b_s.T[None, None, :, :, None].astype(v.dtype)
    return u * vm.reshape(bsz, seq, BRANCH_WIDTH)


def gated_short_conv(gate_b, gate_c, xin, conv_w):
    y = gate_c * xin
    ch = y.shape[-1]
    conv = lax.conv_general_dilated(
        y, conv_w[:, None, :].astype(y.dtype), window_strides=(1,),
        padding=((CONV_WIDTH - 1, 0),), dimension_numbers=("NWC", "WIO", "NWC"),
        feature_group_count=ch)
    return gate_b * conv


def hybrid_mixer(h, w_in, sgu_ln_g, sgu_ln_b, w_spatial, b_spatial, conv_w, w_branch, w_out):
    bsz, seq, _ = h.shape
    p = h @ w_in
    q, k, v, z, cb, cc, cx, gates = jnp.split(p, SPLIT_IDX, axis=-1)

    def heads(t):
        return t.reshape(bsz, seq, SB_HEADS, SB_HEAD_DIM).transpose(0, 2, 1, 3)

    ya = stick_breaking_attention(heads(q), heads(k), heads(v))
    ya = ya.transpose(0, 2, 1, 3).reshape(bsz, seq, BRANCH_WIDTH)
    yb = spatial_gating(jax.nn.gelu(z, approximate=False), sgu_ln_g, sgu_ln_b, w_spatial, b_spatial)
    yc = gated_short_conv(cb, cc, cx, conv_w)

    br = jnp.stack([ya, yb, yc], axis=2)
    br_d = jnp.einsum("bsnc,ncd->bsnd", br, w_branch)
    g = jax.nn.sigmoid(gates.reshape(bsz, seq, N_BRANCHES, D_MODEL))
    merged = jnp.sum(g * br_d, axis=2)
    return merged @ w_out


def memory_cross_attention(h, mem, mem_g, wq, wk, wv, wo):
    bsz, seq, _ = h.shape
    m = rms_norm(mem, mem_g)
    q = (h @ wq).reshape(bsz, seq, XA_HEADS, XA_HEAD_DIM)
    k = (m @ wk).reshape(bsz, MEM_TOKENS, XA_HEADS, XA_HEAD_DIM)
    v = (m @ wv).reshape(bsz, MEM_TOKENS, XA_HEADS, XA_HEAD_DIM)
    s = jnp.einsum("bqhd,bkhd->bhqk", q.astype(jnp.float32), k.astype(jnp.float32)) * (XA_HEAD_DIM ** -0.5)
    pr = jax.nn.softmax(s, axis=-1)
    o = jnp.einsum("bhqk,bkhd->bqhd", pr.astype(v.dtype), v).reshape(bsz, seq, D_MODEL)
    return o @ wo


def swiglu(h, w_gate, w_up, w_down):
    return (jax.nn.silu(h @ w_gate) * (h @ w_up)) @ w_down


def setup_inputs(seed: int = 0) -> dict:
    key = jax.random.key(seed)
    ks = jax.random.split(key, 24)
    f32 = jnp.float32

    def nrm(k, shape, fan_in):
        return jax.random.normal(k, shape, f32) * (fan_in ** -0.5)

    def gain(k, shape):
        return 1.0 + 0.02 * jax.random.normal(k, shape, f32)

    L, D, W = DEPTH, D_MODEL, BRANCH_WIDTH
    return {
        "x": jax.random.normal(ks[0], (BATCH, SEQ, D), f32),
        "mem": jax.random.normal(ks[1], (BATCH, MEM_TOKENS, D), f32),
        "norm_mix_g": gain(ks[2], (L, D)),
        "w_in": nrm(ks[3], (L, D, IN_COLS), D),
        "sgu_ln_g": gain(ks[4], (L, W)),
        "sgu_ln_b": 0.02 * jax.random.normal(ks[5], (L, W), f32),
        "w_spatial": nrm(ks[6], (L, SGU_GROUPS, SGU_LEN, SGU_LEN), SGU_LEN),
        "b_spatial": gain(ks[7], (L, SGU_GROUPS, SGU_LEN)),
        "conv_w": nrm(ks[8], (L, CONV_WIDTH, W), CONV_WIDTH),
        "w_branch": nrm(ks[9], (L, N_BRANCHES, W, D), W),
        "w_out": nrm(ks[10], (L, D, D), D),
        "norm_xa_g": gain(ks[11], (L, D)),
        "mem_norm_g": gain(ks[12], (L, D)),
        "w_q_xa": nrm(ks[13], (L, D, D), D),
        "w_k_xa": nrm(ks[14], (L, D, D), D),
        "w_v_xa": nrm(ks[15], (L, D, D), D),
        "w_o_xa": nrm(ks[16], (L, D, D), D),
        "norm_ffn_g": gain(ks[17], (L, D)),
        "w_gate_ffn": nrm(ks[18], (L, D, FFN_HIDDEN), D),
        "w_up_ffn": nrm(ks[19], (L, D, FFN_HIDDEN), D),
        "w_down_ffn": nrm(ks[20], (L, FFN_HIDDEN, D), FFN_HIDDEN),
        "final_g": gain(ks[21], (D,)),
    }


def reference(x, mem, norm_mix_g, w_in, sgu_ln_g, sgu_ln_b, w_spatial, b_spatial, conv_w,
              w_branch, w_out, norm_xa_g, mem_norm_g, w_q_xa, w_k_xa, w_v_xa, w_o_xa,
              norm_ffn_g, w_gate_ffn, w_up_ffn, w_down_ffn, final_g):
    for l in range(DEPTH):
        x = x + hybrid_mixer(rms_norm(x, norm_mix_g[l]), w_in[l], sgu_ln_g[l], sgu_ln_b[l],
                             w_spatial[l], b_spatial[l], conv_w[l], w_branch[l], w_out[l])
        x = x + memory_cross_attention(rms_norm(x, norm_xa_g[l]), mem, mem_norm_g[l],
                                       w_q_xa[l], w_k_xa[l], w_v_xa[l], w_o_xa[l])
        x = x + swiglu(rms_norm(x, norm_ffn_g[l]), w_gate_ffn[l], w_up_ffn[l], w_down_ffn[l])
    return rms_norm(x, final_g)
```

```cpp
#include <hip/hip_runtime.h>
#include <hip/hip_cooperative_groups.h>
#include <cstdio>
#include <cstdint>
namespace cg = cooperative_groups;

#define LAS __attribute__((address_space(3)))
typedef unsigned short bf16_t;
typedef short bf16x8 __attribute__((ext_vector_type(8)));
typedef float f32x4 __attribute__((ext_vector_type(4)));
typedef float f32x2 __attribute__((ext_vector_type(2)));
typedef float f32x16 __attribute__((ext_vector_type(16)));
typedef unsigned u32x4 __attribute__((ext_vector_type(4)));
typedef unsigned u32x2 __attribute__((ext_vector_type(2)));
typedef __bf16 bf16x2n __attribute__((ext_vector_type(2)));

#define DI __device__ __forceinline__
DI unsigned pkbf(float lo, float hi) { f32x2 v = {lo, hi}; bf16x2n b = __builtin_convertvector(v, bf16x2n); return __builtin_bit_cast(unsigned, b); }
DI float bflo(unsigned u) { return __uint_as_float(u << 16); }
DI float bfhi(unsigned u) { return __uint_as_float(u & 0xffff0000u); }
DI int fresh_tid() { int t = threadIdx.x; asm volatile("" : "+v"(t)); return t; }
#define MFMA32(a, b, c) __builtin_amdgcn_mfma_f32_32x32x16_bf16((a), (b), (c), 0, 0, 0)

constexpr int M = 16384, D = 1024, SEQ = 4096, NBATCH = 4, DEPTH = 2;
constexpr int PC = 3072;
constexpr int FF = 2816;
constexpr int INC = 7168;
constexpr float RMS_EPS = 1e-6f, LN_EPS = 1e-5f;
constexpr float LOG2E = 1.4426950408889634f, LN2 = 0.6931471805599453f;
constexpr float SB_EXIT = 110.0f;

constexpr size_t MiB = (size_t)1 << 20;
constexpr size_t WS_WIN = 1 * MiB;
constexpr size_t WS_WB = 15 * MiB;
constexpr size_t WS_WOUT = 18 * MiB, WS_WQ = 20 * MiB, WS_WK = 22 * MiB, WS_WV = 24 * MiB, WS_WOX = 26 * MiB;
constexpr size_t WS_WGU = 28 * MiB;
constexpr size_t WS_WD = 39 * MiB;
constexpr size_t WS_MB = 45 * MiB, WS_MEMK = 47 * MiB, WS_MEMVT = 49 * MiB;
constexpr size_t WS_XB = 51 * MiB;
constexpr size_t WS_P = 83 * MiB;
constexpr size_t WS_T = 179 * MiB;
constexpr size_t WS_X2 = 211 * MiB;
constexpr size_t WS_SSP = 243 * MiB;
constexpr size_t WS_WK1 = 246 * MiB, WS_WV1 = 248 * MiB, WS_MB1 = 250 * MiB, WS_MEMK1 = 252 * MiB, WS_MEMVT1 = 254 * MiB;
constexpr size_t WS_END = 256 * MiB;

namespace pg8 {
constexpr int BM = 256, BK = 64, HALF = 128, HTB = HALF * BK * 2, STAGE_BYTES = 8 * HTB, NXCD = 8, WGM = 8;
DI int lds_byte(int r, int c) { const int st = (r >> 4) * 2 + (c >> 5), rr = r & 15, cc = c & 31, ob = rr * 64 + cc * 2; return st * 1024 + (ob ^ (((ob >> 9) & 1) << 5)); }
DI void stage_rc(int b, int& R, int& C) { const int st = b / 1024, sb = b % 1024, swz = sb ^ (((sb >> 9) & 1) << 5); R = (st >> 1) * 16 + swz / 64; C = (st & 1) * 32 + (swz % 64) / 2; }
DI int perm32(int rho) { const int n = rho >> 4, i = rho & 15; return 8 * (i >> 2) + 4 * n + (i & 3); }

struct Unit { int pm, pn; };
struct Gemm { const bf16_t* A; const bf16_t* Bt; int M, N, K, lda, ldb; };

struct StaticOrder {
    int nM, nN, nwg, G, c;
    DI void init(int M_, int N_, int G_, int c_) { nM = M_ / BM; nN = N_ / BM; nwg = nM * nN; G = G_; c = c_; }
    DI bool next(int i, Unit& u) const {
        const long L = (long)i * G + c; if (L >= nwg) return false;
        int wgid = (int)L; { const int q = nwg / NXCD, r = nwg % NXCD, xcd = wgid % NXCD, off = wgid / NXCD; wgid = (xcd < r ? xcd * (q + 1) : r * (q + 1) + (xcd - r) * q) + off; }
        const int nig = WGM * nN, gid = wgid / nig, fm = gid * WGM, gsz = (nM - fm) < WGM ? (nM - fm) : WGM;
        u.pm = fm + ((wgid % nig) % gsz); u.pn = (wgid % nig) / gsz; return true;
    }
};

DI f32x2 gelu_pk(f32x2 v) {
    const f32x2 av = __builtin_elementwise_abs(v), d = av * 0.2316418882f + 1.0f;
    f32x2 t; t.x = __builtin_amdgcn_rcpf(d.x); t.y = __builtin_amdgcn_rcpf(d.y);
    f32x2 q = t * 0.5307027145f + (-0.7265760135f); q = q * t + 0.7107068705f; q = q * t + (-0.142248368f); q = q * t + 0.127414796f; q = q * t;
    const f32x2 s = (v * v) * (-0.72134752044f);
    f32x2 e; e.x = __builtin_amdgcn_exp2f(s.x); e.y = __builtin_amdgcn_exp2f(s.y);
    const f32x2 m = v * (q * e), r = v - m;
    f32x2 o; o.x = v.x < 0.f ? m.x : r.x; o.y = v.y < 0.f ? m.y : r.y; return o;
}
DI f32x4 gelu4(f32x4 v) { f32x2 a = gelu_pk((f32x2){v[0], v[1]}), b = gelu_pk((f32x2){v[2], v[3]}); return (f32x4){a.x, a.y, b.x, b.y}; }
DI float sigmoidf_(float x) { return __builtin_amdgcn_rcpf(1.0f + __builtin_amdgcn_exp2f(-x * LOG2E)); }
DI f32x4 sigmoid4(f32x4 v) { return (f32x4){sigmoidf_(v[0]), sigmoidf_(v[1]), sigmoidf_(v[2]), sigmoidf_(v[3])}; }

DI float row_rs(const float* ssp, int row, int fq) {
    const f32x4 v = *(const f32x4*)(ssp + (size_t)row * 16 + fq * 4);
    float s = (v[0] + v[1]) + (v[2] + v[3]);
    s += __shfl_xor(s, 16); s += __shfl_xor(s, 32);
    return 1.0f / sqrtf(s * (1.0f / D) + RMS_EPS);
}

DI void row_rs8(const float* ssp, int row0, int fq, float (&rs)[2][4]) {
    f32x4 v[2][4];
#pragma unroll
    for (int ai = 0; ai < 2; ++ai)
#pragma unroll
        for (int m = 0; m < 4; ++m) v[ai][m] = *(const f32x4*)(ssp + (size_t)(row0 + ai * HALF + m * 16) * 16 + fq * 4);
    asm volatile("" ::: "memory");
#pragma unroll
    for (int ai = 0; ai < 2; ++ai)
#pragma unroll
        for (int m = 0; m < 4; ++m) { float s = (v[ai][m][0] + v[ai][m][1]) + (v[ai][m][2] + v[ai][m][3]); s += __shfl_xor(s, 16); s += __shfl_xor(s, 32); rs[ai][m] = 1.0f / sqrtf(s * (1.0f / D) + RMS_EPS); }
}

DI void row_rs8_lds(const LAS float* tab, int wr, int fr, float (&rs)[2][4]) {
#pragma unroll
    for (int ai = 0; ai < 2; ++ai)
#pragma unroll
        for (int m = 0; m < 4; ++m) rs[ai][m] = tab[ai * HALF + wr * 64 + m * 16 + fr];
}

enum { E_INPROJ = 0, E_TRANS = 1, E_GATE = 2, E_BR0 = 3, E_BRN = 4, E_RESID = 5, E_ROWSCALE = 6, E_SWIGLU = 7 };
struct EpiArgs {
    bf16_t* O; int ldc;
    const float* ssp;
    float cscale;
    const float* xsrc; float* xdst; bf16_t* xb; float* sspo;
    const bf16_t* G;
    const LAS float* rstab;
};
template <int MODE> struct Epi {
    static constexpr bool PERM = true;
    EpiArgs a;
    DI void store8(bf16_t* p, f32x4 v0, f32x4 v1) const { u32x4 w; w.x = pkbf(v0[0], v0[1]); w.y = pkbf(v0[2], v0[3]); w.z = pkbf(v1[0], v1[1]); w.w = pkbf(v1[2], v1[3]); *(u32x4*)p = w; }
    DI void operator()(const f32x4 (&acc)[2][2][4][2], const Unit& u, int wr, int wc, int fr, int fq) const {
        const int row0 = u.pm * BM + wr * 64 + fr, col0 = u.pn * BM + wc * 32 + 8 * fq;
        if constexpr (MODE == E_TRANS) {
            float rsc[2][8];
            if (a.rstab) {
#pragma unroll
                for (int bj = 0; bj < 2; ++bj) { const f32x4 t0 = *(const LAS f32x4*)(a.rstab + bj * HALF + wc * 32 + 8 * fq), t1 = *(const LAS f32x4*)(a.rstab + bj * HALF + wc * 32 + 8 * fq + 4);
                    rsc[bj][0] = t0[0]; rsc[bj][1] = t0[1]; rsc[bj][2] = t0[2]; rsc[bj][3] = t0[3]; rsc[bj][4] = t1[0]; rsc[bj][5] = t1[1]; rsc[bj][6] = t1[2]; rsc[bj][7] = t1[3]; }
            } else if (a.ssp) {
                const int lane = fq * 16 + fr, tok = u.pn * BM + (lane >> 5) * HALF + wc * 32 + (lane & 31);
                const f32x4* sp = (const f32x4*)(a.ssp + (size_t)tok * 16);
                const f32x4 s0 = sp[0], s1 = sp[1], s2 = sp[2], s3 = sp[3];
                const float s = ((s0[0] + s0[1]) + (s0[2] + s0[3])) + ((s1[0] + s1[1]) + (s1[2] + s1[3])) + ((s2[0] + s2[1]) + (s2[2] + s2[3])) + ((s3[0] + s3[1]) + (s3[2] + s3[3]));
                const float rs = 1.0f / sqrtf(s * (1.0f / D) + RMS_EPS);
#pragma unroll
                for (int bj = 0; bj < 2; ++bj)
#pragma unroll
                    for (int e = 0; e < 8; ++e) rsc[bj][e] = __shfl(rs, bj * 32 + 8 * fq + e);
            } else {
#pragma unroll
                for (int bj = 0; bj < 2; ++bj)
#pragma unroll
                    for (int e = 0; e < 8; ++e) rsc[bj][e] = 1.0f;
            }
            const bool act = a.ssp != nullptr && u.pm >= 2;
#pragma unroll
            for (int ai = 0; ai < 2; ++ai)
#pragma unroll
                for (int m = 0; m < 4; ++m) { bf16_t* rowp = a.O + (size_t)(row0 + ai * HALF + m * 16) * a.ldc + col0;
#pragma unroll
                    for (int bj = 0; bj < 2; ++bj) {
                        f32x4 v0 = acc[ai][bj][m][0], v1 = acc[ai][bj][m][1];
                        v0 = v0 * (f32x4){rsc[bj][0], rsc[bj][1], rsc[bj][2], rsc[bj][3]}; v1 = v1 * (f32x4){rsc[bj][4], rsc[bj][5], rsc[bj][6], rsc[bj][7]};
                        if (act) { v0 = gelu4(v0); v1 = gelu4(v1); }
                        store8(rowp + bj * HALF, v0, v1); } }
        } else if constexpr (MODE == E_RESID) {
#pragma unroll
            for (int ai = 0; ai < 2; ++ai) {
                u32x4 xw[4][2];
#pragma unroll
                for (int m = 0; m < 4; ++m)
#pragma unroll
                    for (int bj = 0; bj < 2; ++bj) xw[m][bj] = *(const u32x4*)(a.xb + (size_t)(row0 + ai * HALF + m * 16) * D + col0 + bj * HALF);
                asm volatile("" ::: "memory");
#pragma unroll
                for (int m = 0; m < 4; ++m) { const int row = row0 + ai * HALF + m * 16; const size_t off = (size_t)row * D + col0; float ss = 0.f;
#pragma unroll
                    for (int bj = 0; bj < 2; ++bj) { const u32x4 w = xw[m][bj];
                        const f32x4 v0 = (f32x4){bflo(w.x), bfhi(w.x), bflo(w.y), bfhi(w.y)} + acc[ai][bj][m][0], v1 = (f32x4){bflo(w.z), bfhi(w.z), bflo(w.w), bfhi(w.w)} + acc[ai][bj][m][1];
                        store8(a.xb + off + bj * HALF, v0, v1);
                        ss += (v0[0] * v0[0] + v0[1] * v0[1]) + (v0[2] * v0[2] + v0[3] * v0[3]) + (v1[0] * v1[0] + v1[1] * v1[1]) + (v1[2] * v1[2] + v1[3] * v1[3]); }
                    ss += __shfl_xor(ss, 16); ss += __shfl_xor(ss, 32);
                    if (fq == 0) a.sspo[(size_t)row * 16 + u.pn * 4 + wc] = ss; }
            }
        } else if constexpr (MODE == E_SWIGLU) {
            const int ocol = u.pn * HALF + wc * 32 + 8 * fq;
            float rs8[2][4]; if (a.rstab) row_rs8_lds(a.rstab, wr, fr, rs8); else row_rs8(a.ssp, row0, fq, rs8);
#pragma unroll
            for (int ai = 0; ai < 2; ++ai)
#pragma unroll
                for (int m = 0; m < 4; ++m) { const int row = row0 + ai * HALF + m * 16; const float rs = rs8[ai][m];
                    const f32x4 g0 = acc[ai][0][m][0] * rs, g1 = acc[ai][0][m][1] * rs, u0 = acc[ai][1][m][0] * rs, u1 = acc[ai][1][m][1] * rs;
                    store8(a.O + (size_t)row * a.ldc + ocol, g0 * sigmoid4(g0) * u0, g1 * sigmoid4(g1) * u1); }
        } else {
            float sc = a.cscale; bool gelu = false;
            if constexpr (MODE == E_INPROJ) { sc = (u.pn < 2) ? 0.125f : 1.0f; gelu = (u.pn == 4 || u.pn == 5); }
            if constexpr (MODE == E_INPROJ || MODE == E_GATE || MODE == E_ROWSCALE) {
                float rs8[2][4];
                if (a.rstab) row_rs8_lds(a.rstab, wr, fr, rs8); else if (a.ssp) row_rs8(a.ssp, row0, fq, rs8); else {
#pragma unroll
                    for (int ai = 0; ai < 2; ++ai)
#pragma unroll
                        for (int m = 0; m < 4; ++m) rs8[ai][m] = 1.0f; }
#pragma unroll
                for (int ai = 0; ai < 2; ++ai)
#pragma unroll
                    for (int m = 0; m < 4; ++m) { const int row = row0 + ai * HALF + m * 16; const float rs = sc * rs8[ai][m];
#pragma unroll
                        for (int bj = 0; bj < 2; ++bj) { const size_t off = (size_t)row * a.ldc + col0 + bj * HALF;
                            f32x4 v0 = acc[ai][bj][m][0] * rs, v1 = acc[ai][bj][m][1] * rs;
                            if constexpr (MODE == E_INPROJ) { if (gelu) { v0 = gelu4(v0); v1 = gelu4(v1); } }
                            else if constexpr (MODE == E_GATE) { v0 = sigmoid4(v0); v1 = sigmoid4(v1); }
                            store8(a.O + off, v0, v1); } }
            } else {
#pragma unroll
                for (int ai = 0; ai < 2; ++ai) {
                    u32x4 gw[4][2], pw[4][2];
#pragma unroll
                    for (int m = 0; m < 4; ++m)
#pragma unroll
                        for (int bj = 0; bj < 2; ++bj) { const size_t off = (size_t)(row0 + ai * HALF + m * 16) * a.ldc + col0 + bj * HALF;
                            gw[m][bj] = *(const u32x4*)(a.G + off); if constexpr (MODE == E_BRN) pw[m][bj] = *(const u32x4*)(a.O + off); }
                    asm volatile("" ::: "memory");
#pragma unroll
                    for (int m = 0; m < 4; ++m)
#pragma unroll
                        for (int bj = 0; bj < 2; ++bj) { const size_t off = (size_t)(row0 + ai * HALF + m * 16) * a.ldc + col0 + bj * HALF; const u32x4 g = gw[m][bj];
                            f32x4 v0 = acc[ai][bj][m][0] * (f32x4){bflo(g.x), bfhi(g.x), bflo(g.y), bfhi(g.y)}, v1 = acc[ai][bj][m][1] * (f32x4){bflo(g.z), bfhi(g.z), bflo(g.w), bfhi(g.w)};
                            if constexpr (MODE == E_BRN) { const u32x4 q = pw[m][bj];
                                v0 = v0 + (f32x4){bflo(q.x), bfhi(q.x), bflo(q.y), bfhi(q.y)}; v1 = v1 + (f32x4){bflo(q.z), bfhi(q.z), bflo(q.w), bfhi(q.w)}; }
                            store8(a.O + off, v0, v1); }
                }
            }
        }
    }
};

template <class EpiT>
DI void gemm_phase(LAS unsigned char* lds, const Gemm g, const StaticOrder& S, const EpiT& E) {
    const int tid = fresh_tid(), wid = __builtin_amdgcn_readfirstlane(tid >> 6), lane = tid & 63, wr = wid >> 2, wc = wid & 3, fr = lane & 15, fq = lane >> 4;
    const int nt = g.K / BK;
    unsigned voffA[2], voffB[2];
#pragma unroll
    for (int i = 0; i < 2; ++i) { int R, C; stage_rc(tid * 16 + i * 8192, R, C); const int Rb = EpiT::PERM ? ((R & ~31) + perm32(R & 31)) : R;
        voffA[i] = (unsigned)(R * g.lda + C) * 2u; voffB[i] = (unsigned)(Rb * g.ldb + C) * 2u; }
    const size_t kstep = (size_t)(BK * 2);
    const size_t hstepA = (size_t)HALF * g.lda * 2, hstepB = (size_t)HALF * g.ldb * 2;
    const size_t tstepA = 2 * hstepA, tstepB = 2 * hstepB;
    const unsigned ldsw = (unsigned)wid * 1024u;
    const int aoff = lds_byte(wr * 64 + fr, fq * 8), boff = lds_byte(wc * 32 + fr, fq * 8);
#define PG8_SA(b, h) (((b) * 2 + (h)) * HTB)
#define PG8_SB(b, h) ((4 + (b) * 2 + (h)) * HTB)
#define PG8_STAGE(bufoff, gbase, voff) do { _Pragma("unroll") for (int _i = 0; _i < 2; ++_i) \
        __builtin_amdgcn_global_load_lds((const unsigned*)((const char*)(gbase) + (voff)[_i]), (LAS unsigned*)(lds + (bufoff) + ldsw + _i * 8192), 16, 0, 0); } while (0)
#define PG8_LDA(dst, b, h) do { _Pragma("unroll") for (int m = 0; m < 4; ++m) _Pragma("unroll") for (int k = 0; k < 2; ++k) dst[m][k] = *(const LAS bf16x8*)(lds + PG8_SA(b, h) + aoff + m * 2048 + k * 1024); } while (0)
#define PG8_LDB(dst, b, h) do { _Pragma("unroll") for (int n = 0; n < 2; ++n) _Pragma("unroll") for (int k = 0; k < 2; ++k) dst[n][k] = *(const LAS bf16x8*)(lds + PG8_SB(b, h) + boff + n * 2048 + k * 1024); } while (0)
#define PG8_MMA(ai, bj, At, Bt) do { __builtin_amdgcn_s_setprio(1); _Pragma("unroll") for (int m = 0; m < 4; ++m) _Pragma("unroll") for (int n = 0; n < 2; ++n) _Pragma("unroll") for (int k = 0; k < 2; ++k) \
        acc[ai][bj][m][n] = __builtin_amdgcn_mfma_f32_16x16x32_bf16(Bt[n][k], At[m][k], acc[ai][bj][m][n], 0, 0, 0); __builtin_amdgcn_s_setprio(0); } while (0)
#define PG8_WAIT_V(n) asm volatile("s_waitcnt vmcnt(" #n ")" ::: "memory")
#define PG8_WAIT_L(n) asm volatile("s_waitcnt lgkmcnt(" #n ")" ::: "memory")
#define PG8_BAR __builtin_amdgcn_s_barrier()
#define PG8_SCHED __builtin_amdgcn_sched_barrier(0)
    Unit cur, nxt; int ui = 0;
    if (!S.next(0, cur)) return;
    f32x4 acc[2][2][4][2];
#pragma unroll
    for (int a = 0; a < 2; ++a)
#pragma unroll
        for (int b = 0; b < 2; ++b)
#pragma unroll
            for (int m = 0; m < 4; ++m)
#pragma unroll
                for (int n = 0; n < 2; ++n) acc[a][b][m][n] = (f32x4){0.f, 0.f, 0.f, 0.f};
    bf16x8 At[4][2], B0[2][2], B1[2][2];
    const char* cA = (const char*)g.A + (size_t)cur.pm * tstepA; const char* cB = (const char*)g.Bt + (size_t)cur.pn * tstepB;
    PG8_STAGE(PG8_SB(0, 0), cB, voffB); PG8_STAGE(PG8_SB(0, 1), cB + hstepB, voffB); PG8_STAGE(PG8_SA(0, 0), cA, voffA); PG8_STAGE(PG8_SA(0, 1), cA + hstepA, voffA);
    if (wr == 1) PG8_BAR;
    PG8_WAIT_V(2); PG8_BAR;
    PG8_STAGE(PG8_SB(1, 0), cB + kstep, voffB); PG8_STAGE(PG8_SA(1, 0), cA + kstep, voffA); PG8_STAGE(PG8_SB(1, 1), cB + hstepB + kstep, voffB);
    PG8_WAIT_V(6); PG8_BAR;
    for (;;) {
        const bool has_next = S.next(ui + 1, nxt);
        const char* nA = has_next ? (const char*)g.A + (size_t)nxt.pm * tstepA : cA; const char* nB = has_next ? (const char*)g.Bt + (size_t)nxt.pn * tstepB : cB;
        for (int t = 0; t < nt; t += 2) {
            const bool last = (t == nt - 2);
            const char* a1 = cA + (size_t)(t + 1) * kstep;
            const char* a2 = last ? nA : cA + (size_t)(t + 2) * kstep; const char* b2 = last ? nB : cB + (size_t)(t + 2) * kstep;
            const char* a3 = a2 + kstep; const char* b3 = b2 + kstep;
            PG8_LDB(B0, 0, 0); PG8_LDB(B1, 0, 1); PG8_SCHED; PG8_LDA(At, 0, 0); PG8_STAGE(PG8_SA(1, 1), a1 + hstepA, voffA);
            PG8_WAIT_V(8); PG8_WAIT_L(0); PG8_BAR; PG8_MMA(0, 0, At, B0); PG8_MMA(0, 1, At, B1); PG8_BAR; PG8_SCHED;
            PG8_LDA(At, 0, 1); PG8_STAGE(PG8_SB(0, 0), b2, voffB); PG8_STAGE(PG8_SB(0, 1), b2 + hstepB, voffB); PG8_STAGE(PG8_SA(0, 0), a2, voffA);
            PG8_WAIT_V(8); PG8_WAIT_L(0); PG8_BAR; PG8_MMA(1, 0, At, B0); PG8_MMA(1, 1, At, B1); PG8_BAR; PG8_SCHED;
            PG8_LDB(B0, 1, 0); PG8_LDB(B1, 1, 1); PG8_SCHED; PG8_LDA(At, 1, 0); PG8_STAGE(PG8_SA(0, 1), a2 + hstepA, voffA);
            PG8_WAIT_V(8); PG8_WAIT_L(0); PG8_BAR; PG8_MMA(0, 0, At, B0); PG8_MMA(0, 1, At, B1); PG8_BAR; PG8_SCHED;
            PG8_LDA(At, 1, 1); PG8_STAGE(PG8_SB(1, 0), b3, voffB); PG8_STAGE(PG8_SB(1, 1), b3 + hstepB, voffB); PG8_STAGE(PG8_SA(1, 0), a3, voffA);
            PG8_WAIT_V(8); PG8_WAIT_L(0); PG8_BAR; PG8_MMA(1, 0, At, B0); PG8_MMA(1, 1, At, B1); PG8_BAR; PG8_SCHED;
        }
        if (wr == 0) PG8_BAR;
        E(acc, cur, wr, wc, fr, fq);
        if (!has_next) break;
#pragma unroll
        for (int a = 0; a < 2; ++a)
#pragma unroll
            for (int b = 0; b < 2; ++b)
#pragma unroll
                for (int m = 0; m < 4; ++m)
#pragma unroll
                    for (int n = 0; n < 2; ++n) acc[a][b][m][n] = (f32x4){0.f, 0.f, 0.f, 0.f};
        cur = nxt; cA = nA; cB = nB; ++ui;
        if (wr == 1) PG8_BAR;
    }
    PG8_WAIT_V(0);
    PG8_BAR;

}

struct UnitX { int pm, pn, job, k; };
struct JobP { const bf16_t* A; const bf16_t* Bt; int lda, ldb, nt; };
template <class Prog>
DI void gemm_stream(LAS unsigned char* lds, Prog& P) {
    const int tid = fresh_tid(), wid = __builtin_amdgcn_readfirstlane(tid >> 6), lane = tid & 63, wr = wid >> 2, wc = wid & 3, fr = lane & 15, fq = lane >> 4;
    const size_t kstep = (size_t)(BK * 2);
    const unsigned ldsw = (unsigned)wid * 1024u;
    const int aoff = lds_byte(wr * 64 + fr, fq * 8), boff = lds_byte(wc * 32 + fr, fq * 8);
#define PG8_VOFF(vA, vB, j) do { _Pragma("unroll") for (int _i = 0; _i < 2; ++_i) { int sR_, sC_; stage_rc(tid * 16 + _i * 8192, sR_, sC_); const int sRb_ = (sR_ & ~31) + perm32(sR_ & 31); \
        vA[_i] = (unsigned)(sR_ * (j).lda + sC_) * 2u; vB[_i] = (unsigned)(sRb_ * (j).ldb + sC_) * 2u; } } while (0)
    UnitX cur, nxt;
    if (!P.next(cur)) return;
    JobP jc = P.job(cur.job);
    unsigned voffA[2], voffB[2], voffAn[2], voffBn[2];
    PG8_VOFF(voffA, voffB, jc);
    unsigned hstepA = (unsigned)(HALF * jc.lda * 2), hstepB = (unsigned)(HALF * jc.ldb * 2), hstepAn, hstepBn;
    int nt = jc.nt;
    f32x4 acc[2][2][4][2];
#pragma unroll
    for (int a = 0; a < 2; ++a)
#pragma unroll
        for (int b = 0; b < 2; ++b)
#pragma unroll
            for (int m = 0; m < 4; ++m)
#pragma unroll
                for (int n = 0; n < 2; ++n) acc[a][b][m][n] = (f32x4){0.f, 0.f, 0.f, 0.f};
    bf16x8 At[4][2], B0[2][2], B1[2][2];
    const char* cA = (const char*)jc.A + (size_t)cur.pm * 2 * hstepA; const char* cB = (const char*)jc.Bt + (size_t)cur.pn * 2 * hstepB;
    PG8_STAGE(PG8_SB(0, 0), cB, voffB); PG8_STAGE(PG8_SB(0, 1), cB + hstepB, voffB); PG8_STAGE(PG8_SA(0, 0), cA, voffA); PG8_STAGE(PG8_SA(0, 1), cA + hstepA, voffA);
    if (wr == 1) PG8_BAR;
    PG8_WAIT_V(2); PG8_BAR;
    PG8_STAGE(PG8_SB(1, 0), cB + kstep, voffB); PG8_STAGE(PG8_SA(1, 0), cA + kstep, voffA); PG8_STAGE(PG8_SB(1, 1), cB + hstepB + kstep, voffB);
    PG8_WAIT_V(6); PG8_BAR;
    for (;;) {
        const bool has_next = P.next(nxt);
        const char* nA = cA; const char* nB = cB; int ntn = nt;
        hstepAn = hstepA; hstepBn = hstepB; voffAn[0] = voffA[0]; voffAn[1] = voffA[1]; voffBn[0] = voffB[0]; voffBn[1] = voffB[1];
        if (has_next) { const JobP jn = P.job(nxt.job); PG8_VOFF(voffAn, voffBn, jn); hstepAn = (unsigned)(HALF * jn.lda * 2); hstepBn = (unsigned)(HALF * jn.ldb * 2); ntn = jn.nt;
            nA = (const char*)jn.A + (size_t)nxt.pm * 2 * hstepAn; nB = (const char*)jn.Bt + (size_t)nxt.pn * 2 * hstepBn; }
        for (int t = 0; t < nt; t += 2) {
            const bool last = (t == nt - 2);
            const char* a1 = cA + (size_t)(t + 1) * kstep;
            const char* a2 = last ? nA : cA + (size_t)(t + 2) * kstep; const char* b2 = last ? nB : cB + (size_t)(t + 2) * kstep;
            const char* a3 = a2 + kstep; const char* b3 = b2 + kstep;
            const unsigned hA2 = last ? hstepAn : hstepA, hB2 = last ? hstepBn : hstepB;
            unsigned vA2[2], vB2[2];
            vA2[0] = last ? voffAn[0] : voffA[0]; vA2[1] = last ? voffAn[1] : voffA[1]; vB2[0] = last ? voffBn[0] : voffB[0]; vB2[1] = last ? voffBn[1] : voffB[1];
            PG8_LDB(B0, 0, 0); PG8_LDB(B1, 0, 1); PG8_SCHED; PG8_LDA(At, 0, 0); PG8_STAGE(PG8_SA(1, 1), a1 + hstepA, voffA);
            PG8_WAIT_V(8); PG8_WAIT_L(0); PG8_BAR; PG8_MMA(0, 0, At, B0); PG8_MMA(0, 1, At, B1); PG8_BAR; PG8_SCHED;
            PG8_LDA(At, 0, 1); PG8_STAGE(PG8_SB(0, 0), b2, vB2); PG8_STAGE(PG8_SB(0, 1), b2 + hB2, vB2); PG8_STAGE(PG8_SA(0, 0), a2, vA2);
            PG8_WAIT_V(8); PG8_WAIT_L(0); PG8_BAR; PG8_MMA(1, 0, At, B0); PG8_MMA(1, 1, At, B1); PG8_BAR; PG8_SCHED;
            PG8_LDB(B0, 1, 0); PG8_LDB(B1, 1, 1); PG8_SCHED; PG8_LDA(At, 1, 0); PG8_STAGE(PG8_SA(0, 1), a2 + hA2, vA2);
            PG8_WAIT_V(8); PG8_WAIT_L(0); PG8_BAR; PG8_MMA(0, 0, At, B0); PG8_MMA(0, 1, At, B1); PG8_BAR; PG8_SCHED;
            PG8_LDA(At, 1, 1); PG8_STAGE(PG8_SB(1, 0), b3, vB2); PG8_STAGE(PG8_SB(1, 1), b3 + hB2, vB2); PG8_STAGE(PG8_SA(1, 0), a3, vA2);
            PG8_WAIT_V(8); PG8_WAIT_L(0); PG8_BAR; PG8_MMA(1, 0, At, B0); PG8_MMA(1, 1, At, B1); PG8_BAR; PG8_SCHED;
        }
        if (wr == 0) PG8_BAR;
        P.epilogue(acc, cur, wr, wc, fr, fq);
        if (!has_next) break;
#pragma unroll
        for (int a = 0; a < 2; ++a)
#pragma unroll
            for (int b = 0; b < 2; ++b)
#pragma unroll
                for (int m = 0; m < 4; ++m)
#pragma unroll
                    for (int n = 0; n < 2; ++n) acc[a][b][m][n] = (f32x4){0.f, 0.f, 0.f, 0.f};
        cur = nxt; cA = nA; cB = nB; nt = ntn; hstepA = hstepAn; hstepB = hstepBn; voffA[0] = voffAn[0]; voffA[1] = voffAn[1]; voffB[0] = voffBn[0]; voffB[1] = voffBn[1];
        if (wr == 1) PG8_BAR;
    }
    PG8_WAIT_V(0);
    PG8_BAR;
#undef PG8_VOFF
}
#undef PG8_SA
#undef PG8_SB
#undef PG8_STAGE
#undef PG8_LDA
#undef PG8_LDB
#undef PG8_MMA
#undef PG8_WAIT_V
#undef PG8_WAIT_L
#undef PG8_BAR
#undef PG8_SCHED
}

constexpr int NWAVES = 8, NTHREADS = 512;
constexpr int LDS_BYTES = 147456;

DI float wave_sum(float v) {
#pragma unroll
    for (int o = 1; o < 64; o <<= 1) v += __shfl_xor(v, o);
    return v;
}

DI void transpose_item(const float* W, int K, int N, const float* gk, bf16_t* WT, int dst_row0, int k0, int n0, LAS float* scr, int lane) {
    f32x4 wv[8]; float gv[8];
#pragma unroll
    for (int i = 0; i < 8; ++i) { const int kk = 8 * i + (lane >> 3), nq = (lane & 7) * 4; wv[i] = *(const f32x4*)(W + (size_t)(k0 + kk) * N + n0 + nq); gv[i] = gk ? gk[k0 + kk] : 1.0f; }
    asm volatile("" ::: "memory");
#pragma unroll
    for (int i = 0; i < 8; ++i) { const int kk = 8 * i + (lane >> 3), nq = (lane & 7) * 4; const f32x4 w = wv[i] * gv[i];
        LAS float* d = scr + kk * 33 + nq; d[0] = w[0]; d[1] = w[1]; d[2] = w[2]; d[3] = w[3]; }
    asm volatile("s_waitcnt lgkmcnt(0)" ::: "memory");
    const int c = lane & 7;
#pragma unroll
    for (int j = 0; j < 4; ++j) { const int n = (lane >> 3) + 8 * j; const LAS float* s = scr + (8 * c) * 33 + n;
        u32x4 o; o.x = pkbf(s[0 * 33], s[1 * 33]); o.y = pkbf(s[2 * 33], s[3 * 33]); o.z = pkbf(s[4 * 33], s[5 * 33]); o.w = pkbf(s[6 * 33], s[7 * 33]);
        *(u32x4*)(WT + (size_t)(dst_row0 + n) * K + k0 + 8 * c) = o; }
    asm volatile("s_waitcnt lgkmcnt(0)" ::: "memory");
}

struct Args { const float* in[22]; float* out; unsigned char* ws; };
constexpr int PTR_OFF = 131072;
DI unsigned long long ldq(LAS unsigned char* lds, int i) {
    unsigned off = (unsigned)(PTR_OFF + 8 * i); asm volatile("" : "+v"(off));
    const unsigned long long v = *(const LAS unsigned long long*)(lds + off);
    const unsigned lo = __builtin_amdgcn_readfirstlane((unsigned)v), hi = __builtin_amdgcn_readfirstlane((unsigned)(v >> 32));
    return ((unsigned long long)hi << 32) | lo;
}
#define GAS __attribute__((address_space(1)))
#define INP(i) ((const float*)(const GAS float*)ldq(lds, (i)))
#define OUTP ((float*)(GAS float*)ldq(lds, 22))
#define WSP ((unsigned char*)(GAS unsigned char*)ldq(lds, 23))

DI void prep_weights(int l, LAS unsigned char* lds, int gw, int NGW, int wave, int lane, int part = 0) {
    LAS float* scr = (LAS float*)(lds + wave * 16384);
    unsigned char* ws = WSP;
    constexpr int I_IN = 16 * 224, I_BR = 8 * 32, I_SQ = 16 * 32, I_GU = 16 * 88, I_DN = 44 * 32;
    constexpr int NSQ = 7; constexpr int NITEMS = I_IN + 3 * I_BR + NSQ * I_SQ + 2 * I_GU + I_DN;
    const int it_lo = part == 2 ? NITEMS - I_DN : 0, it_hi = part == 1 ? NITEMS - I_DN : NITEMS;
    for (int it = it_lo + gw; it < it_hi; it += NGW) {
        int r = it;
        if (r < I_IN) { const int kb = r / 224, nb = r % 224, n0 = nb * 32, seg = n0 >> 9;
            int base;
            switch (seg) { case 0: base = 0; break; case 1: base = 512; break; case 2: base = 3072; break; case 3: base = 1024; break; case 4: base = 3584; break;
                           case 5: base = 1536; break; case 6: base = 2048; break; case 7: base = 2560; break; default: base = seg * 512; break; }
            transpose_item(INP(3) + (size_t)l * D * INC, D, INC, INP(2) + l * D, (bf16_t*)(ws + WS_WIN), base + (n0 & 511), kb * 64, n0, scr, lane); continue; }
        r -= I_IN;
        if (r < 3 * I_BR) { const int n = r / I_BR, q = r % I_BR, kb = q / 32, nb = q % 32;
            transpose_item(INP(9) + ((size_t)l * 3 + n) * 512 * D, 512, D, nullptr, (bf16_t*)(ws + WS_WB) + (size_t)n * D * 512, nb * 32, kb * 64, nb * 32, scr, lane); continue; }
        r -= 3 * I_BR;
        if (r < NSQ * I_SQ) { const int w = r / I_SQ, q = r % I_SQ, kb = q / 32, nb = q % 32;
            const float* src; const float* gk = nullptr; size_t dst;
            if (l == 0 && w >= 5) {
                transpose_item(INP(w == 5 ? 14 : 15) + (size_t)D * D, D, D, nullptr, (bf16_t*)(ws + (w == 5 ? WS_WK1 : WS_WV1)), nb * 32, kb * 64, nb * 32, scr, lane); continue; }
            if (w >= 5 || (l == 1 && (w == 2 || w == 3))) continue;
            switch (w) { case 0: src = INP(10); dst = WS_WOUT; break; case 1: src = INP(13); dst = WS_WQ; gk = INP(11) + l * D; break; case 2: src = INP(14); dst = WS_WK; break;
                         case 3: src = INP(15); dst = WS_WV; break; default: src = INP(16); dst = WS_WOX; break; }
            transpose_item(src + (size_t)l * D * D, D, D, gk, (bf16_t*)(ws + dst), nb * 32, kb * 64, nb * 32, scr, lane); continue; }
        r -= NSQ * I_SQ;
        if (r < 2 * I_GU) { const int w = r / I_GU, q = r % I_GU, kb = q / 88, nb = q % 88, n0 = nb * 32;
            transpose_item(INP(18 + w) + (size_t)l * D * FF, D, FF, INP(17) + l * D, (bf16_t*)(ws + WS_WGU), (n0 >> 7) * 256 + w * 128 + (n0 & 127), kb * 64, n0, scr, lane); continue; }
        r -= 2 * I_GU;
        { const int kb = r / 32, nb = r % 32;
          transpose_item(INP(20) + (size_t)l * FF * D, FF, D, nullptr, (bf16_t*)(ws + WS_WD), nb * 32, kb * 64, nb * 32, scr, lane); }
    }
    if (l == 0) {
        for (int row2 = gw; row2 < 2 * NBATCH * 256; row2 += NGW) {
            const int lay = row2 >> 10, row = row2 & 1023; const float* mg = INP(12) + lay * D;
            const f32x4* xr = (const f32x4*)(INP(1) + (size_t)row * D) + lane; f32x4 v[4]; float s = 0.f;
#pragma unroll
            for (int j = 0; j < 4; ++j) { v[j] = xr[64 * j]; s += (v[j][0] * v[j][0] + v[j][1] * v[j][1]) + (v[j][2] * v[j][2] + v[j][3] * v[j][3]); }
            const float rs = 1.0f / sqrtf(wave_sum(s) * (1.0f / D) + RMS_EPS);
            u32x2* o = (u32x2*)((bf16_t*)(ws + (lay ? WS_MB1 : WS_MB)) + (size_t)row * D) + lane;
#pragma unroll
            for (int j = 0; j < 4; ++j) { const f32x4 gv = *((const f32x4*)mg + lane + 64 * j); u32x2 w; w.x = pkbf(v[j][0] * rs * gv[0], v[j][1] * rs * gv[1]); w.y = pkbf(v[j][2] * rs * gv[2], v[j][3] * rs * gv[3]); o[64 * j] = w; }
        }
    }
}

DI void prep_x(LAS unsigned char* lds, int gw, int NGW, int lane) {
    unsigned char* ws = WSP; const float* xin = INP(0);
    float* ssp = (float*)(ws + WS_SSP);
    for (int row = gw; row < M; row += NGW) {
        const f32x4* xr = (const f32x4*)(xin + (size_t)row * D) + lane; f32x4 v[4]; float s = 0.f;
#pragma unroll
        for (int j = 0; j < 4; ++j) { v[j] = xr[64 * j]; s += (v[j][0] * v[j][0] + v[j][1] * v[j][1]) + (v[j][2] * v[j][2] + v[j][3] * v[j][3]); }
        s = wave_sum(s);
        u32x2* o = (u32x2*)((bf16_t*)(ws + WS_XB) + (size_t)row * D) + lane;
#pragma unroll
        for (int j = 0; j < 4; ++j) { u32x2 w; w.x = pkbf(v[j][0], v[j][1]); w.y = pkbf(v[j][2], v[j][3]); o[64 * j] = w; }
        if (lane < 16) ssp[(size_t)row * 16 + lane] = lane == 0 ? s : 0.f;
    }
}

DI void final_norm(LAS unsigned char* lds, int gw, int NGW, int lane) {
    const float* fg = INP(21); float* outp = OUTP; const float* ssp = (const float*)(WSP + WS_SSP);
    for (int row = gw; row < M; row += NGW) {
        f32x4* xr = (f32x4*)(outp + (size_t)row * D) + lane; const u32x2* xbr = (const u32x2*)((const bf16_t*)(WSP + WS_XB) + (size_t)row * D) + lane;
        float s = lane < 16 ? ssp[(size_t)row * 16 + lane] : 0.f; s = wave_sum(s);
        const float rs = 1.0f / sqrtf(s * (1.0f / D) + RMS_EPS);
#pragma unroll
        for (int j = 0; j < 4; ++j) { const f32x4 gv = *((const f32x4*)fg + lane + 64 * j); const u32x2 w = xbr[64 * j]; xr[64 * j] = (f32x4){bflo(w.x), bfhi(w.x), bflo(w.y), bfhi(w.y)} * rs * gv; }
    }
}

DI void sb_attn_item(bf16_t* p, const bf16_t* T, int item, int lane) {
    const int b = item >> 10, h = (item >> 7) & 7, qb = item & 127;
    const int hl = lane >> 5, li = lane & 31;
    const size_t rowbase = (size_t)b * SEQ;
    const int kperm = (li & 16) | ((li & 4) << 1) | ((li & 8) >> 1) | (li & 3);
    const bf16_t* qrow = p + (rowbase + qb * 32 + li) * PC + h * 64 + 8 * hl;
    bf16x8 qf[4];
#pragma unroll
    for (int kk = 0; kk < 4; ++kk) qf[kk] = *(const bf16x8*)(qrow + 16 * kk);
    bf16x8 U[2];
#pragma unroll
    for (int c = 0; c < 2; ++c)
#pragma unroll
        for (int e = 0; e < 8; ++e) U[c][e] = (16 * c + 8 * hl + e >= kperm) ? (short)0x3f80 : (short)0;
    f32x16 o0, o1;
#pragma unroll
    for (int r = 0; r < 16; ++r) { o0[r] = 0.f; o1[r] = 0.f; }
    float carry = 0.f;
    const bf16_t* vt0 = T + (size_t)(h * 64 + li) * M + rowbase + 8 * hl;
    for (int kb = qb; kb >= 0; --kb) {
        const int s0 = kb * 32;
        const bf16_t* krow = p + (rowbase + s0 + kperm) * PC + 512 + h * 64 + 8 * hl;
        bf16x8 kf[4], vf[4];
#pragma unroll
        for (int kk = 0; kk < 4; ++kk) kf[kk] = *(const bf16x8*)(krow + 16 * kk);
#pragma unroll
        for (int c = 0; c < 2; ++c) { vf[c] = *(const bf16x8*)(vt0 + s0 + 16 * c); vf[2 + c] = *(const bf16x8*)(vt0 + (size_t)32 * M + s0 + 16 * c); }
        f32x16 z;
#pragma unroll
        for (int r = 0; r < 16; ++r) z[r] = 0.f;
#pragma unroll
        for (int kk = 0; kk < 4; ++kk) z = MFMA32(kf[kk], qf[kk], z);
        const bool diag = (kb == qb);
        float Lv[16];
#pragma unroll
        for (int r = 0; r < 16; ++r) {
            const float zz = z[r];
            float L = fmaxf(zz, 0.f) + LN2 * __builtin_amdgcn_logf(1.0f + __builtin_amdgcn_exp2f(-fabsf(zz) * LOG2E));
            if (diag && !(16 * (r >> 3) + 8 * hl + (r & 7) < li)) L = 0.f;
            Lv[r] = L;
        }
        bf16x8 Lh[2], Ll[2];
#pragma unroll
        for (int c = 0; c < 2; ++c) { u32x4 wh, wl;
#pragma unroll
            for (int e = 0; e < 4; ++e) { const float a0 = Lv[8 * c + 2 * e], a1 = Lv[8 * c + 2 * e + 1]; const unsigned hp = pkbf(a0, a1); wh[e] = hp; wl[e] = pkbf(a0 - bflo(hp), a1 - bfhi(hp)); }
            Lh[c] = __builtin_bit_cast(bf16x8, wh); Ll[c] = __builtin_bit_cast(bf16x8, wl); }
        f32x16 C;
#pragma unroll
        for (int r = 0; r < 16; ++r) C[r] = carry;
        C = MFMA32(U[0], Lh[0], C); C = MFMA32(U[1], Lh[1], C); C = MFMA32(U[0], Ll[0], C); C = MFMA32(U[1], Ll[1], C);
        bf16x8 pf[2];
#pragma unroll
        for (int c = 0; c < 2; ++c) { u32x4 w;
#pragma unroll
            for (int e = 0; e < 4; ++e) { float a0, a1; { const int r = 8 * c + 2 * e; a0 = __builtin_amdgcn_exp2f((z[r] - C[r]) * LOG2E); a1 = __builtin_amdgcn_exp2f((z[r + 1] - C[r + 1]) * LOG2E);
                    if (diag) { if (!(16 * c + 8 * hl + 2 * e < li)) a0 = 0.f; if (!(16 * c + 8 * hl + 2 * e + 1 < li)) a1 = 0.f; } }
                w[e] = pkbf(a0, a1); }
            pf[c] = __builtin_bit_cast(bf16x8, w); }
        carry = __shfl(C[0], li);
        o0 = MFMA32(vf[0], pf[0], o0); o0 = MFMA32(vf[1], pf[1], o0);
        o1 = MFMA32(vf[2], pf[0], o1); o1 = MFMA32(vf[3], pf[1], o1);
        if (__all(carry > SB_EXIT)) break;
    }
    bf16_t* orow = p + (rowbase + qb * 32 + li) * PC + h * 64 + 4 * hl;
#pragma unroll
    for (int g = 0; g < 4; ++g) {
        u32x2 w0, w1; w0.x = pkbf(o0[4 * g], o0[4 * g + 1]); w0.y = pkbf(o0[4 * g + 2], o0[4 * g + 3]); w1.x = pkbf(o1[4 * g], o1[4 * g + 1]); w1.y = pkbf(o1[4 * g + 2], o1[4 * g + 3]);
        *(u32x2*)(orow + 8 * g) = w0; *(u32x2*)(orow + 32 + 8 * g) = w1; }
}

DI void sgu_item(int l, bf16_t* p, const bf16_t* T, int item, LAS unsigned char* lds, int tid, int wave, int lane) {
    const int g = item & 3, n = (item >> 2) & 31, b = item >> 7;
    const size_t tok0 = (size_t)b * SEQ + n * 128;
    const bf16_t* zv = T + (size_t)512 * M;
    LAS float* red = (LAS float*)lds;
    LAS float* mean = (LAS float*)(lds + 8192);
    LAS float* rstd = (LAS float*)(lds + 8192 + 512);
    {
        float s0 = 0.f, s1 = 0.f, q0 = 0.f, q1 = 0.f;
        const bf16_t* src = zv + (size_t)(wave * 64) * M + tok0 + 2 * lane;
#pragma unroll 1
        for (int jb = 0; jb < 64; jb += 16) {
            unsigned wv[16];
#pragma unroll
            for (int j = 0; j < 16; ++j) wv[j] = *(const unsigned*)(src + (size_t)(jb + j) * M);
            asm volatile("" ::: "memory");
#pragma unroll
            for (int j = 0; j < 16; ++j) { const float a0 = bflo(wv[j]), a1 = bfhi(wv[j]); s0 += a0; s1 += a1; q0 += a0 * a0; q1 += a1 * a1; }
        }
        *(LAS f32x4*)(red + (wave * 64 + lane) * 4) = (f32x4){s0, q0, s1, q1};
    }
    __syncthreads();
    if (tid < 128) { float s = 0.f, q = 0.f;
#pragma unroll
        for (int w = 0; w < 8; ++w) { const f32x2 v = *(LAS f32x2*)(red + (w * 64 + (tid >> 1)) * 4 + (tid & 1) * 2); s += v.x; q += v.y; }
        const float mu = s * (1.0f / 512.0f), var = fmaxf(q * (1.0f / 512.0f) - mu * mu, 0.f);
        mean[tid] = mu; rstd[tid] = 1.0f / sqrtf(var + LN_EPS); }
    __syncthreads();
    const int cblk = wave & 3, th = wave >> 2, hl = lane >> 5, li = lane & 31;
    const int cch = g * 128 + cblk * 32 + li;
    const float lg = INP(4)[l * 512 + cch], lb = INP(5)[l * 512 + cch];
    const bf16_t* arow = zv + (size_t)cch * M + tok0 + 8 * hl;
    const float* wsp = INP(6) + ((size_t)(l * 4 + g) * 128) * 128;
    f32x16 acc0, acc1;
#pragma unroll
    for (int r = 0; r < 16; ++r) { acc0[r] = 0.f; acc1[r] = 0.f; }
#pragma unroll
    for (int hf = 0; hf < 2; ++hf) if (hf == 0 || th) {
        u32x4 raw[4]; f32x4 wv[4][2][2];
#pragma unroll
        for (int k4 = 0; k4 < 4; ++k4) { const int kk = 4 * hf + k4, sb = 16 * kk + 8 * hl;
            raw[k4] = *(const u32x4*)(arow + 16 * kk);
#pragma unroll
            for (int tb = 0; tb < 2; ++tb) { const int t = th * 64 + tb * 32 + li; wv[k4][tb][0] = *(const f32x4*)(wsp + (size_t)t * 128 + sb); wv[k4][tb][1] = *(const f32x4*)(wsp + (size_t)t * 128 + sb + 4); } }
        asm volatile("" ::: "memory");
#pragma unroll
        for (int k4 = 0; k4 < 4; ++k4) { const int kk = 4 * hf + k4, sb = 16 * kk + 8 * hl;
            const f32x4 m0 = *(LAS f32x4*)(mean + sb), m1 = *(LAS f32x4*)(mean + sb + 4), r0 = *(LAS f32x4*)(rstd + sb), r1 = *(LAS f32x4*)(rstd + sb + 4);
            const u32x4 rw = raw[k4]; u32x4 aw;
            aw.x = pkbf((bflo(rw.x) - m0[0]) * r0[0] * lg + lb, (bfhi(rw.x) - m0[1]) * r0[1] * lg + lb);
            aw.y = pkbf((bflo(rw.y) - m0[2]) * r0[2] * lg + lb, (bfhi(rw.y) - m0[3]) * r0[3] * lg + lb);
            aw.z = pkbf((bflo(rw.z) - m1[0]) * r1[0] * lg + lb, (bfhi(rw.z) - m1[1]) * r1[1] * lg + lb);
            aw.w = pkbf((bflo(rw.w) - m1[2]) * r1[2] * lg + lb, (bfhi(rw.w) - m1[3]) * r1[3] * lg + lb);
            const bf16x8 af = __builtin_bit_cast(bf16x8, aw);
#pragma unroll
            for (int tb = 0; tb < 2; ++tb) { const f32x4 w0 = wv[k4][tb][0], w1 = wv[k4][tb][1];
                u32x4 bw; bw.x = pkbf(w0[0], w0[1]); bw.y = pkbf(w0[2], w0[3]); bw.z = pkbf(w1[0], w1[1]); bw.w = pkbf(w1[2], w1[3]);
                const bf16x8 bfr = __builtin_bit_cast(bf16x8, bw);
                if (tb == 0) acc0 = MFMA32(af, bfr, acc0); else acc1 = MFMA32(af, bfr, acc1); } }
    }
#pragma unroll
    for (int tb = 0; tb < 2; ++tb) {
        const int t = th * 64 + tb * 32 + li; const float bs = INP(7)[(l * 4 + g) * 128 + t];
        bf16_t* urow = p + (tok0 + t) * PC + 1024 + g * 128 + cblk * 32 + 4 * hl;
        u32x2 uws[4];
#pragma unroll
        for (int q = 0; q < 4; ++q) uws[q] = *(const u32x2*)(urow + 8 * q);
#pragma unroll
        for (int q = 0; q < 4; ++q) { const u32x2 uw = uws[q];
            float v0, v1, v2, v3;
            if (tb == 0) { v0 = acc0[4 * q]; v1 = acc0[4 * q + 1]; v2 = acc0[4 * q + 2]; v3 = acc0[4 * q + 3]; } else { v0 = acc1[4 * q]; v1 = acc1[4 * q + 1]; v2 = acc1[4 * q + 2]; v3 = acc1[4 * q + 3]; }
            u32x2 ow; ow.x = pkbf(bflo(uw.x) * (v0 + bs), bfhi(uw.x) * (v1 + bs)); ow.y = pkbf(bflo(uw.y) * (v2 + bs), bfhi(uw.y) * (v3 + bs));
            *(u32x2*)(urow + 8 * q) = ow; }
    }
    __syncthreads();
}

DI void conv_phase(int l, bf16_t* p, LAS unsigned char* lds, int gtid, int NGT) {
    const float* cw = INP(8) + (size_t)l * 3 * 512;
    for (int it = gtid; it < M * 64; it += NGT) {
        const int row = it >> 6, c8 = (it & 63) * 8, t = row & (SEQ - 1);
        bf16_t* pr = p + (size_t)row * PC;
        float accv[8];
#pragma unroll
        for (int e = 0; e < 8; ++e) accv[e] = 0.f;
        u32x4 ccv[3], cxv[3];
#pragma unroll
        for (int j = 0; j < 3; ++j) { const int dt = (t - (2 - j) >= 0) ? 2 - j : 0;
            ccv[j] = *(const u32x4*)(pr - (size_t)dt * PC + 2048 + c8); cxv[j] = *(const u32x4*)(pr - (size_t)dt * PC + 2560 + c8); }
        const u32x4 cb = *(const u32x4*)(pr + 1536 + c8);
        asm volatile("" ::: "memory");
#pragma unroll
        for (int j = 0; j < 3; ++j) { const int dt = 2 - j;
            if (t - dt >= 0) {
                const u32x4 cc = ccv[j], cx = cxv[j];
                const f32x4 w0 = *(const f32x4*)(cw + j * 512 + c8), w1 = *(const f32x4*)(cw + j * 512 + c8 + 4);
                accv[0] += w0[0] * bflo(cc.x) * bflo(cx.x); accv[1] += w0[1] * bfhi(cc.x) * bfhi(cx.x); accv[2] += w0[2] * bflo(cc.y) * bflo(cx.y); accv[3] += w0[3] * bfhi(cc.y) * bfhi(cx.y);
                accv[4] += w1[0] * bflo(cc.z) * bflo(cx.z); accv[5] += w1[1] * bfhi(cc.z) * bfhi(cx.z); accv[6] += w1[2] * bflo(cc.w) * bflo(cx.w); accv[7] += w1[3] * bfhi(cc.w) * bfhi(cx.w); } }
        u32x4 o; o.x = pkbf(bflo(cb.x) * accv[0], bfhi(cb.x) * accv[1]); o.y = pkbf(bflo(cb.y) * accv[2], bfhi(cb.y) * accv[3]); o.z = pkbf(bflo(cb.z) * accv[4], bfhi(cb.z) * accv[5]); o.w = pkbf(bflo(cb.w) * accv[6], bfhi(cb.w) * accv[7]);
        *(u32x4*)(pr + 1536 + c8) = o;
    }
}

DI void xattn_wg(const bf16_t* qx, const bf16_t* memK, const bf16_t* memVT, bf16_t* ox, int item, int tid, int wave, int lane, LAS unsigned char* lds) {
    const int b = item >> 6, h = (item >> 4) & 3, qb = (item & 15) * 8 + wave;
    const int hl = lane >> 5, li = lane & 31;
    const size_t qrow = (size_t)b * SEQ + qb * 32 + li;
    bf16x8 qf[16];
#pragma unroll
    for (int kk = 0; kk < 16; ++kk) qf[kk] = *(const bf16x8*)(qx + qrow * D + h * 256 + 16 * kk + 8 * hl);
    const int sr = tid >> 4, sp0 = (tid & 15) * 2;
    const int kperm_sr = (sr & 16) | ((sr & 4) << 1) | ((sr & 8) >> 1) | (sr & 3);
    const bf16_t* kbase = memK + (size_t)(b * 256) * D + h * 256;
    const bf16_t* vbase = memVT + (size_t)(h * 256) * D + b * 256;
    u32x4 st[2];
#define XA_LOAD(c) do { if ((c) < 8) { _Pragma("unroll") for (int e = 0; e < 2; ++e) st[e] = *(const u32x4*)(kbase + (size_t)((c) * 32 + sr) * D + (sp0 + e) * 8); } \
                        else { _Pragma("unroll") for (int e = 0; e < 2; ++e) st[e] = *(const u32x4*)(vbase + (size_t)(((c) - 8) * 32 + sr) * D + (sp0 + e) * 8); } } while (0)
#define XA_STORE(c) do { const int rl = (c) < 8 ? kperm_sr : sr; _Pragma("unroll") for (int e = 0; e < 2; ++e) { const int p = sp0 + e; \
                        *(LAS u32x4*)(lds + ((c) & 1) * 16384 + (((p >> 1) * 64) + (p & 1) * 32 + rl) * 16) = st[e]; } } while (0)
    XA_LOAD(0); XA_STORE(0);
    __syncthreads();
    f32x16 S[8];
#pragma unroll
    for (int c = 0; c < 8; ++c) {
        XA_LOAD(c + 1);
        f32x16 z;
#pragma unroll
        for (int r = 0; r < 16; ++r) z[r] = 0.f;
        const LAS unsigned char* buf = lds + (c & 1) * 16384 + lane * 16;
#pragma unroll
        for (int kk = 0; kk < 16; ++kk) { const bf16x8 kf = *(const LAS bf16x8*)(buf + kk * 1024); z = MFMA32(kf, qf[kk], z); }
        S[c] = z;
        XA_STORE(c + 1);
        __syncthreads();
    }
    float mx = -3.0e38f;
#pragma unroll
    for (int kb = 0; kb < 8; ++kb)
#pragma unroll
        for (int r = 0; r < 16; ++r) mx = fmaxf(mx, S[kb][r]);
    mx = fmaxf(mx, __shfl_xor(mx, 32));
    float sum = 0.f;
    bf16x8 pf[16];
#pragma unroll
    for (int kb = 0; kb < 8; ++kb)
#pragma unroll
        for (int c = 0; c < 2; ++c) { u32x4 w;
#pragma unroll
            for (int e = 0; e < 4; ++e) { const float a0 = __builtin_amdgcn_exp2f((S[kb][8 * c + 2 * e] - mx) * LOG2E), a1 = __builtin_amdgcn_exp2f((S[kb][8 * c + 2 * e + 1] - mx) * LOG2E); sum += a0 + a1; w[e] = pkbf(a0, a1); }
            pf[2 * kb + c] = __builtin_bit_cast(bf16x8, w); }
    sum += __shfl_xor(sum, 32);
    const float inv = 1.0f / sum;
    bf16_t* orow = ox + qrow * D + h * 256 + 4 * hl;
#pragma unroll 1
    for (int c = 8; c < 16; ++c) {
        if (c + 1 < 16) XA_LOAD(c + 1);
        f32x16 o;
#pragma unroll
        for (int r = 0; r < 16; ++r) o[r] = 0.f;
        const LAS unsigned char* buf = lds + (c & 1) * 16384 + lane * 16;
#pragma unroll
        for (int s = 0; s < 16; ++s) { const bf16x8 vf = *(const LAS bf16x8*)(buf + s * 1024); o = MFMA32(vf, pf[s], o); }
        const int db = c - 8;
#pragma unroll
        for (int g = 0; g < 4; ++g) { u32x2 w; w.x = pkbf(o[4 * g] * inv, o[4 * g + 1] * inv); w.y = pkbf(o[4 * g + 2] * inv, o[4 * g + 3] * inv); *(u32x2*)(orow + db * 32 + 8 * g) = w; }
        if (c + 1 < 16) XA_STORE(c + 1);
        __syncthreads();
    }
#undef XA_LOAD
#undef XA_STORE
}

constexpr int RSD_OFF = 131072 + 768, RS_OFF = 131072 + 1024, RS_MAXU = 15;
template <class Prog>
DI void fill_rs(LAS unsigned char* lds, Prog P2, const float* ssp, int tid) {
    LAS int* desc = (LAS int*)(lds + RSD_OFF);
    if (tid == 0) { pg8::UnitX x; int n = 0; while (n < RS_MAXU && P2.next(x)) { desc[n] = P2.rs_base(x); ++n; } desc[RS_MAXU] = n; }
    __syncthreads();
    const int n = desc[RS_MAXU];
    for (int kb = 0; kb < n; kb += 8) {
        f32x4 sv[4][4]; int ok[4];
#pragma unroll
        for (int j = 0; j < 4; ++j) { const int k = kb + 2 * j + (tid >> 8); const int base = k < n ? desc[k] : -1; ok[j] = base >= 0;
            const f32x4* sp = (const f32x4*)(ssp + (size_t)((ok[j] ? base : 0) + (tid & 255)) * 16);
#pragma unroll
            for (int q = 0; q < 4; ++q) sv[j][q] = ok[j] ? sp[q] : (f32x4){0.f, 0.f, 0.f, 0.f}; }
        asm volatile("" ::: "memory");
#pragma unroll
        for (int j = 0; j < 4; ++j) if (ok[j]) { const int k = kb + 2 * j + (tid >> 8); float s = 0.f;
#pragma unroll
            for (int q = 0; q < 4; ++q) s += (sv[j][q][0] + sv[j][q][1]) + (sv[j][q][2] + sv[j][q][3]);
            ((LAS float*)(lds + RS_OFF))[k * 256 + (tid & 255)] = 1.0f / sqrtf(s * (1.0f / D) + RMS_EPS); }
    }
    __syncthreads();
}
struct ProgC {
    unsigned char* ws; LAS unsigned char* lds; int G, c; int j, i, kk; pg8::Unit u; bool have;
    DI int rs_base(const pg8::UnitX& x) const { return (x.job & 1) ? -1 : x.pm * 256; }
    DI void init(unsigned char* ws_, int G_, int c_, LAS unsigned char* lds_) { lds = lds_; kk = 0; ws = ws_; G = G_; c = c_; j = 0; i = 0; pg8::StaticOrder S; S.init(M, D, G, c); have = S.next(0, u); }
    DI bool next(pg8::UnitX& x) {
        if (have && j >= 6) { pg8::StaticOrder S; S.init(M, D, G, c); ++i; j = 0; have = S.next(i, u); }
        if (!have) return false;
        x.pm = u.pm; x.pn = u.pn; x.job = j; x.k = kk; ++kk; ++j; return true; }
    DI pg8::JobP job(int jj) const { const int n = jj >> 1; pg8::JobP p;
        if ((jj & 1) == 0) { p.A = (const bf16_t*)(ws + WS_XB); p.Bt = (const bf16_t*)(ws + WS_WIN) + (size_t)(4096 + n * 1024) * D; p.lda = D; p.ldb = D; p.nt = D / 64; }
        else { const int acol = n == 0 ? 0 : (n == 1 ? 1024 : 1536); p.A = (const bf16_t*)(ws + WS_P) + acol; p.Bt = (const bf16_t*)(ws + WS_WB) + (size_t)n * D * 512; p.lda = PC; p.ldb = 512; p.nt = 512 / 64; }
        return p; }
    DI void epilogue(const f32x4 (&acc)[2][2][4][2], const pg8::UnitX& x, int wr, int wc, int fr, int fq) const {
        pg8::EpiArgs ea{}; const pg8::Unit uu{x.pm, x.pn};
        if ((x.job & 1) == 0) { ea.O = (bf16_t*)(ws + WS_T); ea.ldc = D; ea.ssp = (const float*)(ws + WS_SSP); ea.rstab = (const LAS float*)(lds + RS_OFF) + x.k * 256; ea.cscale = 1.f; pg8::Epi<pg8::E_GATE> E{ea}; E(acc, uu, wr, wc, fr, fq); }
        else { ea.O = (bf16_t*)(ws + WS_X2); ea.ldc = D; ea.G = (const bf16_t*)(ws + WS_T);
            if (x.job == 1) { pg8::Epi<pg8::E_BR0> E{ea}; E(acc, uu, wr, wc, fr, fq); } else { pg8::Epi<pg8::E_BRN> E{ea}; E(acc, uu, wr, wc, fr, fq); } }
    }
};
struct ProgA {
    unsigned char* ws; LAS unsigned char* lds; int G, c; int jb, i, njobs, kk;
    DI int rs_base(const pg8::UnitX& x) const { return x.job == 0 ? x.pm * 256 : (x.job == 1 ? x.pn * 256 : -1); }
    DI void init(unsigned char* ws_, int G_, int c_, int l, LAS unsigned char* lds_) { lds = lds_; kk = 0; ws = ws_; G = G_; c = c_; jb = 0; i = 0; njobs = l == 0 ? 4 : 2; }
    DI bool next(pg8::UnitX& x) {
        for (; jb < njobs; ++jb, i = 0) {
            pg8::StaticOrder S; pg8::Unit u;
            if (jb == 0) S.init(M, 3072, G, c); else if (jb == 1) S.init(1024, M, G, c); else if (jb == 2) S.init(1024, D, G, (c + 64) % G); else S.init(D, 1024, G, (c + 192) % G);
            if (S.next(i, u)) { x.pm = u.pm; x.pn = u.pn; x.job = jb; x.k = kk; ++kk; ++i; return true; }
        }
        return false;
    }
    DI pg8::JobP job(int jj) const { pg8::JobP p; p.lda = D; p.ldb = D; p.nt = D / 64;
        if (jj == 0) { p.A = (const bf16_t*)(ws + WS_XB); p.Bt = (const bf16_t*)(ws + WS_WIN); }
        else if (jj == 1) { p.A = (const bf16_t*)(ws + WS_WIN) + (size_t)3072 * D; p.Bt = (const bf16_t*)(ws + WS_XB); }
        else if (jj == 2) { p.A = (const bf16_t*)(ws + WS_MB); p.Bt = (const bf16_t*)(ws + WS_WK); }
        else { p.A = (const bf16_t*)(ws + WS_WV); p.Bt = (const bf16_t*)(ws + WS_MB); }
        return p; }
    DI void epilogue(const f32x4 (&acc)[2][2][4][2], const pg8::UnitX& x, int wr, int wc, int fr, int fq) const {
        pg8::EpiArgs ea{}; const pg8::Unit uu{x.pm, x.pn};
        const LAS float* rst = (const LAS float*)(lds + RS_OFF) + x.k * 256;
        if (x.job == 0) { ea.O = (bf16_t*)(ws + WS_P); ea.ldc = PC; ea.ssp = (const float*)(ws + WS_SSP); ea.rstab = rst; ea.cscale = 1.f; pg8::Epi<pg8::E_INPROJ> E{ea}; E(acc, uu, wr, wc, fr, fq); }
        else if (x.job == 2) { ea.O = (bf16_t*)(ws + WS_MEMK); ea.ldc = D; ea.ssp = nullptr; ea.cscale = 1.f; pg8::Epi<pg8::E_ROWSCALE> E{ea}; E(acc, uu, wr, wc, fr, fq); }
        else { if (x.job == 1) { ea.O = (bf16_t*)(ws + WS_T); ea.ldc = M; ea.ssp = (const float*)(ws + WS_SSP); ea.rstab = rst; } else { ea.O = (bf16_t*)(ws + WS_MEMVT); ea.ldc = 1024; ea.ssp = nullptr; }
            pg8::Epi<pg8::E_TRANS> E{ea}; E(acc, uu, wr, wc, fr, fq); }
    }
};
struct ProgJ {
    unsigned char* ws; LAS unsigned char* lds; int G, c; int jb, i, njobs, kk;
    DI int rs_base(const pg8::UnitX& x) const { return x.job == 0 ? x.pm * 256 : -1; }
    DI void init(unsigned char* ws_, int G_, int c_, int l, LAS unsigned char* lds_) { lds = lds_; kk = 0; ws = ws_; G = G_; c = c_; jb = 0; i = 0; njobs = l == 0 ? 3 : 1; }
    DI bool next(pg8::UnitX& x) {
        for (; jb < njobs; ++jb, i = 0) {
            pg8::StaticOrder S; pg8::Unit u;
            if (jb == 0) S.init(M, 2 * FF, G, c); else if (jb == 1) S.init(1024, D, G, (c + 128) % G); else S.init(D, 1024, G, (c + 96) % G);
            if (S.next(i, u)) { x.pm = u.pm; x.pn = u.pn; x.job = jb; x.k = kk; ++kk; ++i; return true; }
        }
        return false;
    }
    DI pg8::JobP job(int jj) const { pg8::JobP p; p.lda = D; p.ldb = D; p.nt = D / 64;
        if (jj == 0) { p.A = (const bf16_t*)(ws + WS_XB); p.Bt = (const bf16_t*)(ws + WS_WGU); }
        else if (jj == 1) { p.A = (const bf16_t*)(ws + WS_MB1); p.Bt = (const bf16_t*)(ws + WS_WK1); }
        else { p.A = (const bf16_t*)(ws + WS_WV1); p.Bt = (const bf16_t*)(ws + WS_MB1); }
        return p; }
    DI void epilogue(const f32x4 (&acc)[2][2][4][2], const pg8::UnitX& x, int wr, int wc, int fr, int fq) const {
        pg8::EpiArgs ea{}; const pg8::Unit uu{x.pm, x.pn};
        if (x.job == 0) { ea.O = (bf16_t*)(ws + WS_P); ea.ldc = FF; ea.ssp = (const float*)(ws + WS_SSP) + (size_t)2 * M * 16; ea.rstab = (const LAS float*)(lds + RS_OFF) + x.k * 256; pg8::Epi<pg8::E_SWIGLU> E{ea}; E(acc, uu, wr, wc, fr, fq); }
        else if (x.job == 1) { ea.O = (bf16_t*)(ws + WS_MEMK1); ea.ldc = D; ea.ssp = nullptr; ea.cscale = 1.f; pg8::Epi<pg8::E_ROWSCALE> E{ea}; E(acc, uu, wr, wc, fr, fq); }
        else { ea.O = (bf16_t*)(ws + WS_MEMVT1); ea.ldc = 1024; ea.ssp = nullptr; pg8::Epi<pg8::E_TRANS> E{ea}; E(acc, uu, wr, wc, fr, fq); }
    }
};
#define XB_TMO      128
#define XB_XCNT(j)  (256  + 64 * (j))
#define XB_XSUB(j)  (1280 + 64 * (j))
#define XB_XGEN(j)  (2304 + 64 * (j))
#define XB_TOP      3328
#define XB_TOPGEN   3392
#define XCD_BAR_WORDS 3456
#define XB_SPIN_CAP (1u << 18)

__device__ __forceinline__ unsigned xb_ld(unsigned* p)              { return __hip_atomic_load(p, __ATOMIC_RELAXED, __HIP_MEMORY_SCOPE_AGENT); }
__device__ __forceinline__ unsigned xb_add(unsigned* p, unsigned v) { return __hip_atomic_fetch_add(p, v, __ATOMIC_RELAXED, __HIP_MEMORY_SCOPE_AGENT); }
__device__ __forceinline__ unsigned xb_xcc_id() { return (unsigned)__builtin_amdgcn_s_getreg((3 << 11) | 20) & 0xFu; }
#define XB_SPIN(cond, bar) do { unsigned _sp = 0; while (cond) { __builtin_amdgcn_s_sleep(1); \
    if ((++_sp & 255u) == 0u) { if (xb_ld(&(bar)[XB_TMO])) break; if (_sp > XB_SPIN_CAP) { atomicAdd(&(bar)[XB_TMO], 1u); break; } } } } while (0)

struct XcdBarrier {
    unsigned* bar; unsigned x;
    volatile LAS unsigned* st;
};

__device__ __forceinline__ XcdBarrier xcd_barrier_post(unsigned* bar, volatile LAS unsigned* st) {
    XcdBarrier b; b.bar = bar; b.x = xb_xcc_id(); b.st = st;
    if (threadIdx.x == 0) (void)xb_add(&bar[XB_XCNT(b.x)], 1u);
    return b;
}
__device__ __forceinline__ void xcd_barrier_complete(unsigned* bar, unsigned x, unsigned& nloc, unsigned& nx) {
    const unsigned G = gridDim.x * gridDim.y * gridDim.z;
    unsigned sum, cnt, mine, sp = 0u;
    for (;;) {
        sum = 0u; cnt = 0u; mine = 0u;
#pragma unroll
        for (unsigned j = 0; j < 16; ++j) { const unsigned c = xb_ld(&bar[XB_XCNT(j)]); sum += c; cnt += (c > 0u) ? 1u : 0u; mine = (j == x) ? c : mine; }
        if (sum == G) break;
        __builtin_amdgcn_s_sleep(1);
        if ((++sp & 255u) == 0u) { if (xb_ld(&bar[XB_TMO])) break; if (sp > XB_SPIN_CAP) { atomicAdd(&bar[XB_TMO], 1u); break; } }
    }
    nloc = mine > 0u ? mine : 1u; nx = cnt > 0u ? cnt : 1u;
}

__device__ __forceinline__ void xcd_barrier(const XcdBarrier& b) {
    asm volatile("s_waitcnt vmcnt(0)" ::: "memory");
    __syncthreads();
    if (threadIdx.x == 0) {
        unsigned* bar = b.bar;
        __builtin_amdgcn_s_waitcnt(0);
        unsigned nloc = b.st[0], nx = b.st[1];
        if (nloc == 0u) { xcd_barrier_complete(bar, b.x, nloc, nx); b.st[0] = nloc; b.st[1] = nx; }
        const unsigned old = xb_add(&bar[XB_XSUB(b.x)], 1u);
        const unsigned gen = old / nloc;
        if (old + 1u == (gen + 1u) * nloc) {
            __builtin_amdgcn_fence(__ATOMIC_RELEASE, "agent");
            asm volatile("s_waitcnt vmcnt(0)" ::: "memory");
            const unsigned og = xb_add(&bar[XB_TOP], 1u);
            const unsigned tg = og / nx;
            if (og + 1u == (tg + 1u) * nx) xb_add(&bar[XB_TOPGEN], 1u);
            else XB_SPIN(xb_ld(&bar[XB_TOPGEN]) == tg, bar);
            __builtin_amdgcn_fence(__ATOMIC_ACQUIRE, "agent");
            xb_add(&bar[XB_XGEN(b.x)], 1u);
            asm volatile("s_waitcnt vmcnt(0)" ::: "memory");
        } else {
            XB_SPIN(xb_ld(&bar[XB_XGEN(b.x)]) == gen, bar);
            __builtin_amdgcn_fence(__ATOMIC_ACQUIRE, "agent");
            asm volatile("s_waitcnt vmcnt(0)" ::: "memory");
        }
    }
    __syncthreads();
}

#define WSB(off) ((bf16_t*)(WSP + (off)))
#define WSF(off) ((float*)(WSP + (off)))
__global__ void __launch_bounds__(NTHREADS, 2) fwd_megakernel(Args A_unused) {
    extern __shared__ __attribute__((aligned(16))) unsigned char lds_raw[];
    LAS unsigned char* lds = (LAS unsigned char*)lds_raw;
    cg::grid_group grid = cg::this_grid();
    { const int tid = threadIdx.x;
    if (tid < 24) { const unsigned long long* ka = (const unsigned long long*)__builtin_amdgcn_kernarg_segment_ptr(); *(LAS unsigned long long*)(lds + PTR_OFF + 8 * tid) = ka[tid]; } }
    if (threadIdx.x < 8) ((LAS unsigned*)(lds + PTR_OFF + 256))[threadIdx.x] = 0u;
    __syncthreads();
    if (blockIdx.x == 0) { unsigned* bw = (unsigned*)ldq(lds, 23); for (int w = threadIdx.x; w < XCD_BAR_WORDS; w += NTHREADS) __hip_atomic_store(bw + w, 0u, __ATOMIC_RELAXED, __HIP_MEMORY_SCOPE_AGENT); }
    asm volatile("s_waitcnt vmcnt(0)" ::: "memory");
    __syncthreads();
    grid.sync();
    const XcdBarrier bar = xcd_barrier_post((unsigned*)ldq(lds, 23), (volatile LAS unsigned*)(lds + PTR_OFF + 256));
#define XBAR() do { XcdBarrier b2_ = bar; asm volatile("" : "+s"(b2_.x)); xcd_barrier(b2_); } while (0)
#define FRESH_IDS const int tid = fresh_tid(), lane = tid & 63, wave = __builtin_amdgcn_readfirstlane(tid >> 6); (void)lane; (void)wave
#define GRID_ ((int)gridDim.x)
#define BID_ ((int)blockIdx.x)
#define GW_ (BID_ * NWAVES + wave)
#define NGW_ (GRID_ * NWAVES)
    constexpr size_t SSPB = (size_t)M * 16 * 4;
    using namespace pg8;

    { FRESH_IDS; prep_x(lds, GW_, NGW_, lane); }
    { FRESH_IDS; prep_weights(0, lds, GW_, NGW_, wave, lane); }
    XBAR();
    for (int l = 0; l < DEPTH; ++l) {
        { ProgA PA; PA.init(WSP, GRID_, BID_, l, lds); { FRESH_IDS; fill_rs(lds, PA, WSF(WS_SSP), tid); } gemm_stream(lds, PA); }
        XBAR();
        if (l > 0) { FRESH_IDS; prep_weights(l, lds, GW_, NGW_, wave, lane, 2); __syncthreads(); }
        { FRESH_IDS; for (int it = BID_; it < NBATCH * 32 * 4; it += GRID_) sgu_item(l, WSB(WS_P), WSB(WS_T), it, lds, tid, wave, lane); }
        { FRESH_IDS; for (int it = GW_; it < NBATCH * 8 * 128; it += NGW_) sb_attn_item(WSB(WS_P), WSB(WS_T), it, lane); }
        { FRESH_IDS; conv_phase(l, WSB(WS_P), lds, BID_ * NTHREADS + tid, GRID_ * NTHREADS); }
        XBAR();
        { ProgC PCg; PCg.init(WSP, GRID_, BID_, lds); { FRESH_IDS; fill_rs(lds, PCg, WSF(WS_SSP), tid); } gemm_stream(lds, PCg); }
        XBAR();
        {
            StaticOrder S; S.init(M, D, GRID_, BID_);
            EpiArgs ea{}; Gemm g{WSB(WS_X2), WSB(WS_WOUT), M, D, D, D, D}; ea.xb = WSB(WS_XB); ea.sspo = WSF(WS_SSP + SSPB); Epi<E_RESID> E{ea}; gemm_phase(lds, g, S, E);
        }
        XBAR();
        {
            StaticOrder S; S.init(M, D, GRID_, BID_);
            EpiArgs ea{}; Gemm g{WSB(WS_XB), WSB(WS_WQ), M, D, D, D, D}; ea.O = WSB(WS_T); ea.ldc = D; ea.ssp = WSF(WS_SSP + SSPB); ea.cscale = 0.0625f; Epi<E_ROWSCALE> E{ea}; gemm_phase(lds, g, S, E);
            Unit u;
            for (int i = 0; S.next(i, u); ++i) { FRESH_IDS; xattn_wg(WSB(WS_T), WSB(l ? WS_MEMK1 : WS_MEMK), WSB(l ? WS_MEMVT1 : WS_MEMVT), WSB(WS_X2), (u.pm >> 4) * 64 + u.pn * 16 + (u.pm & 15), tid, wave, lane, lds); }
        }
        XBAR();
        {
            StaticOrder S; S.init(M, D, GRID_, BID_);
            EpiArgs ea{}; Gemm g{WSB(WS_X2), WSB(WS_WOX), M, D, D, D, D}; ea.xb = WSB(WS_XB); ea.sspo = WSF(WS_SSP + 2 * SSPB); Epi<E_RESID> E{ea}; gemm_phase(lds, g, S, E);
        }
        XBAR();
        { ProgJ PJ; PJ.init(WSP, GRID_, BID_, l, lds); { FRESH_IDS; fill_rs(lds, PJ, WSF(WS_SSP + 2 * SSPB), tid); } gemm_stream(lds, PJ); }
        XBAR();
        {
            StaticOrder S; S.init(M, D, GRID_, BID_);
            EpiArgs ea{}; Gemm g{WSB(WS_P), WSB(WS_WD), M, D, FF, FF, FF}; ea.xb = WSB(WS_XB); ea.sspo = WSF(WS_SSP); Epi<E_RESID> E{ea}; gemm_phase(lds, g, S, E);
        }
        if (l + 1 < DEPTH) { FRESH_IDS; prep_weights(l + 1, lds, GW_, NGW_, wave, lane, 1); }
        XBAR();
    }
    { FRESH_IDS; final_norm(lds, GW_, NGW_, lane); }
}

extern "C" void kernel_launch(void* const* d_in, const int* in_sizes, int n_in, void* d_out, int out_size, void* d_ws, size_t ws_size, hipStream_t stream) {
    static int grid = 0;
    if (grid == 0) {
        if (n_in != 22 || in_sizes[0] != M * D || out_size != M * D || ws_size < WS_END) { fprintf(stderr, "kernel_launch: unexpected shapes (n_in %d, in0 %d, out %d, ws %zu)\n", n_in, n_in > 0 ? in_sizes[0] : -1, out_size, ws_size); grid = -1; return; }
        int dev = 0, cus = 0, per_cu = 0;
        hipGetDevice(&dev); hipDeviceGetAttribute(&cus, hipDeviceAttributeMultiprocessorCount, dev);
        hipFuncSetAttribute((const void*)fwd_megakernel, hipFuncAttributeMaxDynamicSharedMemorySize, LDS_BYTES);
        hipOccupancyMaxActiveBlocksPerMultiprocessor(&per_cu, (const void*)fwd_megakernel, NTHREADS, LDS_BYTES);
        if (per_cu < 1) { fprintf(stderr, "kernel_launch: occupancy query says %d blocks per CU\n", per_cu); per_cu = 1; }
        (void)hipGetLastError();
        grid = cus;
    }
    if (grid < 0) return;
    Args a{};
    for (int i = 0; i < 22; ++i) a.in[i] = (const float*)d_in[i];
    a.out = (float*)d_out; a.ws = (unsigned char*)d_ws;
    void* args[] = {&a};
    hipError_t e = hipLaunchCooperativeKernel((const void*)fwd_megakernel, dim3(grid), dim3(NTHREADS), args, LDS_BYTES, stream);
    if (e != hipSuccess) fprintf(stderr, "cooperative launch failed: %s (grid %d)\n", hipGetErrorString(e), grid);
}
```

```cpp
#include <hip/hip_runtime.h>
#include <hip/hip_cooperative_groups.h>
#include <cstdio>
#include <cstdint>
namespace cg = cooperative_groups;

#define LAS __attribute__((address_space(3)))
typedef unsigned short bf16_t;
typedef short bf16x8 __attribute__((ext_vector_type(8)));
typedef float f32x4 __attribute__((ext_vector_type(4)));
typedef float f32x2 __attribute__((ext_vector_type(2)));
typedef float f32x16 __attribute__((ext_vector_type(16)));
typedef unsigned u32x4 __attribute__((ext_vector_type(4)));
typedef unsigned u32x2 __attribute__((ext_vector_type(2)));
typedef __bf16 bf16x2n __attribute__((ext_vector_type(2)));

#define DI __device__ __forceinline__
DI unsigned pkbf(float lo, float hi) { f32x2 v = {lo, hi}; bf16x2n b = __builtin_convertvector(v, bf16x2n); return __builtin_bit_cast(unsigned, b); }
DI float bflo(unsigned u) { return __uint_as_float(u << 16); }
DI float bfhi(unsigned u) { return __uint_as_float(u & 0xffff0000u); }
DI int fresh_tid() { int t = threadIdx.x; asm volatile("" : "+v"(t)); return t; }
#define MFMA32(a, b, c) __builtin_amdgcn_mfma_f32_32x32x16_bf16((a), (b), (c), 0, 0, 0)

constexpr int M = 16384, D = 1024, SEQ = 4096, NBATCH = 4, DEPTH = 2;
constexpr int PC = 3072;
constexpr int FF = 2816;
constexpr int INC = 7168;
constexpr float RMS_EPS = 1e-6f, LN_EPS = 1e-5f;
constexpr float LOG2E = 1.4426950408889634f, LN2 = 0.6931471805599453f;
constexpr float SB_EXIT = 110.0f;

constexpr size_t MiB = (size_t)1 << 20;
constexpr size_t WS_WIN = 1 * MiB;
constexpr size_t WS_WB = 15 * MiB;
constexpr size_t WS_WOUT = 18 * MiB, WS_WQ = 20 * MiB, WS_WK = 22 * MiB, WS_WV = 24 * MiB, WS_WOX = 26 * MiB;
constexpr size_t WS_WGU = 28 * MiB;
constexpr size_t WS_WD = 39 * MiB;
constexpr size_t WS_MB = 45 * MiB, WS_MEMK = 47 * MiB, WS_MEMVT = 49 * MiB;
constexpr size_t WS_XB = 51 * MiB;
constexpr size_t WS_P = 83 * MiB;
constexpr size_t WS_T = 179 * MiB;
constexpr size_t WS_X2 = 211 * MiB;
constexpr size_t WS_SSP = 243 * MiB;
constexpr size_t WS_WK1 = 246 * MiB, WS_WV1 = 248 * MiB, WS_MB1 = 250 * MiB, WS_MEMK1 = 252 * MiB, WS_MEMVT1 = 254 * MiB;
constexpr size_t WS_END = 256 * MiB;

namespace pg8 {
constexpr int BM = 256, BK = 64, HALF = 128, HTB = HALF * BK * 2, STAGE_BYTES = 8 * HTB, NXCD = 8, WGM = 8;
DI int lds_byte(int r, int c) { const int st = (r >> 4) * 2 + (c >> 5), rr = r & 15, cc = c & 31, ob = rr * 64 + cc * 2; return st * 1024 + (ob ^ (((ob >> 9) & 1) << 5)); }
DI void stage_rc(int b, int& R, int& C) { const int st = b / 1024, sb = b % 1024, swz = sb ^ (((sb >> 9) & 1) << 5); R = (st >> 1) * 16 + swz / 64; C = (st & 1) * 32 + (swz % 64) / 2; }
DI int perm32(int rho) { const int n = rho >> 4, i = rho & 15; return 8 * (i >> 2) + 4 * n + (i & 3); }

struct Unit { int pm, pn; };
struct Gemm { const bf16_t* A; const bf16_t* Bt; int M, N, K, lda, ldb; };

struct StaticOrder {
    int nM, nN, nwg, G, c;
    DI void init(int M_, int N_, int G_, int c_) { nM = M_ / BM; nN = N_ / BM; nwg = nM * nN; G = G_; c = c_; }
    DI bool next(int i, Unit& u) const {
        const long L = (long)i * G + c; if (L >= nwg) return false;
        int wgid = (int)L; { const int q = nwg / NXCD, r = nwg % NXCD, xcd = wgid % NXCD, off = wgid / NXCD; wgid = (xcd < r ? xcd * (q + 1) : r * (q + 1) + (xcd - r) * q) + off; }
        const int nig = WGM * nN, gid = wgid / nig, fm = gid * WGM, gsz = (nM - fm) < WGM ? (nM - fm) : WGM;
        u.pm = fm + ((wgid % nig) % gsz); u.pn = (wgid % nig) / gsz; return true;
    }
};

DI f32x2 gelu_pk(f32x2 v) {
    const f32x2 av = __builtin_elementwise_abs(v), d = av * 0.2316418882f + 1.0f;
    f32x2 t; t.x = __builtin_amdgcn_rcpf(d.x); t.y = __builtin_amdgcn_rcpf(d.y);
    f32x2 q = t * 0.5307027145f + (-0.7265760135f); q = q * t + 0.7107068705f; q = q * t + (-0.142248368f); q = q * t + 0.127414796f; q = q * t;
    const f32x2 s = (v * v) * (-0.72134752044f);
    f32x2 e; e.x = __builtin_amdgcn_exp2f(s.x); e.y = __builtin_amdgcn_exp2f(s.y);
    const f32x2 m = v * (q * e), r = v - m;
    f32x2 o; o.x = v.x < 0.f ? m.x : r.x; o.y = v.y < 0.f ? m.y : r.y; return o;
}
DI f32x4 gelu4(f32x4 v) { f32x2 a = gelu_pk((f32x2){v[0], v[1]}), b = gelu_pk((f32x2){v[2], v[3]}); return (f32x4){a.x, a.y, b.x, b.y}; }
DI float sigmoidf_(float x) { return __builtin_amdgcn_rcpf(1.0f + __builtin_amdgcn_exp2f(-x * LOG2E)); }
DI f32x4 sigmoid4(f32x4 v) { return (f32x4){sigmoidf_(v[0]), sigmoidf_(v[1]), sigmoidf_(v[2]), sigmoidf_(v[3])}; }

DI float row_rs(const float* ssp, int row, int fq) {
    const f32x4 v = *(const f32x4*)(ssp + (size_t)row * 16 + fq * 4);
    float s = (v[0] + v[1]) + (v[2] + v[3]);
    s += __shfl_xor(s, 16); s += __shfl_xor(s, 32);
    return 1.0f / sqrtf(s * (1.0f / D) + RMS_EPS);
}

DI void row_rs8(const float* ssp, int row0, int fq, float (&rs)[2][4]) {
    f32x4 v[2][4];
#pragma unroll
    for (int ai = 0; ai < 2; ++ai)
#pragma unroll
        for (int m = 0; m < 4; ++m) v[ai][m] = *(const f32x4*)(ssp + (size_t)(row0 + ai * HALF + m * 16) * 16 + fq * 4);
    asm volatile("" ::: "memory");
#pragma unroll
    for (int ai = 0; ai < 2; ++ai)
#pragma unroll
        for (int m = 0; m < 4; ++m) { float s = (v[ai][m][0] + v[ai][m][1]) + (v[ai][m][2] + v[ai][m][3]); s += __shfl_xor(s, 16); s += __shfl_xor(s, 32); rs[ai][m] = 1.0f / sqrtf(s * (1.0f / D) + RMS_EPS); }
}

DI void row_rs8_lds(const LAS float* tab, int wr, int fr, float (&rs)[2][4]) {
#pragma unroll
    for (int ai = 0; ai < 2; ++ai)
#pragma unroll
        for (int m = 0; m < 4; ++m) rs[ai][m] = tab[ai * HALF + wr * 64 + m * 16 + fr];
}

enum { E_INPROJ = 0, E_TRANS = 1, E_GATE = 2, E_BR0 = 3, E_BRN = 4, E_RESID = 5, E_ROWSCALE = 6, E_SWIGLU = 7 };
struct EpiArgs {
    bf16_t* O; int ldc;
    const float* ssp;
    float cscale;
    const float* xsrc; float* xdst; bf16_t* xb; float* sspo;
    const bf16_t* G;
    const LAS float* rstab;
};
template <int MODE> struct Epi {
    static constexpr bool PERM = true;
    EpiArgs a;
    DI void store8(bf16_t* p, f32x4 v0, f32x4 v1) const { u32x4 w; w.x = pkbf(v0[0], v0[1]); w.y = pkbf(v0[2], v0[3]); w.z = pkbf(v1[0], v1[1]); w.w = pkbf(v1[2], v1[3]); *(u32x4*)p = w; }
    DI void operator()(const f32x4 (&acc)[2][2][4][2], const Unit& u, int wr, int wc, int fr, int fq) const {
        const int row0 = u.pm * BM + wr * 64 + fr, col0 = u.pn * BM + wc * 32 + 8 * fq;
        if constexpr (MODE == E_TRANS) {
            float rsc[2][8];
            if (a.rstab) {
#pragma unroll
                for (int bj = 0; bj < 2; ++bj) { const f32x4 t0 = *(const LAS f32x4*)(a.rstab + bj * HALF + wc * 32 + 8 * fq), t1 = *(const LAS f32x4*)(a.rstab + bj * HALF + wc * 32 + 8 * fq + 4);
                    rsc[bj][0] = t0[0]; rsc[bj][1] = t0[1]; rsc[bj][2] = t0[2]; rsc[bj][3] = t0[3]; rsc[bj][4] = t1[0]; rsc[bj][5] = t1[1]; rsc[bj][6] = t1[2]; rsc[bj][7] = t1[3]; }
            } else if (a.ssp) {
                const int lane = fq * 16 + fr, tok = u.pn * BM + (lane >> 5) * HALF + wc * 32 + (lane & 31);
                const f32x4* sp = (const f32x4*)(a.ssp + (size_t)tok * 16);
                const f32x4 s0 = sp[0], s1 = sp[1], s2 = sp[2], s3 = sp[3];
                const float s = ((s0[0] + s0[1]) + (s0[2] + s0[3])) + ((s1[0] + s1[1]) + (s1[2] + s1[3])) + ((s2[0] + s2[1]) + (s2[2] + s2[3])) + ((s3[0] + s3[1]) + (s3[2] + s3[3]));
                const float rs = 1.0f / sqrtf(s * (1.0f / D) + RMS_EPS);
#pragma unroll
                for (int bj = 0; bj < 2; ++bj)
#pragma unroll
                    for (int e = 0; e < 8; ++e) rsc[bj][e] = __shfl(rs, bj * 32 + 8 * fq + e);
            } else {
#pragma unroll
                for (int bj = 0; bj < 2; ++bj)
#pragma unroll
                    for (int e = 0; e < 8; ++e) rsc[bj][e] = 1.0f;
            }
            const bool act = a.ssp != nullptr && u.pm >= 2;
#pragma unroll
            for (int ai = 0; ai < 2; ++ai)
#pragma unroll
                for (int m = 0; m < 4; ++m) { bf16_t* rowp = a.O + (size_t)(row0 + ai * HALF + m * 16) * a.ldc + col0;
#pragma unroll
                    for (int bj = 0; bj < 2; ++bj) {
                        f32x4 v0 = acc[ai][bj][m][0], v1 = acc[ai][bj][m][1];
                        v0 = v0 * (f32x4){rsc[bj][0], rsc[bj][1], rsc[bj][2], rsc[bj][3]}; v1 = v1 * (f32x4){rsc[bj][4], rsc[bj][5], rsc[bj][6], rsc[bj][7]};
                        if (act) { v0 = gelu4(v0); v1 = gelu4(v1); }
                        store8(rowp + bj * HALF, v0, v1); } }
        } else if constexpr (MODE == E_RESID) {
#pragma unroll
            for (int ai = 0; ai < 2; ++ai) {
                u32x4 xw[4][2];
#pragma unroll
                for (int m = 0; m < 4; ++m)
#pragma unroll
                    for (int bj = 0; bj < 2; ++bj) xw[m][bj] = *(const u32x4*)(a.xb + (size_t)(row0 + ai * HALF + m * 16) * D + col0 + bj * HALF);
                asm volatile("" ::: "memory");
#pragma unroll
                for (int m = 0; m < 4; ++m) { const int row = row0 + ai * HALF + m * 16; const size_t off = (size_t)row * D + col0; float ss = 0.f;
#pragma unroll
                    for (int bj = 0; bj < 2; ++bj) { const u32x4 w = xw[m][bj];
                        const f32x4 v0 = (f32x4){bflo(w.x), bfhi(w.x), bflo(w.y), bfhi(w.y)} + acc[ai][bj][m][0], v1 = (f32x4){bflo(w.z), bfhi(w.z), bflo(w.w), bfhi(w.w)} + acc[ai][bj][m][1];
                        store8(a.xb + off + bj * HALF, v0, v1);
                        ss += (v0[0] * v0[0] + v0[1] * v0[1]) + (v0[2] * v0[2] + v0[3] * v0[3]) + (v1[0] * v1[0] + v1[1] * v1[1]) + (v1[2] * v1[2] + v1[3] * v1[3]); }
                    ss += __shfl_xor(ss, 16); ss += __shfl_xor(ss, 32);
                    if (fq == 0) a.sspo[(size_t)row * 16 + u.pn * 4 + wc] = ss; }
            }
        } else if constexpr (MODE == E_SWIGLU) {
            const int ocol = u.pn * HALF + wc * 32 + 8 * fq;
            float rs8[2][4]; if (a.rstab) row_rs8_lds(a.rstab, wr, fr, rs8); else row_rs8(a.ssp, row0, fq, rs8);
#pragma unroll
            for (int ai = 0; ai < 2; ++ai)
#pragma unroll
                for (int m = 0; m < 4; ++m) { const int row = row0 + ai * HALF + m * 16; const float rs = rs8[ai][m];
                    const f32x4 g0 = acc[ai][0][m][0] * rs, g1 = acc[ai][0][m][1] * rs, u0 = acc[ai][1][m][0] * rs, u1 = acc[ai][1][m][1] * rs;
                    store8(a.O + (size_t)row * a.ldc + ocol, g0 * sigmoid4(g0) * u0, g1 * sigmoid4(g1) * u1); }
        } else {
            float sc = a.cscale; bool gelu = false;
            if constexpr (MODE == E_INPROJ) { sc = (u.pn < 2) ? 0.125f : 1.0f; gelu = (u.pn == 4 || u.pn == 5); }
            if constexpr (MODE == E_INPROJ || MODE == E_GATE || MODE == E_ROWSCALE) {
                float rs8[2][4];
                if (a.rstab) row_rs8_lds(a.rstab, wr, fr, rs8); else if (a.ssp) row_rs8(a.ssp, row0, fq, rs8); else {
#pragma unroll
                    for (int ai = 0; ai < 2; ++ai)
#pragma unroll
                        for (int m = 0; m < 4; ++m) rs8[ai][m] = 1.0f; }
#pragma unroll
                for (int ai = 0; ai < 2; ++ai)
#pragma unroll
                    for (int m = 0; m < 4; ++m) { const int row = row0 + ai * HALF + m * 16; const float rs = sc * rs8[ai][m];
#pragma unroll
                        for (int bj = 0; bj < 2; ++bj) { const size_t off = (size_t)row * a.ldc + col0 + bj * HALF;
                            f32x4 v0 = acc[ai][bj][m][0] * rs, v1 = acc[ai][bj][m][1] * rs;
                            if constexpr (MODE == E_INPROJ) { if (gelu) { v0 = gelu4(v0); v1 = gelu4(v1); } }
                            else if constexpr (MODE == E_GATE) { v0 = sigmoid4(v0); v1 = sigmoid4(v1); }
                            store8(a.O + off, v0, v1); } }
            } else {
#pragma unroll
                for (int ai = 0; ai < 2; ++ai) {
                    u32x4 gw[4][2], pw[4][2];
#pragma unroll
                    for (int m = 0; m < 4; ++m)
#pragma unroll
                        for (int bj = 0; bj < 2; ++bj) { const size_t off = (size_t)(row0 + ai * HALF + m * 16) * a.ldc + col0 + bj * HALF;
                            gw[m][bj] = *(const u32x4*)(a.G + off); if constexpr (MODE == E_BRN) pw[m][bj] = *(const u32x4*)(a.O + off); }
                    asm volatile("" ::: "memory");
#pragma unroll
                    for (int m = 0; m < 4; ++m)
#pragma unroll
                        for (int bj = 0; bj < 2; ++bj) { const size_t off = (size_t)(row0 + ai * HALF + m * 16) * a.ldc + col0 + bj * HALF; const u32x4 g = gw[m][bj];
                            f32x4 v0 = acc[ai][bj][m][0] * (f32x4){bflo(g.x), bfhi(g.x), bflo(g.y), bfhi(g.y)}, v1 = acc[ai][bj][m][1] * (f32x4){bflo(g.z), bfhi(g.z), bflo(g.w), bfhi(g.w)};
                            if constexpr (MODE == E_BRN) { const u32x4 q = pw[m][bj];
                                v0 = v0 + (f32x4){bflo(q.x), bfhi(q.x), bflo(q.y), bfhi(q.y)}; v1 = v1 + (f32x4){bflo(q.z), bfhi(q.z), bflo(q.w), bfhi(q.w)}; }
                            store8(a.O + off, v0, v1); }
                }
            }
        }
    }
};

template <class EpiT>
DI void gemm_phase(LAS unsigned char* lds, const Gemm g, const StaticOrder& S, const EpiT& E) {
    const int tid = fresh_tid(), wid = __builtin_amdgcn_readfirstlane(tid >> 6), lane = tid & 63, wr = wid >> 2, wc = wid & 3, fr = lane & 15, fq = lane >> 4;
    const int nt = g.K / BK;
    unsigned voffA[2], voffB[2];
#pragma unroll
    for (int i = 0; i < 2; ++i) { int R, C; stage_rc(tid * 16 + i * 8192, R, C); const int Rb = EpiT::PERM ? ((R & ~31) + perm32(R & 31)) : R;
        voffA[i] = (unsigned)(R * g.lda + C) * 2u; voffB[i] = (unsigned)(Rb * g.ldb + C) * 2u; }
    const size_t kstep = (size_t)(BK * 2);
    const size_t hstepA = (size_t)HALF * g.lda * 2, hstepB = (size_t)HALF * g.ldb * 2;
    const size_t tstepA = 2 * hstepA, tstepB = 2 * hstepB;
    const unsigned ldsw = (unsigned)wid * 1024u;
    const int aoff = lds_byte(wr * 64 + fr, fq * 8), boff = lds_byte(wc * 32 + fr, fq * 8);
#define PG8_SA(b, h) (((b) * 2 + (h)) * HTB)
#define PG8_SB(b, h) ((4 + (b) * 2 + (h)) * HTB)
#define PG8_STAGE(bufoff, gbase, voff) do { _Pragma("unroll") for (int _i = 0; _i < 2; ++_i) \
        __builtin_amdgcn_global_load_lds((const unsigned*)((const char*)(gbase) + (voff)[_i]), (LAS unsigned*)(lds + (bufoff) + ldsw + _i * 8192), 16, 0, 0); } while (0)
#define PG8_LDA(dst, b, h) do { _Pragma("unroll") for (int m = 0; m < 4; ++m) _Pragma("unroll") for (int k = 0; k < 2; ++k) dst[m][k] = *(const LAS bf16x8*)(lds + PG8_SA(b, h) + aoff + m * 2048 + k * 1024); } while (0)
#define PG8_LDB(dst, b, h) do { _Pragma("unroll") for (int n = 0; n < 2; ++n) _Pragma("unroll") for (int k = 0; k < 2; ++k) dst[n][k] = *(const LAS bf16x8*)(lds + PG8_SB(b, h) + boff + n * 2048 + k * 1024); } while (0)
#define PG8_MMA(ai, bj, At, Bt) do { __builtin_amdgcn_s_setprio(1); _Pragma("unroll") for (int m = 0; m < 4; ++m) _Pragma("unroll") for (int n = 0; n < 2; ++n) _Pragma("unroll") for (int k = 0; k < 2; ++k) \
        acc[ai][bj][m][n] = __builtin_amdgcn_mfma_f32_16x16x32_bf16(Bt[n][k], At[m][k], acc[ai][bj][m][n], 0, 0, 0); __builtin_amdgcn_s_setprio(0); } while (0)
#define PG8_WAIT_V(n) asm volatile("s_waitcnt vmcnt(" #n ")" ::: "memory")
#define PG8_WAIT_L(n) asm volatile("s_waitcnt lgkmcnt(" #n ")" ::: "memory")
#define PG8_BAR __builtin_amdgcn_s_barrier()
#define PG8_SCHED __builtin_amdgcn_sched_barrier(0)
    Unit cur, nxt; int ui = 0;
    if (!S.next(0, cur)) return;
    f32x4 acc[2][2][4][2];
#pragma unroll
    for (int a = 0; a < 2; ++a)
#pragma unroll
        for (int b = 0; b < 2; ++b)
#pragma unroll
            for (int m = 0; m < 4; ++m)
#pragma unroll
                for (int n = 0; n < 2; ++n) acc[a][b][m][n] = (f32x4){0.f, 0.f, 0.f, 0.f};
    bf16x8 At[4][2], B0[2][2], B1[2][2];
    const char* cA = (const char*)g.A + (size_t)cur.pm * tstepA; const char* cB = (const char*)g.Bt + (size_t)cur.pn * tstepB;
    PG8_STAGE(PG8_SB(0, 0), cB, voffB); PG8_STAGE(PG8_SB(0, 1), cB + hstepB, voffB); PG8_STAGE(PG8_SA(0, 0), cA, voffA); PG8_STAGE(PG8_SA(0, 1), cA + hstepA, voffA);
    if (wr == 1) PG8_BAR;
    PG8_WAIT_V(2); PG8_BAR;
    PG8_STAGE(PG8_SB(1, 0), cB + kstep, voffB); PG8_STAGE(PG8_SA(1, 0), cA + kstep, voffA); PG8_STAGE(PG8_SB(1, 1), cB + hstepB + kstep, voffB);
    PG8_WAIT_V(6); PG8_BAR;
    for (;;) {
        const bool has_next = S.next(ui + 1, nxt);
        const char* nA = has_next ? (const char*)g.A + (size_t)nxt.pm * tstepA : cA; const char* nB = has_next ? (const char*)g.Bt + (size_t)nxt.pn * tstepB : cB;
        for (int t = 0; t < nt; t += 2) {
            const bool last = (t == nt - 2);
            const char* a1 = cA + (size_t)(t + 1) * kstep;
            const char* a2 = last ? nA : cA + (size_t)(t + 2) * kstep; const char* b2 = last ? nB : cB + (size_t)(t + 2) * kstep;
            const char* a3 = a2 + kstep; const char* b3 = b2 + kstep;
            PG8_LDB(B0, 0, 0); PG8_LDB(B1, 0, 1); PG8_SCHED; PG8_LDA(At, 0, 0); PG8_STAGE(PG8_SA(1, 1), a1 + hstepA, voffA);
            PG8_WAIT_V(8); PG8_WAIT_L(0); PG8_BAR; PG8_MMA(0, 0, At, B0); PG8_MMA(0, 1, At, B1); PG8_BAR; PG8_SCHED;
            PG8_LDA(At, 0, 1); PG8_STAGE(PG8_SB(0, 0), b2, voffB); PG8_STAGE(PG8_SB(0, 1), b2 + hstepB, voffB); PG8_STAGE(PG8_SA(0, 0), a2, voffA);
            PG8_WAIT_V(8); PG8_WAIT_L(0); PG8_BAR; PG8_MMA(1, 0, At, B0); PG8_MMA(1, 1, At, B1); PG8_BAR; PG8_SCHED;
            PG8_LDB(B0, 1, 0); PG8_LDB(B1, 1, 1); PG8_SCHED; PG8_LDA(At, 1, 0); PG8_STAGE(PG8_SA(0, 1), a2 + hstepA, voffA);
            PG8_WAIT_V(8); PG8_WAIT_L(0); PG8_BAR; PG8_MMA(0, 0, At, B0); PG8_MMA(0, 1, At, B1); PG8_BAR; PG8_SCHED;
            PG8_LDA(At, 1, 1); PG8_STAGE(PG8_SB(1, 0), b3, voffB); PG8_STAGE(PG8_SB(1, 1), b3 + hstepB, voffB); PG8_STAGE(PG8_SA(1, 0), a3, voffA);
            PG8_WAIT_V(8); PG8_WAIT_L(0); PG8_BAR; PG8_MMA(1, 0, At, B0); PG8_MMA(1, 1, At, B1); PG8_BAR; PG8_SCHED;
        }
        if (wr == 0) PG8_BAR;
        E(acc, cur, wr, wc, fr, fq);
        if (!has_next) break;
#pragma unroll
        for (int a = 0; a < 2; ++a)
#pragma unroll
            for (int b = 0; b < 2; ++b)
#pragma unroll
                for (int m = 0; m < 4; ++m)
#pragma unroll
                    for (int n = 0; n < 2; ++n) acc[a][b][m][n] = (f32x4){0.f, 0.f, 0.f, 0.f};
        cur = nxt; cA = nA; cB = nB; ++ui;
        if (wr == 1) PG8_BAR;
    }
    PG8_WAIT_V(0);
    PG8_BAR;

}

struct UnitX { int pm, pn, job, k; };
struct JobP { const bf16_t* A; const bf16_t* Bt; int lda, ldb, nt; };
template <class Prog>
DI void gemm_stream(LAS unsigned char* lds, Prog& P) {
    const int tid = fresh_tid(), wid = __builtin_amdgcn_readfirstlane(tid >> 6), lane = tid & 63, wr = wid >> 2, wc = wid & 3, fr = lane & 15, fq = lane >> 4;
    const size_t kstep = (size_t)(BK * 2);
    const unsigned ldsw = (unsigned)wid * 1024u;
    const int aoff = lds_byte(wr * 64 + fr, fq * 8), boff = lds_byte(wc * 32 + fr, fq * 8);
#define PG8_VOFF(vA, vB, j) do { _Pragma("unroll") for (int _i = 0; _i < 2; ++_i) { int sR_, sC_; stage_rc(tid * 16 + _i * 8192, sR_, sC_); const int sRb_ = (sR_ & ~31) + perm32(sR_ & 31); \
        vA[_i] = (unsigned)(sR_ * (j).lda + sC_) * 2u; vB[_i] = (unsigned)(sRb_ * (j).ldb + sC_) * 2u; } } while (0)
    UnitX cur, nxt;
    if (!P.next(cur)) return;
    JobP jc = P.job(cur.job);
    unsigned voffA[2], voffB[2], voffAn[2], voffBn[2];
    PG8_VOFF(voffA, voffB, jc);
    unsigned hstepA = (unsigned)(HALF * jc.lda * 2), hstepB = (unsigned)(HALF * jc.ldb * 2), hstepAn, hstepBn;
    int nt = jc.nt;
    f32x4 acc[2][2][4][2];
#pragma unroll
    for (int a = 0; a < 2; ++a)
#pragma unroll
        for (int b = 0; b < 2; ++b)
#pragma unroll
            for (int m = 0; m < 4; ++m)
#pragma unroll
                for (int n = 0; n < 2; ++n) acc[a][b][m][n] = (f32x4){0.f, 0.f, 0.f, 0.f};
    bf16x8 At[4][2], B0[2][2], B1[2][2];
    const char* cA = (const char*)jc.A + (size_t)cur.pm * 2 * hstepA; const char* cB = (const char*)jc.Bt + (size_t)cur.pn * 2 * hstepB;
    PG8_STAGE(PG8_SB(0, 0), cB, voffB); PG8_STAGE(PG8_SB(0, 1), cB + hstepB, voffB); PG8_STAGE(PG8_SA(0, 0), cA, voffA); PG8_STAGE(PG8_SA(0, 1), cA + hstepA, voffA);
    if (wr == 1) PG8_BAR;
    PG8_WAIT_V(2); PG8_BAR;
    PG8_STAGE(PG8_SB(1, 0), cB + kstep, voffB); PG8_STAGE(PG8_SA(1, 0), cA + kstep, voffA); PG8_STAGE(PG8_SB(1, 1), cB + hstepB + kstep, voffB);
    PG8_WAIT_V(6); PG8_BAR;
    for (;;) {
        const bool has_next = P.next(nxt);
        const char* nA = cA; const char* nB = cB; int ntn = nt;
        hstepAn = hstepA; hstepBn = hstepB; voffAn[0] = voffA[0]; voffAn[1] = voffA[1]; voffBn[0] = voffB[0]; voffBn[1] = voffB[1];
        if (has_next) { const JobP jn = P.job(nxt.job); PG8_VOFF(voffAn, voffBn, jn); hstepAn = (unsigned)(HALF * jn.lda * 2); hstepBn = (unsigned)(HALF * jn.ldb * 2); ntn = jn.nt;
            nA = (const char*)jn.A + (size_t)nxt.pm * 2 * hstepAn; nB = (const char*)jn.Bt + (size_t)nxt.pn * 2 * hstepBn; }
        for (int t = 0; t < nt; t += 2) {
            const bool last = (t == nt - 2);
            const char* a1 = cA + (size_t)(t + 1) * kstep;
            const char* a2 = last ? nA : cA + (size_t)(t + 2) * kstep; const char* b2 = last ? nB : cB + (size_t)(t + 2) * kstep;
            const char* a3 = a2 + kstep; const char* b3 = b2 + kstep;
            const unsigned hA2 = last ? hstepAn : hstepA, hB2 = last ? hstepBn : hstepB;
            unsigned vA2[2], vB2[2];
            vA2[0] = last ? voffAn[0] : voffA[0]; vA2[1] = last ? voffAn[1] : voffA[1]; vB2[0] = last ? voffBn[0] : voffB[0]; vB2[1] = last ? voffBn[1] : voffB[1];
            PG8_LDB(B0, 0, 0); PG8_LDB(B1, 0, 1); PG8_SCHED; PG8_LDA(At, 0, 0); PG8_STAGE(PG8_SA(1, 1), a1 + hstepA, voffA);
            PG8_WAIT_V(8); PG8_WAIT_L(0); PG8_BAR; PG8_MMA(0, 0, At, B0); PG8_MMA(0, 1, At, B1); PG8_BAR; PG8_SCHED;
            PG8_LDA(At, 0, 1); PG8_STAGE(PG8_SB(0, 0), b2, vB2); PG8_STAGE(PG8_SB(0, 1), b2 + hB2, vB2); PG8_STAGE(PG8_SA(0, 0), a2, vA2);
            PG8_WAIT_V(8); PG8_WAIT_L(0); PG8_BAR; PG8_MMA(1, 0, At, B0); PG8_MMA(1, 1, At, B1); PG8_BAR; PG8_SCHED;
            PG8_LDB(B0, 1, 0); PG8_LDB(B1, 1, 1); PG8_SCHED; PG8_LDA(At, 1, 0); PG8_STAGE(PG8_SA(0, 1), a2 + hA2, vA2);
            PG8_WAIT_V(8); PG8_WAIT_L(0); PG8_BAR; PG8_MMA(0, 0, At, B0); PG8_MMA(0, 1, At, B1); PG8_BAR; PG8_SCHED;
            PG8_LDA(At, 1, 1); PG8_STAGE(PG8_SB(1, 0), b3, vB2); PG8_STAGE(PG8_SB(1, 1), b3 + hB2, vB2); PG8_STAGE(PG8_SA(1, 0), a3, vA2);
            PG8_WAIT_V(8); PG8_WAIT_L(0); PG8_BAR; PG8_MMA(1, 0, At, B0); PG8_MMA(1, 1, At, B1); PG8_BAR; PG8_SCHED;
        }
        if (wr == 0) PG8_BAR;
        P.epilogue(acc, cur, wr, wc, fr, fq);
        if (!has_next) break;
#pragma unroll
        for (int a = 0; a < 2; ++a)
#pragma unroll
            for (int b = 0; b < 2; ++b)
#pragma unroll
                for (int m = 0; m < 4; ++m)
#pragma unroll
                    for (int n = 0; n < 2; ++n) acc[a][b][m][n] = (f32x4){0.f, 0.f, 0.f, 0.f};
        cur = nxt; cA = nA; cB = nB; nt = ntn; hstepA = hstepAn; hstepB = hstepBn; voffA[0] = voffAn[0]; voffA[1] = voffAn[1]; voffB[0] = voffBn[0]; voffB[1] = voffBn[1];
        if (wr == 1) PG8_BAR;
    }
    PG8_WAIT_V(0);
    PG8_BAR;
#undef PG8_VOFF
}
#undef PG8_SA
#undef PG8_SB
#undef PG8_STAGE
#undef PG8_LDA
#undef PG8_LDB
#undef PG8_MMA
#undef PG8_WAIT_V
#undef PG8_WAIT_L
#undef PG8_BAR
#undef PG8_SCHED
}

constexpr int NWAVES = 8, NTHREADS = 512;
constexpr int LDS_BYTES = 147456;

DI float wave_sum(float v) {
#pragma unroll
    for (int o = 1; o < 64; o <<= 1) v += __shfl_xor(v, o);
    return v;
}

DI void transpose_item(const float* W, int K, int N, const float* gk, bf16_t* WT, int dst_row0, int k0, int n0, LAS float* scr, int lane) {
    f32x4 wv[8]; float gv[8];
#pragma unroll
    for (int i = 0; i < 8; ++i) { const int kk = 8 * i + (lane >> 3), nq = (lane & 7) * 4; wv[i] = *(const f32x4*)(W + (size_t)(k0 + kk) * N + n0 + nq); gv[i] = gk ? gk[k0 + kk] : 1.0f; }
    asm volatile("" ::: "memory");
#pragma unroll
    for (int i = 0; i < 8; ++i) { const int kk = 8 * i + (lane >> 3), nq = (lane & 7) * 4; const f32x4 w = wv[i] * gv[i];
        LAS float* d = scr + kk * 33 + nq; d[0] = w[0]; d[1] = w[1]; d[2] = w[2]; d[3] = w[3]; }
    asm volatile("s_waitcnt lgkmcnt(0)" ::: "memory");
    const int c = lane & 7;
#pragma unroll
    for (int j = 0; j < 4; ++j) { const int n = (lane >> 3) + 8 * j; const LAS float* s = scr + (8 * c) * 33 + n;
        u32x4 o; o.x = pkbf(s[0 * 33], s[1 * 33]); o.y = pkbf(s[2 * 33], s[3 * 33]); o.z = pkbf(s[4 * 33], s[5 * 33]); o.w = pkbf(s[6 * 33], s[7 * 33]);
        *(u32x4*)(WT + (size_t)(dst_row0 + n) * K + k0 + 8 * c) = o; }
    asm volatile("s_waitcnt lgkmcnt(0)" ::: "memory");
}

struct Args { const float* in[22]; float* out; unsigned char* ws; };
constexpr int PTR_OFF = 131072;
DI unsigned long long ldq(LAS unsigned char* lds, int i) {
    unsigned off = (unsigned)(PTR_OFF + 8 * i); asm volatile("" : "+v"(off));
    const unsigned long long v = *(const LAS unsigned long long*)(lds + off);
    const unsigned lo = __builtin_amdgcn_readfirstlane((unsigned)v), hi = __builtin_amdgcn_readfirstlane((unsigned)(v >> 32));
    return ((unsigned long long)hi << 32) | lo;
}
#define GAS __attribute__((address_space(1)))
#define INP(i) ((const float*)(const GAS float*)ldq(lds, (i)))
#define OUTP ((float*)(GAS float*)ldq(lds, 22))
#define WSP ((unsigned char*)(GAS unsigned char*)ldq(lds, 23))

DI void prep_weights(int l, LAS unsigned char* lds, int gw, int NGW, int wave, int lane, int part = 0) {
    LAS float* scr = (LAS float*)(lds + wave * 16384);
    unsigned char* ws = WSP;
    constexpr int I_IN = 16 * 224, I_BR = 8 * 32, I_SQ = 16 * 32, I_GU = 16 * 88, I_DN = 44 * 32;
    constexpr int NSQ = 7; constexpr int NITEMS = I_IN + 3 * I_BR + NSQ * I_SQ + 2 * I_GU + I_DN;
    const int it_lo = part == 2 ? NITEMS - I_DN : 0, it_hi = part == 1 ? NITEMS - I_DN : NITEMS;
    for (int it = it_lo + gw; it < it_hi; it += NGW) {
        int r = it;
        if (r < I_IN) { const int kb = r / 224, nb = r % 224, n0 = nb * 32, seg = n0 >> 9;
            int base;
            switch (seg) { case 0: base = 0; break; case 1: base = 512; break; case 2: base = 3072; break; case 3: base = 1024; break; case 4: base = 3584; break;
                           case 5: base = 1536; break; case 6: base = 2048; break; case 7: base = 2560; break; default: base = seg * 512; break; }
            transpose_item(INP(3) + (size_t)l * D * INC, D, INC, INP(2) + l * D, (bf16_t*)(ws + WS_WIN), base + (n0 & 511), kb * 64, n0, scr, lane); continue; }
        r -= I_IN;
        if (r < 3 * I_BR) { const int n = r / I_BR, q = r % I_BR, kb = q / 32, nb = q % 32;
            transpose_item(INP(9) + ((size_t)l * 3 + n) * 512 * D, 512, D, nullptr, (bf16_t*)(ws + WS_WB) + (size_t)n * D * 512, nb * 32, kb * 64, nb * 32, scr, lane); continue; }
        r -= 3 * I_BR;
        if (r < NSQ * I_SQ) { const int w = r / I_SQ, q = r % I_SQ, kb = q / 32, nb = q % 32;
            const float* src; const float* gk = nullptr; size_t dst;
            if (l == 0 && w >= 5) {
                transpose_item(INP(w == 5 ? 14 : 15) + (size_t)D * D, D, D, nullptr, (bf16_t*)(ws + (w == 5 ? WS_WK1 : WS_WV1)), nb * 32, kb * 64, nb * 32, scr, lane); continue; }
            if (w >= 5 || (l == 1 && (w == 2 || w == 3))) continue;
            switch (w) { case 0: src = INP(10); dst = WS_WOUT; break; case 1: src = INP(13); dst = WS_WQ; gk = INP(11) + l * D; break; case 2: src = INP(14); dst = WS_WK; break;
                         case 3: src = INP(15); dst = WS_WV; break; default: src = INP(16); dst = WS_WOX; break; }
            transpose_item(src + (size_t)l * D * D, D, D, gk, (bf16_t*)(ws + dst), nb * 32, kb * 64, nb * 32, scr, lane); continue; }
        r -= NSQ * I_SQ;
        if (r < 2 * I_GU) { const int w = r / I_GU, q = r % I_GU, kb = q / 88, nb = q % 88, n0 = nb * 32;
            transpose_item(INP(18 + w) + (size_t)l * D * FF, D, FF, INP(17) + l * D, (bf16_t*)(ws + WS_WGU), (n0 >> 7) * 256 + w * 128 + (n0 & 127), kb * 64, n0, scr, lane); continue; }
        r -= 2 * I_GU;
        { const int kb = r / 32, nb = r % 32;
          transpose_item(INP(20) + (size_t)l * FF * D, FF, D, nullptr, (bf16_t*)(ws + WS_WD), nb * 32, kb * 64, nb * 32, scr, lane); }
    }
    if (l == 0) {
        for (int row2 = gw; row2 < 2 * NBATCH * 256; row2 += NGW) {
            const int lay = row2 >> 10, row = row2 & 1023; const float* mg = INP(12) + lay * D;
            const f32x4* xr = (const f32x4*)(INP(1) + (size_t)row * D) + lane; f32x4 v[4]; float s = 0.f;
#pragma unroll
            for (int j = 0; j < 4; ++j) { v[j] = xr[64 * j]; s += (v[j][0] * v[j][0] + v[j][1] * v[j][1]) + (v[j][2] * v[j][2] + v[j][3] * v[j][3]); }
            const float rs = 1.0f / sqrtf(wave_sum(s) * (1.0f / D) + RMS_EPS);
            u32x2* o = (u32x2*)((bf16_t*)(ws + (lay ? WS_MB1 : WS_MB)) + (size_t)row * D) + lane;
#pragma unroll
            for (int j = 0; j < 4; ++j) { const f32x4 gv = *((const f32x4*)mg + lane + 64 * j); u32x2 w; w.x = pkbf(v[j][0] * rs * gv[0], v[j][1] * rs * gv[1]); w.y = pkbf(v[j][2] * rs * gv[2], v[j][3] * rs * gv[3]); o[64 * j] = w; }
        }
    }
}

DI void prep_x(LAS unsigned char* lds, int gw, int NGW, int lane) {
    unsigned char* ws = WSP; const float* xin = INP(0);
    float* ssp = (float*)(ws + WS_SSP);
    for (int row = gw; row < M; row += NGW) {
        const f32x4* xr = (const f32x4*)(xin + (size_t)row * D) + lane; f32x4 v[4]; float s = 0.f;
#pragma unroll
        for (int j = 0; j < 4; ++j) { v[j] = xr[64 * j]; s += (v[j][0] * v[j][0] + v[j][1] * v[j][1]) + (v[j][2] * v[j][2] + v[j][3] * v[j][3]); }
        s = wave_sum(s);
        u32x2* o = (u32x2*)((bf16_t*)(ws + WS_XB) + (size_t)row * D) + lane;
#pragma unroll
        for (int j = 0; j < 4; ++j) { u32x2 w; w.x = pkbf(v[j][0], v[j][1]); w.y = pkbf(v[j][2], v[j][3]); o[64 * j] = w; }
        if (lane < 16) ssp[(size_t)row * 16 + lane] = lane == 0 ? s : 0.f;
    }
}

DI void final_norm(LAS unsigned char* lds, int gw, int NGW, int lane) {
    const float* fg = INP(21); float* outp = OUTP; const float* ssp = (const float*)(WSP + WS_SSP);
    for (int row = gw; row < M; row += NGW) {
        f32x4* xr = (f32x4*)(outp + (size_t)row * D) + lane; const u32x2* xbr = (const u32x2*)((const bf16_t*)(WSP + WS_XB) + (size_t)row * D) + lane;
        float s = lane < 16 ? ssp[(size_t)row * 16 + lane] : 0.f; s = wave_sum(s);
        const float rs = 1.0f / sqrtf(s * (1.0f / D) + RMS_EPS);
#pragma unroll
        for (int j = 0; j < 4; ++j) { const f32x4 gv = *((const f32x4*)fg + lane + 64 * j); const u32x2 w = xbr[64 * j]; xr[64 * j] = (f32x4){bflo(w.x), bfhi(w.x), bflo(w.y), bfhi(w.y)} * rs * gv; }
    }
}

DI void sb_attn_item(bf16_t* p, const bf16_t* T, int item, int lane) {
    const int b = item >> 10, h = (item >> 7) & 7, qb = item & 127;
    const int hl = lane >> 5, li = lane & 31;
    const size_t rowbase = (size_t)b * SEQ;
    const int kperm = (li & 16) | ((li & 4) << 1) | ((li & 8) >> 1) | (li & 3);
    const bf16_t* qrow = p + (rowbase + qb * 32 + li) * PC + h * 64 + 8 * hl;
    bf16x8 qf[4];
#pragma unroll
    for (int kk = 0; kk < 4; ++kk) qf[kk] = *(const bf16x8*)(qrow + 16 * kk);
    bf16x8 U[2];
#pragma unroll
    for (int c = 0; c < 2; ++c)
#pragma unroll
        for (int e = 0; e < 8; ++e) U[c][e] = (16 * c + 8 * hl + e >= kperm) ? (short)0x3f80 : (short)0;
    f32x16 o0, o1;
#pragma unroll
    for (int r = 0; r < 16; ++r) { o0[r] = 0.f; o1[r] = 0.f; }
    float carry = 0.f;
    const bf16_t* vt0 = T + (size_t)(h * 64 + li) * M + rowbase + 8 * hl;
    for (int kb = qb; kb >= 0; --kb) {
        const int s0 = kb * 32;
        const bf16_t* krow = p + (rowbase + s0 + kperm) * PC + 512 + h * 64 + 8 * hl;
        bf16x8 kf[4], vf[4];
#pragma unroll
        for (int kk = 0; kk < 4; ++kk) kf[kk] = *(const bf16x8*)(krow + 16 * kk);
#pragma unroll
        for (int c = 0; c < 2; ++c) { vf[c] = *(const bf16x8*)(vt0 + s0 + 16 * c); vf[2 + c] = *(const bf16x8*)(vt0 + (size_t)32 * M + s0 + 16 * c); }
        f32x16 z;
#pragma unroll
        for (int r = 0; r < 16; ++r) z[r] = 0.f;
#pragma unroll
        for (int kk = 0; kk < 4; ++kk) z = MFMA32(kf[kk], qf[kk], z);
        const bool diag = (kb == qb);
        float Lv[16];
#pragma unroll
        for (int r = 0; r < 16; ++r) {
            const float zz = z[r];
            float L = fmaxf(zz, 0.f) + LN2 * __builtin_amdgcn_logf(1.0f + __builtin_amdgcn_exp2f(-fabsf(zz) * LOG2E));
            if (diag && !(16 * (r >> 3) + 8 * hl + (r & 7) < li)) L = 0.f;
            Lv[r] = L;
        }
        bf16x8 Lh[2], Ll[2];
#pragma unroll
        for (int c = 0; c < 2; ++c) { u32x4 wh, wl;
#pragma unroll
            for (int e = 0; e < 4; ++e) { const float a0 = Lv[8 * c + 2 * e], a1 = Lv[8 * c + 2 * e + 1]; const unsigned hp = pkbf(a0, a1); wh[e] = hp; wl[e] = pkbf(a0 - bflo(hp), a1 - bfhi(hp)); }
            Lh[c] = __builtin_bit_cast(bf16x8, wh); Ll[c] = __builtin_bit_cast(bf16x8, wl); }
        f32x16 C;
#pragma unroll
        for (int r = 0; r < 16; ++r) C[r] = carry;
        C = MFMA32(U[0], Lh[0], C); C = MFMA32(U[1], Lh[1], C); C = MFMA32(U[0], Ll[0], C); C = MFMA32(U[1], Ll[1], C);
        bf16x8 pf[2];
#pragma unroll
        for (int c = 0; c < 2; ++c) { u32x4 w;
#pragma unroll
            for (int e = 0; e < 4; ++e) { float a0, a1; { const int r = 8 * c + 2 * e; a0 = __builtin_amdgcn_exp2f((z[r] - C[r]) * LOG2E); a1 = __builtin_amdgcn_exp2f((z[r + 1] - C[r + 1]) * LOG2E);
                    if (diag) { if (!(16 * c + 8 * hl + 2 * e < li)) a0 = 0.f; if (!(16 * c + 8 * hl + 2 * e + 1 < li)) a1 = 0.f; } }
                w[e] = pkbf(a0, a1); }
            pf[c] = __builtin_bit_cast(bf16x8, w); }
        carry = __shfl(C[0], li);
        o0 = MFMA32(vf[0], pf[0], o0); o0 = MFMA32(vf[1], pf[1], o0);
        o1 = MFMA32(vf[2], pf[0], o1); o1 = MFMA32(vf[3], pf[1], o1);
        if (__all(carry > SB_EXIT)) break;
    }
    bf16_t* orow = p + (rowbase + qb * 32 + li) * PC + h * 64 + 4 * hl;
#pragma unroll
    for (int g = 0; g < 4; ++g) {
        u32x2 w0, w1; w0.x = pkbf(o0[4 * g], o0[4 * g + 1]); w0.y = pkbf(o0[4 * g + 2], o0[4 * g + 3]); w1.x = pkbf(o1[4 * g], o1[4 * g + 1]); w1.y = pkbf(o1[4 * g + 2], o1[4 * g + 3]);
        *(u32x2*)(orow + 8 * g) = w0; *(u32x2*)(orow + 32 + 8 * g) = w1; }
}

DI void sgu_item(int l, bf16_t* p, const bf16_t* T, int item, LAS unsigned char* lds, int tid, int wave, int lane) {
    const int g = item & 3, n = (item >> 2) & 31, b = item >> 7;
    const size_t tok0 = (size_t)b * SEQ + n * 128;
    const bf16_t* zv = T + (size_t)512 * M;
    LAS float* red = (LAS float*)lds;
    LAS float* mean = (LAS float*)(lds + 8192);
    LAS float* rstd = (LAS float*)(lds + 8192 + 512);
    {
        float s0 = 0.f, s1 = 0.f, q0 = 0.f, q1 = 0.f;
        const bf16_t* src = zv + (size_t)(wave * 64) * M + tok0 + 2 * lane;
#pragma unroll 1
        for (int jb = 0; jb < 64; jb += 16) {
            unsigned wv[16];
#pragma unroll
            for (int j = 0; j < 16; ++j) wv[j] = *(const unsigned*)(src + (size_t)(jb + j) * M);
            asm volatile("" ::: "memory");
#pragma unroll
            for (int j = 0; j < 16; ++j) { const float a0 = bflo(wv[j]), a1 = bfhi(wv[j]); s0 += a0; s1 += a1; q0 += a0 * a0; q1 += a1 * a1; }
        }
        *(LAS f32x4*)(red + (wave * 64 + lane) * 4) = (f32x4){s0, q0, s1, q1};
    }
    __syncthreads();
    if (tid < 128) { float s = 0.f, q = 0.f;
#pragma unroll
        for (int w = 0; w < 8; ++w) { const f32x2 v = *(LAS f32x2*)(red + (w * 64 + (tid >> 1)) * 4 + (tid & 1) * 2); s += v.x; q += v.y; }
        const float mu = s * (1.0f / 512.0f), var = fmaxf(q * (1.0f / 512.0f) - mu * mu, 0.f);
        mean[tid] = mu; rstd[tid] = 1.0f / sqrtf(var + LN_EPS); }
    __syncthreads();
    const int cblk = wave & 3, th = wave >> 2, hl = lane >> 5, li = lane & 31;
    const int cch = g * 128 + cblk * 32 + li;
    const float lg = INP(4)[l * 512 + cch], lb = INP(5)[l * 512 + cch];
    const bf16_t* arow = zv + (size_t)cch * M + tok0 + 8 * hl;
    const float* wsp = INP(6) + ((size_t)(l * 4 + g) * 128) * 128;
    f32x16 acc0, acc1;
#pragma unroll
    for (int r = 0; r < 16; ++r) { acc0[r] = 0.f; acc1[r] = 0.f; }
#pragma unroll
    for (int hf = 0; hf < 2; ++hf) if (hf == 0 || th) {
        u32x4 raw[4]; f32x4 wv[4][2][2];
#pragma unroll
        for (int k4 = 0; k4 < 4; ++k4) { const int kk = 4 * hf + k4, sb = 16 * kk + 8 * hl;
            raw[k4] = *(const u32x4*)(arow + 16 * kk);
#pragma unroll
            for (int tb = 0; tb < 2; ++tb) { const int t = th * 64 + tb * 32 + li; wv[k4][tb][0] = *(const f32x4*)(wsp + (size_t)t * 128 + sb); wv[k4][tb][1] = *(const f32x4*)(wsp + (size_t)t * 128 + sb + 4); } }
        asm volatile("" ::: "memory");
#pragma unroll
        for (int k4 = 0; k4 < 4; ++k4) { const int kk = 4 * hf + k4, sb = 16 * kk + 8 * hl;
            const f32x4 m0 = *(LAS f32x4*)(mean + sb), m1 = *(LAS f32x4*)(mean + sb + 4), r0 = *(LAS f32x4*)(rstd + sb), r1 = *(LAS f32x4*)(rstd + sb + 4);
            const u32x4 rw = raw[k4]; u32x4 aw;
            aw.x = pkbf((bflo(rw.x) - m0[0]) * r0[0] * lg + lb, (bfhi(rw.x) - m0[1]) * r0[1] * lg + lb);
            aw.y = pkbf((bflo(rw.y) - m0[2]) * r0[2] * lg + lb, (bfhi(rw.y) - m0[3]) * r0[3] * lg + lb);
            aw.z = pkbf((bflo(rw.z) - m1[0]) * r1[0] * lg + lb, (bfhi(rw.z) - m1[1]) * r1[1] * lg + lb);
            aw.w = pkbf((bflo(rw.w) - m1[2]) * r1[2] * lg + lb, (bfhi(rw.w) - m1[3]) * r1[3] * lg + lb);
            const bf16x8 af = __builtin_bit_cast(bf16x8, aw);
#pragma unroll
            for (int tb = 0; tb < 2; ++tb) { const f32x4 w0 = wv[k4][tb][0], w1 = wv[k4][tb][1];
                u32x4 bw; bw.x = pkbf(w0[0], w0[1]); bw.y = pkbf(w0[2], w0[3]); bw.z = pkbf(w1[0], w1[1]); bw.w = pkbf(w1[2], w1[3]);
                const bf16x8 bfr = __builtin_bit_cast(bf16x8, bw);
                if (tb == 0) acc0 = MFMA32(af, bfr, acc0); else acc1 = MFMA32(af, bfr, acc1); } }
    }
#pragma unroll
    for (int tb = 0; tb < 2; ++tb) {
        const int t = th * 64 + tb * 32 + li; const float bs = INP(7)[(l * 4 + g) * 128 + t];
        bf16_t* urow = p + (tok0 + t) * PC + 1024 + g * 128 + cblk * 32 + 4 * hl;
        u32x2 uws[4];
#pragma unroll
        for (int q = 0; q < 4; ++q) uws[q] = *(const u32x2*)(urow + 8 * q);
#pragma unroll
        for (int q = 0; q < 4; ++q) { const u32x2 uw = uws[q];
            float v0, v1, v2, v3;
            if (tb == 0) { v0 = acc0[4 * q]; v1 = acc0[4 * q + 1]; v2 = acc0[4 * q + 2]; v3 = acc0[4 * q + 3]; } else { v0 = acc1[4 * q]; v1 = acc1[4 * q + 1]; v2 = acc1[4 * q + 2]; v3 = acc1[4 * q + 3]; }
            u32x2 ow; ow.x = pkbf(bflo(uw.x) * (v0 + bs), bfhi(uw.x) * (v1 + bs)); ow.y = pkbf(bflo(uw.y) * (v2 + bs), bfhi(uw.y) * (v3 + bs));
            *(u32x2*)(urow + 8 * q) = ow; }
    }
    __syncthreads();
}

DI void conv_phase(int l, bf16_t* p, LAS unsigned char* lds, int gtid, int NGT) {
    const float* cw = INP(8) + (size_t)l * 3 * 512;
    for (int it = gtid; it < M * 64; it += NGT) {
        const int row = it >> 6, c8 = (it & 63) * 8, t = row & (SEQ - 1);
        bf16_t* pr = p + (size_t)row * PC;
        float accv[8];
#pragma unroll
        for (int e = 0; e < 8; ++e) accv[e] = 0.f;
        u32x4 ccv[3], cxv[3];
#pragma unroll
        for (int j = 0; j < 3; ++j) { const int dt = (t - (2 - j) >= 0) ? 2 - j : 0;
            ccv[j] = *(const u32x4*)(pr - (size_t)dt * PC + 2048 + c8); cxv[j] = *(const u32x4*)(pr - (size_t)dt * PC + 2560 + c8); }
        const u32x4 cb = *(const u32x4*)(pr + 1536 + c8);
        asm volatile("" ::: "memory");
#pragma unroll
        for (int j = 0; j < 3; ++j) { const int dt = 2 - j;
            if (t - dt >= 0) {
                const u32x4 cc = ccv[j], cx = cxv[j];
                const f32x4 w0 = *(const f32x4*)(cw + j * 512 + c8), w1 = *(const f32x4*)(cw + j * 512 + c8 + 4);
                accv[0] += w0[0] * bflo(cc.x) * bflo(cx.x); accv[1] += w0[1] * bfhi(cc.x) * bfhi(cx.x); accv[2] += w0[2] * bflo(cc.y) * bflo(cx.y); accv[3] += w0[3] * bfhi(cc.y) * bfhi(cx.y);
                accv[4] += w1[0] * bflo(cc.z) * bflo(cx.z); accv[5] += w1[1] * bfhi(cc.z) * bfhi(cx.z); accv[6] += w1[2] * bflo(cc.w) * bflo(cx.w); accv[7] += w1[3] * bfhi(cc.w) * bfhi(cx.w); } }
        u32x4 o; o.x = pkbf(bflo(cb.x) * accv[0], bfhi(cb.x) * accv[1]); o.y = pkbf(bflo(cb.y) * accv[2], bfhi(cb.y) * accv[3]); o.z = pkbf(bflo(cb.z) * accv[4], bfhi(cb.z) * accv[5]); o.w = pkbf(bflo(cb.w) * accv[6], bfhi(cb.w) * accv[7]);
        *(u32x4*)(pr + 1536 + c8) = o;
    }
}

DI void xattn_wg(const bf16_t* qx, const bf16_t* memK, const bf16_t* memVT, bf16_t* ox, int item, int tid, int wave, int lane, LAS unsigned char* lds) {
    const int b = item >> 6, h = (item >> 4) & 3, qb = (item & 15) * 8 + wave;
    const int hl = lane >> 5, li = lane & 31;
    const size_t qrow = (size_t)b * SEQ + qb * 32 + li;
    bf16x8 qf[16];
#pragma unroll
    for (int kk = 0; kk < 16; ++kk) qf[kk] = *(const bf16x8*)(qx + qrow * D + h * 256 + 16 * kk + 8 * hl);
    const int sr = tid >> 4, sp0 = (tid & 15) * 2;
    const int kperm_sr = (sr & 16) | ((sr & 4) << 1) | ((sr & 8) >> 1) | (sr & 3);
    const bf16_t* kbase = memK + (size_t)(b * 256) * D + h * 256;
    const bf16_t* vbase = memVT + (size_t)(h * 256) * D + b * 256;
    u32x4 st[2];
#define XA_LOAD(c) do { if ((c) < 8) { _Pragma("unroll") for (int e = 0; e < 2; ++e) st[e] = *(const u32x4*)(kbase + (size_t)((c) * 32 + sr) * D + (sp0 + e) * 8); } \
                        else { _Pragma("unroll") for (int e = 0; e < 2; ++e) st[e] = *(const u32x4*)(vbase + (size_t)(((c) - 8) * 32 + sr) * D + (sp0 + e) * 8); } } while (0)
#define XA_STORE(c) do { const int rl = (c) < 8 ? kperm_sr : sr; _Pragma("unroll") for (int e = 0; e < 2; ++e) { const int p = sp0 + e; \
                        *(LAS u32x4*)(lds + ((c) & 1) * 16384 + (((p >> 1) * 64) + (p & 1) * 32 + rl) * 16) = st[e]; } } while (0)
    XA_LOAD(0); XA_STORE(0);
    __syncthreads();
    f32x16 S[8];
#pragma unroll
    for (int c = 0; c < 8; ++c) {
        XA_LOAD(c + 1);
        f32x16 z;
#pragma unroll
        for (int r = 0; r < 16; ++r) z[r] = 0.f;
        const LAS unsigned char* buf = lds + (c & 1) * 16384 + lane * 16;
#pragma unroll
        for (int kk = 0; kk < 16; ++kk) { const bf16x8 kf = *(const LAS bf16x8*)(buf + kk * 1024); z = MFMA32(kf, qf[kk], z); }
        S[c] = z;
        XA_STORE(c + 1);
        __syncthreads();
    }
    float mx = -3.0e38f;
#pragma unroll
    for (int kb = 0; kb < 8; ++kb)
#pragma unroll
        for (int r = 0; r < 16; ++r) mx = fmaxf(mx, S[kb][r]);
    mx = fmaxf(mx, __shfl_xor(mx, 32));
    float sum = 0.f;
    bf16x8 pf[16];
#pragma unroll
    for (int kb = 0; kb < 8; ++kb)
#pragma unroll
        for (int c = 0; c < 2; ++c) { u32x4 w;
#pragma unroll
            for (int e = 0; e < 4; ++e) { const float a0 = __builtin_amdgcn_exp2f((S[kb][8 * c + 2 * e] - mx) * LOG2E), a1 = __builtin_amdgcn_exp2f((S[kb][8 * c + 2 * e + 1] - mx) * LOG2E); sum += a0 + a1; w[e] = pkbf(a0, a1); }
            pf[2 * kb + c] = __builtin_bit_cast(bf16x8, w); }
    sum += __shfl_xor(sum, 32);
    const float inv = 1.0f / sum;
    bf16_t* orow = ox + qrow * D + h * 256 + 4 * hl;
#pragma unroll 1
    for (int c = 8; c < 16; ++c) {
        if (c + 1 < 16) XA_LOAD(c + 1);
        f32x16 o;
#pragma unroll
        for (int r = 0; r < 16; ++r) o[r] = 0.f;
        const LAS unsigned char* buf = lds + (c & 1) * 16384 + lane * 16;
#pragma unroll
        for (int s = 0; s < 16; ++s) { const bf16x8 vf = *(const LAS bf16x8*)(buf + s * 1024); o = MFMA32(vf, pf[s], o); }
        const int db = c - 8;
#pragma unroll
        for (int g = 0; g < 4; ++g) { u32x2 w; w.x = pkbf(o[4 * g] * inv, o[4 * g + 1] * inv); w.y = pkbf(o[4 * g + 2] * inv, o[4 * g + 3] * inv); *(u32x2*)(orow + db * 32 + 8 * g) = w; }
        if (c + 1 < 16) XA_STORE(c + 1);
        __syncthreads();
    }
#undef XA_LOAD
#undef XA_STORE
}

constexpr int RSD_OFF = 131072 + 768, RS_OFF = 131072 + 1024, RS_MAXU = 15;
template <class Prog>
DI void fill_rs(LAS unsigned char* lds, Prog P2, const float* ssp, int tid) {
    LAS int* desc = (LAS int*)(lds + RSD_OFF);
    if (tid == 0) { pg8::UnitX x; int n = 0; while (n < RS_MAXU && P2.next(x)) { desc[n] = P2.rs_base(x); ++n; } desc[RS_MAXU] = n; }
    __syncthreads();
    const int n = desc[RS_MAXU];
    for (int kb = 0; kb < n; kb += 8) {
        f32x4 sv[4][4]; int ok[4];
#pragma unroll
        for (int j = 0; j < 4; ++j) { const int k = kb + 2 * j + (tid >> 8); const int base = k < n ? desc[k] : -1; ok[j] = base >= 0;
            const f32x4* sp = (const f32x4*)(ssp + (size_t)((ok[j] ? base : 0) + (tid & 255)) * 16);
#pragma unroll
            for (int q = 0; q < 4; ++q) sv[j][q] = ok[j] ? sp[q] : (f32x4){0.f, 0.f, 0.f, 0.f}; }
        asm volatile("" ::: "memory");
#pragma unroll
        for (int j = 0; j < 4; ++j) if (ok[j]) { const int k = kb + 2 * j + (tid >> 8); float s = 0.f;
#pragma unroll
            for (int q = 0; q < 4; ++q) s += (sv[j][q][0] + sv[j][q][1]) + (sv[j][q][2] + sv[j][q][3]);
            ((LAS float*)(lds + RS_OFF))[k * 256 + (tid & 255)] = 1.0f / sqrtf(s * (1.0f / D) + RMS_EPS); }
    }
    __syncthreads();
}
struct ProgC {
    unsigned char* ws; LAS unsigned char* lds; int G, c; int j, i, kk; pg8::Unit u; bool have;
    DI int rs_base(const pg8::UnitX& x) const { return (x.job & 1) ? -1 : x.pm * 256; }
    DI void init(unsigned char* ws_, int G_, int c_, LAS unsigned char* lds_) { lds = lds_; kk = 0; ws = ws_; G = G_; c = c_; j = 0; i = 0; pg8::StaticOrder S; S.init(M, D, G, c); have = S.next(0, u); }
    DI bool next(pg8::UnitX& x) {
        if (have && j >= 6) { pg8::StaticOrder S; S.init(M, D, G, c); ++i; j = 0; have = S.next(i, u); }
        if (!have) return false;
        x.pm = u.pm; x.pn = u.pn; x.job = j; x.k = kk; ++kk; ++j; return true; }
    DI pg8::JobP job(int jj) const { const int n = jj >> 1; pg8::JobP p;
        if ((jj & 1) == 0) { p.A = (const bf16_t*)(ws + WS_XB); p.Bt = (const bf16_t*)(ws + WS_WIN) + (size_t)(4096 + n * 1024) * D; p.lda = D; p.ldb = D; p.nt = D / 64; }
        else { const int acol = n == 0 ? 0 : (n == 1 ? 1024 : 1536); p.A = (const bf16_t*)(ws + WS_P) + acol; p.Bt = (const bf16_t*)(ws + WS_WB) + (size_t)n * D * 512; p.lda = PC; p.ldb = 512; p.nt = 512 / 64; }
        return p; }
    DI void epilogue(const f32x4 (&acc)[2][2][4][2], const pg8::UnitX& x, int wr, int wc, int fr, int fq) const {
        pg8::EpiArgs ea{}; const pg8::Unit uu{x.pm, x.pn};
        if ((x.job & 1) == 0) { ea.O = (bf16_t*)(ws + WS_T); ea.ldc = D; ea.ssp = (const float*)(ws + WS_SSP); ea.rstab = x.k < RS_MAXU ? (const LAS float*)(lds + RS_OFF) + x.k * 256 : nullptr; ea.cscale = 1.f; pg8::Epi<pg8::E_GATE> E{ea}; E(acc, uu, wr, wc, fr, fq); }
        else { ea.O = (bf16_t*)(ws + WS_X2); ea.ldc = D; ea.G = (const bf16_t*)(ws + WS_T);
            if (x.job == 1) { pg8::Epi<pg8::E_BR0> E{ea}; E(acc, uu, wr, wc, fr, fq); } else { pg8::Epi<pg8::E_BRN> E{ea}; E(acc, uu, wr, wc, fr, fq); } }
    }
};
struct ProgA {
    unsigned char* ws; LAS unsigned char* lds; int G, c; int jb, i, njobs, kk;
    DI int rs_base(const pg8::UnitX& x) const { return x.job == 0 ? x.pm * 256 : (x.job == 1 ? x.pn * 256 : -1); }
    DI void init(unsigned char* ws_, int G_, int c_, int l, LAS unsigned char* lds_) { lds = lds_; kk = 0; ws = ws_; G = G_; c = c_; jb = 0; i = 0; njobs = l == 0 ? 4 : 2; }
    DI bool next(pg8::UnitX& x) {
        for (; jb < njobs; ++jb, i = 0) {
            pg8::StaticOrder S; pg8::Unit u;
            if (jb == 0) S.init(M, 3072, G, c); else if (jb == 1) S.init(1024, M, G, c); else if (jb == 2) S.init(1024, D, G, (c + 64) % G); else S.init(D, 1024, G, (c + 192) % G);
            if (S.next(i, u)) { x.pm = u.pm; x.pn = u.pn; x.job = jb; x.k = kk; ++kk; ++i; return true; }
        }
        return false;
    }
    DI pg8::JobP job(int jj) const { pg8::JobP p; p.lda = D; p.ldb = D; p.nt = D / 64;
        if (jj == 0) { p.A = (const bf16_t*)(ws + WS_XB); p.Bt = (const bf16_t*)(ws + WS_WIN); }
        else if (jj == 1) { p.A = (const bf16_t*)(ws + WS_WIN) + (size_t)3072 * D; p.Bt = (const bf16_t*)(ws + WS_XB); }
        else if (jj == 2) { p.A = (const bf16_t*)(ws + WS_MB); p.Bt = (const bf16_t*)(ws + WS_WK); }
        else { p.A = (const bf16_t*)(ws + WS_WV); p.Bt = (const bf16_t*)(ws + WS_MB); }
        return p; }
    DI void epilogue(const f32x4 (&acc)[2][2][4][2], const pg8::UnitX& x, int wr, int wc, int fr, int fq) const {
        pg8::EpiArgs ea{}; const pg8::Unit uu{x.pm, x.pn};
        const LAS float* rst = x.k < RS_MAXU ? (const LAS float*)(lds + RS_OFF) + x.k * 256 : nullptr;
        if (x.job == 0) { ea.O = (bf16_t*)(ws + WS_P); ea.ldc = PC; ea.ssp = (const float*)(ws + WS_SSP); ea.rstab = rst; ea.cscale = 1.f; pg8::Epi<pg8::E_INPROJ> E{ea}; E(acc, uu, wr, wc, fr, fq); }
        else if (x.job == 2) { ea.O = (bf16_t*)(ws + WS_MEMK); ea.ldc = D; ea.ssp = nullptr; ea.cscale = 1.f; pg8::Epi<pg8::E_ROWSCALE> E{ea}; E(acc, uu, wr, wc, fr, fq); }
        else { if (x.job == 1) { ea.O = (bf16_t*)(ws + WS_T); ea.ldc = M; ea.ssp = (const float*)(ws + WS_SSP); ea.rstab = rst; } else { ea.O = (bf16_t*)(ws + WS_MEMVT); ea.ldc = 1024; ea.ssp = nullptr; }
            pg8::Epi<pg8::E_TRANS> E{ea}; E(acc, uu, wr, wc, fr, fq); }
    }
};
struct ProgJ {
    unsigned char* ws; LAS unsigned char* lds; int G, c; int jb, i, njobs, kk;
    DI int rs_base(const pg8::UnitX& x) const { return x.job == 0 ? x.pm * 256 : -1; }
    DI void init(unsigned char* ws_, int G_, int c_, int l, LAS unsigned char* lds_) { lds = lds_; kk = 0; ws = ws_; G = G_; c = c_; jb = 0; i = 0; njobs = l == 0 ? 3 : 1; }
    DI bool next(pg8::UnitX& x) {
        for (; jb < njobs; ++jb, i = 0) {
            pg8::StaticOrder S; pg8::Unit u;
            if (jb == 0) S.init(M, 2 * FF, G, c); else if (jb == 1) S.init(1024, D, G, (c + 128) % G); else S.init(D, 1024, G, (c + 96) % G);
            if (S.next(i, u)) { x.pm = u.pm; x.pn = u.pn; x.job = jb; x.k = kk; ++kk; ++i; return true; }
        }
        return false;
    }
    DI pg8::JobP job(int jj) const { pg8::JobP p; p.lda = D; p.ldb = D; p.nt = D / 64;
        if (jj == 0) { p.A = (const bf16_t*)(ws + WS_XB); p.Bt = (const bf16_t*)(ws + WS_WGU); }
        else if (jj == 1) { p.A = (const bf16_t*)(ws + WS_MB1); p.Bt = (const bf16_t*)(ws + WS_WK1); }
        else { p.A = (const bf16_t*)(ws + WS_WV1); p.Bt = (const bf16_t*)(ws + WS_MB1); }
        return p; }
    DI void epilogue(const f32x4 (&acc)[2][2][4][2], const pg8::UnitX& x, int wr, int wc, int fr, int fq) const {
        pg8::EpiArgs ea{}; const pg8::Unit uu{x.pm, x.pn};
        if (x.job == 0) { ea.O = (bf16_t*)(ws + WS_P); ea.ldc = FF; ea.ssp = (const float*)(ws + WS_SSP) + (size_t)2 * M * 16; ea.rstab = x.k < RS_MAXU ? (const LAS float*)(lds + RS_OFF) + x.k * 256 : nullptr; pg8::Epi<pg8::E_SWIGLU> E{ea}; E(acc, uu, wr, wc, fr, fq); }
        else if (x.job == 1) { ea.O = (bf16_t*)(ws + WS_MEMK1); ea.ldc = D; ea.ssp = nullptr; ea.cscale = 1.f; pg8::Epi<pg8::E_ROWSCALE> E{ea}; E(acc, uu, wr, wc, fr, fq); }
        else { ea.O = (bf16_t*)(ws + WS_MEMVT1); ea.ldc = 1024; ea.ssp = nullptr; pg8::Epi<pg8::E_TRANS> E{ea}; E(acc, uu, wr, wc, fr, fq); }
    }
};
#define XB_TMO      128
#define XB_XCNT(j)  (256  + 64 * (j))
#define XB_XSUB(j)  (1280 + 64 * (j))
#define XB_XGEN(j)  (2304 + 64 * (j))
#define XB_TOP      3328
#define XB_TOPGEN   3392
#define XCD_BAR_WORDS 3456
#define XB_SPIN_CAP (1u << 18)

__device__ __forceinline__ unsigned xb_ld(unsigned* p)              { return __hip_atomic_load(p, __ATOMIC_RELAXED, __HIP_MEMORY_SCOPE_AGENT); }
__device__ __forceinline__ unsigned xb_add(unsigned* p, unsigned v) { return __hip_atomic_fetch_add(p, v, __ATOMIC_RELAXED, __HIP_MEMORY_SCOPE_AGENT); }
__device__ __forceinline__ unsigned xb_xcc_id() { return (unsigned)__builtin_amdgcn_s_getreg((3 << 11) | 20) & 0xFu; }
#define XB_SPIN(cond, bar) do { unsigned _sp = 0; while (cond) { __builtin_amdgcn_s_sleep(1); \
    if ((++_sp & 255u) == 0u) { if (xb_ld(&(bar)[XB_TMO])) break; if (_sp > XB_SPIN_CAP) { atomicAdd(&(bar)[XB_TMO], 1u); break; } } } } while (0)

struct XcdBarrier {
    unsigned* bar; unsigned x;
    volatile LAS unsigned* st;
};

__device__ __forceinline__ XcdBarrier xcd_barrier_post(unsigned* bar, volatile LAS unsigned* st) {
    XcdBarrier b; b.bar = bar; b.x = xb_xcc_id(); b.st = st;
    if (threadIdx.x == 0) (void)xb_add(&bar[XB_XCNT(b.x)], 1u);
    return b;
}
__device__ __forceinline__ void xcd_barrier_complete(unsigned* bar, unsigned x, unsigned& nloc, unsigned& nx) {
    const unsigned G = gridDim.x * gridDim.y * gridDim.z;
    unsigned sum, cnt, mine, sp = 0u;
    for (;;) {
        sum = 0u; cnt = 0u; mine = 0u;
#pragma unroll
        for (unsigned j = 0; j < 16; ++j) { const unsigned c = xb_ld(&bar[XB_XCNT(j)]); sum += c; cnt += (c > 0u) ? 1u : 0u; mine = (j == x) ? c : mine; }
        if (sum == G) break;
        __builtin_amdgcn_s_sleep(1);
        if ((++sp & 255u) == 0u) { if (xb_ld(&bar[XB_TMO])) break; if (sp > XB_SPIN_CAP) { atomicAdd(&bar[XB_TMO], 1u); break; } }
    }
    nloc = mine > 0u ? mine : 1u; nx = cnt > 0u ? cnt : 1u;
}

__device__ __forceinline__ void xcd_barrier(const XcdBarrier& b) {
    asm volatile("s_waitcnt vmcnt(0)" ::: "memory");
    __syncthreads();
    if (threadIdx.x == 0) {
        unsigned* bar = b.bar;
        __builtin_amdgcn_s_waitcnt(0);
        unsigned nloc = b.st[0], nx = b.st[1];
        if (nloc == 0u) { xcd_barrier_complete(bar, b.x, nloc, nx); b.st[0] = nloc; b.st[1] = nx; }
        const unsigned old = xb_add(&bar[XB_XSUB(b.x)], 1u);
        const unsigned gen = old / nloc;
        if (old + 1u == (gen + 1u) * nloc) {
            __builtin_amdgcn_fence(__ATOMIC_RELEASE, "agent");
            asm volatile("s_waitcnt vmcnt(0)" ::: "memory");
            const unsigned og = xb_add(&bar[XB_TOP], 1u);
            const unsigned tg = og / nx;
            if (og + 1u == (tg + 1u) * nx) xb_add(&bar[XB_TOPGEN], 1u);
            else XB_SPIN(xb_ld(&bar[XB_TOPGEN]) == tg, bar);
            __builtin_amdgcn_fence(__ATOMIC_ACQUIRE, "agent");
            xb_add(&bar[XB_XGEN(b.x)], 1u);
            asm volatile("s_waitcnt vmcnt(0)" ::: "memory");
        } else {
            XB_SPIN(xb_ld(&bar[XB_XGEN(b.x)]) == gen, bar);
            __builtin_amdgcn_fence(__ATOMIC_ACQUIRE, "agent");
            asm volatile("s_waitcnt vmcnt(0)" ::: "memory");
        }
    }
    __syncthreads();
}

#define WSB(off) ((bf16_t*)(WSP + (off)))
#define WSF(off) ((float*)(WSP + (off)))
__global__ void __launch_bounds__(NTHREADS, 2) fwd_megakernel(Args A_unused) {
    extern __shared__ __attribute__((aligned(16))) unsigned char lds_raw[];
    LAS unsigned char* lds = (LAS unsigned char*)lds_raw;
    cg::grid_group grid = cg::this_grid();
    { const int tid = threadIdx.x;
    if (tid < 24) { const unsigned long long* ka = (const unsigned long long*)__builtin_amdgcn_kernarg_segment_ptr(); *(LAS unsigned long long*)(lds + PTR_OFF + 8 * tid) = ka[tid]; } }
    if (threadIdx.x < 8) ((LAS unsigned*)(lds + PTR_OFF + 256))[threadIdx.x] = 0u;
    __syncthreads();
    if (blockIdx.x == 0) { unsigned* bw = (unsigned*)ldq(lds, 23); for (int w = threadIdx.x; w < XCD_BAR_WORDS; w += NTHREADS) __hip_atomic_store(bw + w, 0u, __ATOMIC_RELAXED, __HIP_MEMORY_SCOPE_AGENT); }
    asm volatile("s_waitcnt vmcnt(0)" ::: "memory");
    __syncthreads();
    grid.sync();
    const XcdBarrier bar = xcd_barrier_post((unsigned*)ldq(lds, 23), (volatile LAS unsigned*)(lds + PTR_OFF + 256));
#define XBAR() do { XcdBarrier b2_ = bar; asm volatile("" : "+s"(b2_.x)); xcd_barrier(b2_); } while (0)
#define FRESH_IDS const int tid = fresh_tid(), lane = tid & 63, wave = __builtin_amdgcn_readfirstlane(tid >> 6); (void)lane; (void)wave
#define GRID_ ((int)gridDim.x)
#define BID_ ((int)blockIdx.x)
#define GW_ (BID_ * NWAVES + wave)
#define NGW_ (GRID_ * NWAVES)
    constexpr size_t SSPB = (size_t)M * 16 * 4;
    using namespace pg8;

    { FRESH_IDS; prep_x(lds, GW_, NGW_, lane); }
    { FRESH_IDS; prep_weights(0, lds, GW_, NGW_, wave, lane); }
    XBAR();
    for (int l = 0; l < DEPTH; ++l) {
        { ProgA PA; PA.init(WSP, GRID_, BID_, l, lds); { FRESH_IDS; fill_rs(lds, PA, WSF(WS_SSP), tid); } gemm_stream(lds, PA); }
        XBAR();
        if (l > 0) { FRESH_IDS; prep_weights(l, lds, GW_, NGW_, wave, lane, 2); __syncthreads(); }
        { FRESH_IDS; for (int it = BID_; it < NBATCH * 32 * 4; it += GRID_) sgu_item(l, WSB(WS_P), WSB(WS_T), it, lds, tid, wave, lane); }
        { FRESH_IDS; for (int it = GW_; it < NBATCH * 8 * 128; it += NGW_) sb_attn_item(WSB(WS_P), WSB(WS_T), it, lane); }
        { FRESH_IDS; conv_phase(l, WSB(WS_P), lds, BID_ * NTHREADS + tid, GRID_ * NTHREADS); }
        XBAR();
        { ProgC PCg; PCg.init(WSP, GRID_, BID_, lds); { FRESH_IDS; fill_rs(lds, PCg, WSF(WS_SSP), tid); } gemm_stream(lds, PCg); }
        XBAR();
        {
            StaticOrder S; S.init(M, D, GRID_, BID_);
            EpiArgs ea{}; Gemm g{WSB(WS_X2), WSB(WS_WOUT), M, D, D, D, D}; ea.xb = WSB(WS_XB); ea.sspo = WSF(WS_SSP + SSPB); Epi<E_RESID> E{ea}; gemm_phase(lds, g, S, E);
        }
        XBAR();
        {
            StaticOrder S; S.init(M, D, GRID_, BID_);
            EpiArgs ea{}; Gemm g{WSB(WS_XB), WSB(WS_WQ), M, D, D, D, D}; ea.O = WSB(WS_T); ea.ldc = D; ea.ssp = WSF(WS_SSP + SSPB); ea.cscale = 0.0625f; Epi<E_ROWSCALE> E{ea}; gemm_phase(lds, g, S, E);
            Unit u;
            for (int i = 0; S.next(i, u); ++i) { FRESH_IDS; xattn_wg(WSB(WS_T), WSB(l ? WS_MEMK1 : WS_MEMK), WSB(l ? WS_MEMVT1 : WS_MEMVT), WSB(WS_X2), (u.pm >> 4) * 64 + u.pn * 16 + (u.pm & 15), tid, wave, lane, lds); }
        }
        XBAR();
        {
            StaticOrder S; S.init(M, D, GRID_, BID_);
            EpiArgs ea{}; Gemm g{WSB(WS_X2), WSB(WS_WOX), M, D, D, D, D}; ea.xb = WSB(WS_XB); ea.sspo = WSF(WS_SSP + 2 * SSPB); Epi<E_RESID> E{ea}; gemm_phase(lds, g, S, E);
        }
        XBAR();
        { ProgJ PJ; PJ.init(WSP, GRID_, BID_, l, lds); { FRESH_IDS; fill_rs(lds, PJ, WSF(WS_SSP + 2 * SSPB), tid); } gemm_stream(lds, PJ); }
        XBAR();
        {
            StaticOrder S; S.init(M, D, GRID_, BID_);
            EpiArgs ea{}; Gemm g{WSB(WS_P), WSB(WS_WD), M, D, FF, FF, FF}; ea.xb = WSB(WS_XB); ea.sspo = WSF(WS_SSP); Epi<E_RESID> E{ea}; gemm_phase(lds, g, S, E);
        }
        if (l + 1 < DEPTH) { FRESH_IDS; prep_weights(l + 1, lds, GW_, NGW_, wave, lane, 1); }
        XBAR();
    }
    { FRESH_IDS; final_norm(lds, GW_, NGW_, lane); }
}

extern "C" void kernel_launch(void* const* d_in, const int* in_sizes, int n_in, void* d_out, int out_size, void* d_ws, size_t ws_size, hipStream_t stream) {
    static int grid = 0;
    if (grid == 0) {
        if (n_in != 22 || in_sizes[0] != M * D || out_size != M * D || ws_size < WS_END) { fprintf(stderr, "kernel_launch: unexpected shapes (n_in %d, in0 %d, out %d, ws %zu)\n", n_in, n_in > 0 ? in_sizes[0] : -1, out_size, ws_size); grid = -1; return; }
        int dev = 0, cus = 0, per_cu = 0;
        hipGetDevice(&dev); hipDeviceGetAttribute(&cus, hipDeviceAttributeMultiprocessorCount, dev);
        hipFuncSetAttribute((const void*)fwd_megakernel, hipFuncAttributeMaxDynamicSharedMemorySize, LDS_BYTES);
        hipOccupancyMaxActiveBlocksPerMultiprocessor(&per_cu, (const void*)fwd_megakernel, NTHREADS, LDS_BYTES);
        if (per_cu < 1) { fprintf(stderr, "kernel_launch: occupancy query says %d blocks per CU\n", per_cu); per_cu = 1; }
        (void)hipGetLastError();
        grid = cus;
    }
    if (grid < 0) return;
    Args a{};
    for (int i = 0; i < 22; ++i) a.in[i] = (const float*)d_in[i];
    a.out = (float*)d_out; a.ws = (unsigned char*)d_ws;
    void* args[] = {&a};
    hipError_t e = hipLaunchCooperativeKernel((const void*)fwd_megakernel, dim3(grid), dim3(NTHREADS), args, LDS_BYTES, stream);
    if (e != hipSuccess) fprintf(stderr, "cooperative launch failed: %s (grid %d)\n", hipGetErrorString(e), grid);
}
```

```cpp
#include <hip/hip_runtime.h>
#include <hip/hip_cooperative_groups.h>
#include <cstdio>
#include <cstdint>
namespace cg = cooperative_groups;

#define LAS __attribute__((address_space(3)))
typedef unsigned short bf16_t;
typedef short bf16x8 __attribute__((ext_vector_type(8)));
typedef float f32x4 __attribute__((ext_vector_type(4)));
typedef float f32x2 __attribute__((ext_vector_type(2)));
typedef float f32x16 __attribute__((ext_vector_type(16)));
typedef unsigned u32x4 __attribute__((ext_vector_type(4)));
typedef unsigned u32x2 __attribute__((ext_vector_type(2)));
typedef __bf16 bf16x2n __attribute__((ext_vector_type(2)));

#define DI __device__ __forceinline__
DI unsigned pkbf(float lo, float hi) { f32x2 v = {lo, hi}; bf16x2n b = __builtin_convertvector(v, bf16x2n); return __builtin_bit_cast(unsigned, b); }
DI float bflo(unsigned u) { return __uint_as_float(u << 16); }
DI float bfhi(unsigned u) { return __uint_as_float(u & 0xffff0000u); }
DI int fresh_tid() { int t = threadIdx.x; asm volatile("" : "+v"(t)); return t; }
#define MFMA32(a, b, c) __builtin_amdgcn_mfma_f32_32x32x16_bf16((a), (b), (c), 0, 0, 0)

constexpr int M = 16384, D = 1024, SEQ = 4096, NBATCH = 4, DEPTH = 2;
constexpr int PC = 3072;
constexpr int FF = 2816;
constexpr int INC = 7168;
constexpr float RMS_EPS = 1e-6f, LN_EPS = 1e-5f;
constexpr float LOG2E = 1.4426950408889634f, LN2 = 0.6931471805599453f;
constexpr float SB_EXIT = 110.0f;

constexpr size_t MiB = (size_t)1 << 20;
constexpr size_t WS_WIN = 1 * MiB;
constexpr size_t WS_WB = 15 * MiB;
constexpr size_t WS_WOUT = 18 * MiB, WS_WQ = 20 * MiB, WS_WK = 22 * MiB, WS_WV = 24 * MiB, WS_WOX = 26 * MiB;
constexpr size_t WS_WGU = 28 * MiB;
constexpr size_t WS_WD = 39 * MiB;
constexpr size_t WS_MB = 45 * MiB, WS_MEMK = 47 * MiB, WS_MEMVT = 49 * MiB;
constexpr size_t WS_XB = 51 * MiB;
constexpr size_t WS_P = 83 * MiB;
constexpr size_t WS_T = 179 * MiB;
constexpr size_t WS_X2 = 211 * MiB;
constexpr size_t WS_SSP = 243 * MiB;
constexpr size_t WS_WK1 = 246 * MiB, WS_WV1 = 248 * MiB, WS_MB1 = 250 * MiB, WS_MEMK1 = 252 * MiB, WS_MEMVT1 = 254 * MiB;
constexpr size_t WS_END = 256 * MiB;

namespace pg8 {
constexpr int BM = 256, BK = 64, HALF = 128, HTB = HALF * BK * 2, STAGE_BYTES = 8 * HTB, NXCD = 8, WGM = 8;
DI int lds_byte(int r, int c) { const int st = (r >> 4) * 2 + (c >> 5), rr = r & 15, cc = c & 31, ob = rr * 64 + cc * 2; return st * 1024 + (ob ^ (((ob >> 9) & 1) << 5)); }
DI void stage_rc(int b, int& R, int& C) { const int st = b / 1024, sb = b % 1024, swz = sb ^ (((sb >> 9) & 1) << 5); R = (st >> 1) * 16 + swz / 64; C = (st & 1) * 32 + (swz % 64) / 2; }
DI int perm32(int rho) { const int n = rho >> 4, i = rho & 15; return 8 * (i >> 2) + 4 * n + (i & 3); }

struct Unit { int pm, pn; };
struct Gemm { const bf16_t* A; const bf16_t* Bt; int M, N, K, lda, ldb; };

struct StaticOrder {
    int nM, nN, nwg, G, c;
    DI void init(int M_, int N_, int G_, int c_) { nM = M_ / BM; nN = N_ / BM; nwg = nM * nN; G = G_; c = c_; }
    DI bool next(int i, Unit& u) const {
        const long L = (long)i * G + c; if (L >= nwg) return false;
        int wgid = (int)L; { const int q = nwg / NXCD, r = nwg % NXCD, xcd = wgid % NXCD, off = wgid / NXCD; wgid = (xcd < r ? xcd * (q + 1) : r * (q + 1) + (xcd - r) * q) + off; }
        const int nig = WGM * nN, gid = wgid / nig, fm = gid * WGM, gsz = (nM - fm) < WGM ? (nM - fm) : WGM;
        u.pm = fm + ((wgid % nig) % gsz); u.pn = (wgid % nig) / gsz; return true;
    }
};

DI f32x2 gelu_pk(f32x2 v) {
    const f32x2 av = __builtin_elementwise_abs(v), d = av * 0.2316418882f + 1.0f;
    f32x2 t; t.x = __builtin_amdgcn_rcpf(d.x); t.y = __builtin_amdgcn_rcpf(d.y);
    f32x2 q = t * 0.5307027145f + (-0.7265760135f); q = q * t + 0.7107068705f; q = q * t + (-0.142248368f); q = q * t + 0.127414796f; q = q * t;
    const f32x2 s = (v * v) * (-0.72134752044f);
    f32x2 e; e.x = __builtin_amdgcn_exp2f(s.x); e.y = __builtin_amdgcn_exp2f(s.y);
    const f32x2 m = v * (q * e), r = v - m;
    f32x2 o; o.x = v.x < 0.f ? m.x : r.x; o.y = v.y < 0.f ? m.y : r.y; return o;
}
DI f32x4 gelu4(f32x4 v) { f32x2 a = gelu_pk((f32x2){v[0], v[1]}), b = gelu_pk((f32x2){v[2], v[3]}); return (f32x4){a.x, a.y, b.x, b.y}; }
DI float sigmoidf_(float x) { return __builtin_amdgcn_rcpf(1.0f + __builtin_amdgcn_exp2f(-x * LOG2E)); }
DI f32x4 sigmoid4(f32x4 v) { return (f32x4){sigmoidf_(v[0]), sigmoidf_(v[1]), sigmoidf_(v[2]), sigmoidf_(v[3])}; }

DI float row_rs(const float* ssp, int row, int fq) {
    const f32x4 v = *(const f32x4*)(ssp + (size_t)row * 16 + fq * 4);
    float s = (v[0] + v[1]) + (v[2] + v[3]);
    s += __shfl_xor(s, 16); s += __shfl_xor(s, 32);
    return 1.0f / sqrtf(s * (1.0f / D) + RMS_EPS);
}

DI void row_rs8(const float* ssp, int row0, int fq, float (&rs)[2][4]) {
    f32x4 v[2][4];
#pragma unroll
    for (int ai = 0; ai < 2; ++ai)
#pragma unroll
        for (int m = 0; m < 4; ++m) v[ai][m] = *(const f32x4*)(ssp + (size_t)(row0 + ai * HALF + m * 16) * 16 + fq * 4);
    asm volatile("" ::: "memory");
#pragma unroll
    for (int ai = 0; ai < 2; ++ai)
#pragma unroll
        for (int m = 0; m < 4; ++m) { float s = (v[ai][m][0] + v[ai][m][1]) + (v[ai][m][2] + v[ai][m][3]); s += __shfl_xor(s, 16); s += __shfl_xor(s, 32); rs[ai][m] = 1.0f / sqrtf(s * (1.0f / D) + RMS_EPS); }
}

DI void row_rs8_lds(const LAS float* tab, int wr, int fr, float (&rs)[2][4]) {
#pragma unroll
    for (int ai = 0; ai < 2; ++ai)
#pragma unroll
        for (int m = 0; m < 4; ++m) rs[ai][m] = tab[ai * HALF + wr * 64 + m * 16 + fr];
}

enum { E_INPROJ = 0, E_TRANS = 1, E_GATE = 2, E_BR0 = 3, E_BRN = 4, E_RESID = 5, E_ROWSCALE = 6, E_SWIGLU = 7 };
struct EpiArgs {
    bf16_t* O; int ldc;
    const float* ssp;
    float cscale;
    const float* xsrc; float* xdst; bf16_t* xb; float* sspo;
    const bf16_t* G;
    const LAS float* rstab;
};
template <int MODE> struct Epi {
    static constexpr bool PERM = true;
    EpiArgs a;
    DI void store8(bf16_t* p, f32x4 v0, f32x4 v1) const { u32x4 w; w.x = pkbf(v0[0], v0[1]); w.y = pkbf(v0[2], v0[3]); w.z = pkbf(v1[0], v1[1]); w.w = pkbf(v1[2], v1[3]); *(u32x4*)p = w; }
    DI void operator()(const f32x4 (&acc)[2][2][4][2], const Unit& u, int wr, int wc, int fr, int fq) const {
        const int row0 = u.pm * BM + wr * 64 + fr, col0 = u.pn * BM + wc * 32 + 8 * fq;
        if constexpr (MODE == E_TRANS) {
            float rsc[2][8];
            if (a.rstab) {
#pragma unroll
                for (int bj = 0; bj < 2; ++bj) { const f32x4 t0 = *(const LAS f32x4*)(a.rstab + bj * HALF + wc * 32 + 8 * fq), t1 = *(const LAS f32x4*)(a.rstab + bj * HALF + wc * 32 + 8 * fq + 4);
                    rsc[bj][0] = t0[0]; rsc[bj][1] = t0[1]; rsc[bj][2] = t0[2]; rsc[bj][3] = t0[3]; rsc[bj][4] = t1[0]; rsc[bj][5] = t1[1]; rsc[bj][6] = t1[2]; rsc[bj][7] = t1[3]; }
            } else if (a.ssp) {
                const int lane = fq * 16 + fr, tok = u.pn * BM + (lane >> 5) * HALF + wc * 32 + (lane & 31);
                const f32x4* sp = (const f32x4*)(a.ssp + (size_t)tok * 16);
                const f32x4 s0 = sp[0], s1 = sp[1], s2 = sp[2], s3 = sp[3];
                const float s = ((s0[0] + s0[1]) + (s0[2] + s0[3])) + ((s1[0] + s1[1]) + (s1[2] + s1[3])) + ((s2[0] + s2[1]) + (s2[2] + s2[3])) + ((s3[0] + s3[1]) + (s3[2] + s3[3]));
                const float rs = 1.0f / sqrtf(s * (1.0f / D) + RMS_EPS);
#pragma unroll
                for (int bj = 0; bj < 2; ++bj)
#pragma unroll
                    for (int e = 0; e < 8; ++e) rsc[bj][e] = __shfl(rs, bj * 32 + 8 * fq + e);
            } else {
#pragma unroll
                for (int bj = 0; bj < 2; ++bj)
#pragma unroll
                    for (int e = 0; e < 8; ++e) rsc[bj][e] = 1.0f;
            }
            const bool act = a.ssp != nullptr && u.pm >= 2;
#pragma unroll
            for (int ai = 0; ai < 2; ++ai)
#pragma unroll
                for (int m = 0; m < 4; ++m) { bf16_t* rowp = a.O + (size_t)(row0 + ai * HALF + m * 16) * a.ldc + col0;
#pragma unroll
                    for (int bj = 0; bj < 2; ++bj) {
                        f32x4 v0 = acc[ai][bj][m][0], v1 = acc[ai][bj][m][1];
                        v0 = v0 * (f32x4){rsc[bj][0], rsc[bj][1], rsc[bj][2], rsc[bj][3]}; v1 = v1 * (f32x4){rsc[bj][4], rsc[bj][5], rsc[bj][6], rsc[bj][7]};
                        if (act) { v0 = gelu4(v0); v1 = gelu4(v1); }
                        store8(rowp + bj * HALF, v0, v1); } }
        } else if constexpr (MODE == E_RESID) {
#pragma unroll
            for (int ai = 0; ai < 2; ++ai) {
                u32x4 xw[4][2];
#pragma unroll
                for (int m = 0; m < 4; ++m)
#pragma unroll
                    for (int bj = 0; bj < 2; ++bj) xw[m][bj] = *(const u32x4*)(a.xb + (size_t)(row0 + ai * HALF + m * 16) * D + col0 + bj * HALF);
                asm volatile("" ::: "memory");
#pragma unroll
                for (int m = 0; m < 4; ++m) { const int row = row0 + ai * HALF + m * 16; const size_t off = (size_t)row * D + col0; float ss = 0.f;
#pragma unroll
                    for (int bj = 0; bj < 2; ++bj) { const u32x4 w = xw[m][bj];
                        const f32x4 v0 = (f32x4){bflo(w.x), bfhi(w.x), bflo(w.y), bfhi(w.y)} + acc[ai][bj][m][0], v1 = (f32x4){bflo(w.z), bfhi(w.z), bflo(w.w), bfhi(w.w)} + acc[ai][bj][m][1];
                        store8(a.xb + off + bj * HALF, v0, v1);
                        ss += (v0[0] * v0[0] + v0[1] * v0[1]) + (v0[2] * v0[2] + v0[3] * v0[3]) + (v1[0] * v1[0] + v1[1] * v1[1]) + (v1[2] * v1[2] + v1[3] * v1[3]); }
                    ss += __shfl_xor(ss, 16); ss += __shfl_xor(ss, 32);
                    if (fq == 0) a.sspo[(size_t)row * 16 + u.pn * 4 + wc] = ss; }
            }
        } else if constexpr (MODE == E_SWIGLU) {
            const int ocol = u.pn * HALF + wc * 32 + 8 * fq;
            float rs8[2][4]; if (a.rstab) row_rs8_lds(a.rstab, wr, fr, rs8); else row_rs8(a.ssp, row0, fq, rs8);
#pragma unroll
            for (int ai = 0; ai < 2; ++ai)
#pragma unroll
                for (int m = 0; m < 4; ++m) { const int row = row0 + ai * HALF + m * 16; const float rs = rs8[ai][m];
                    const f32x4 g0 = acc[ai][0][m][0] * rs, g1 = acc[ai][0][m][1] * rs, u0 = acc[ai][1][m][0] * rs, u1 = acc[ai][1][m][1] * rs;
                    store8(a.O + (size_t)row * a.ldc + ocol, g0 * sigmoid4(g0) * u0, g1 * sigmoid4(g1) * u1); }
        } else {
            float sc = a.cscale; bool gelu = false;
            if constexpr (MODE == E_INPROJ) { sc = (u.pn < 2) ? 0.125f : 1.0f; gelu = (u.pn == 4 || u.pn == 5); }
            if constexpr (MODE == E_INPROJ || MODE == E_GATE || MODE == E_ROWSCALE) {
                float rs8[2][4];
                if (a.rstab) row_rs8_lds(a.rstab, wr, fr, rs8); else if (a.ssp) row_rs8(a.ssp, row0, fq, rs8); else {
#pragma unroll
                    for (int ai = 0; ai < 2; ++ai)
#pragma unroll
                        for (int m = 0; m < 4; ++m) rs8[ai][m] = 1.0f; }
#pragma unroll
                for (int ai = 0; ai < 2; ++ai)
#pragma unroll
                    for (int m = 0; m < 4; ++m) { const int row = row0 + ai * HALF + m * 16; const float rs = sc * rs8[ai][m];
#pragma unroll
                        for (int bj = 0; bj < 2; ++bj) { const size_t off = (size_t)row * a.ldc + col0 + bj * HALF;
                            f32x4 v0 = acc[ai][bj][m][0] * rs, v1 = acc[ai][bj][m][1] * rs;
                            if constexpr (MODE == E_INPROJ) { if (gelu) { v0 = gelu4(v0); v1 = gelu4(v1); } }
                            else if constexpr (MODE == E_GATE) { v0 = sigmoid4(v0); v1 = sigmoid4(v1); }
                            store8(a.O + off, v0, v1); } }
            } else {
#pragma unroll
                for (int ai = 0; ai < 2; ++ai) {
                    u32x4 gw[4][2], pw[4][2];
#pragma unroll
                    for (int m = 0; m < 4; ++m)
#pragma unroll
                        for (int bj = 0; bj < 2; ++bj) { const size_t off = (size_t)(row0 + ai * HALF + m * 16) * a.ldc + col0 + bj * HALF;
                            gw[m][bj] = *(const u32x4*)(a.G + off); if constexpr (MODE == E_BRN) pw[m][bj] = *(const u32x4*)(a.O + off); }
                    asm volatile("" ::: "memory");
#pragma unroll
                    for (int m = 0; m < 4; ++m)
#pragma unroll
                        for (int bj = 0; bj < 2; ++bj) { const size_t off = (size_t)(row0 + ai * HALF + m * 16) * a.ldc + col0 + bj * HALF; const u32x4 g = gw[m][bj];
                            f32x4 v0 = acc[ai][bj][m][0] * (f32x4){bflo(g.x), bfhi(g.x), bflo(g.y), bfhi(g.y)}, v1 = acc[ai][bj][m][1] * (f32x4){bflo(g.z), bfhi(g.z), bflo(g.w), bfhi(g.w)};
                            if constexpr (MODE == E_BRN) { const u32x4 q = pw[m][bj];
                                v0 = v0 + (f32x4){bflo(q.x), bfhi(q.x), bflo(q.y), bfhi(q.y)}; v1 = v1 + (f32x4){bflo(q.z), bfhi(q.z), bflo(q.w), bfhi(q.w)}; }
                            store8(a.O + off, v0, v1); }
                }
            }
        }
    }
};

template <class EpiT>
DI void gemm_phase(LAS unsigned char* lds, const Gemm g, const StaticOrder& S, const EpiT& E) {
    const int tid = fresh_tid(), wid = __builtin_amdgcn_readfirstlane(tid >> 6), lane = tid & 63, wr = wid >> 2, wc = wid & 3, fr = lane & 15, fq = lane >> 4;
    const int nt = g.K / BK;
    unsigned voffA[2], voffB[2];
#pragma unroll
    for (int i = 0; i < 2; ++i) { int R, C; stage_rc(tid * 16 + i * 8192, R, C); const int Rb = EpiT::PERM ? ((R & ~31) + perm32(R & 31)) : R;
        voffA[i] = (unsigned)(R * g.lda + C) * 2u; voffB[i] = (unsigned)(Rb * g.ldb + C) * 2u; }
    const size_t kstep = (size_t)(BK * 2);
    const size_t hstepA = (size_t)HALF * g.lda * 2, hstepB = (size_t)HALF * g.ldb * 2;
    const size_t tstepA = 2 * hstepA, tstepB = 2 * hstepB;
    const unsigned ldsw = (unsigned)wid * 1024u;
    const int aoff = lds_byte(wr * 64 + fr, fq * 8), boff = lds_byte(wc * 32 + fr, fq * 8);
#define PG8_SA(b, h) (((b) * 2 + (h)) * HTB)
#define PG8_SB(b, h) ((4 + (b) * 2 + (h)) * HTB)
#define PG8_STAGE(bufoff, gbase, voff) do { _Pragma("unroll") for (int _i = 0; _i < 2; ++_i) \
        __builtin_amdgcn_global_load_lds((const unsigned*)((const char*)(gbase) + (voff)[_i]), (LAS unsigned*)(lds + (bufoff) + ldsw + _i * 8192), 16, 0, 0); } while (0)
#define PG8_LDA(dst, b, h) do { _Pragma("unroll") for (int m = 0; m < 4; ++m) _Pragma("unroll") for (int k = 0; k < 2; ++k) dst[m][k] = *(const LAS bf16x8*)(lds + PG8_SA(b, h) + aoff + m * 2048 + k * 1024); } while (0)
#define PG8_LDB(dst, b, h) do { _Pragma("unroll") for (int n = 0; n < 2; ++n) _Pragma("unroll") for (int k = 0; k < 2; ++k) dst[n][k] = *(const LAS bf16x8*)(lds + PG8_SB(b, h) + boff + n * 2048 + k * 1024); } while (0)
#define PG8_MMA(ai, bj, At, Bt) do { __builtin_amdgcn_s_setprio(1); _Pragma("unroll") for (int m = 0; m < 4; ++m) _Pragma("unroll") for (int n = 0; n < 2; ++n) _Pragma("unroll") for (int k = 0; k < 2; ++k) \
        acc[ai][bj][m][n] = __builtin_amdgcn_mfma_f32_16x16x32_bf16(Bt[n][k], At[m][k], acc[ai][bj][m][n], 0, 0, 0); __builtin_amdgcn_s_setprio(0); } while (0)
#define PG8_WAIT_V(n) asm volatile("s_waitcnt vmcnt(" #n ")" ::: "memory")
#define PG8_WAIT_L(n) asm volatile("s_waitcnt lgkmcnt(" #n ")" ::: "memory")
#define PG8_BAR __builtin_amdgcn_s_barrier()
#define PG8_SCHED __builtin_amdgcn_sched_barrier(0)
    Unit cur, nxt; int ui = 0;
    if (!S.next(0, cur)) return;
    f32x4 acc[2][2][4][2];
#pragma unroll
    for (int a = 0; a < 2; ++a)
#pragma unroll
        for (int b = 0; b < 2; ++b)
#pragma unroll
            for (int m = 0; m < 4; ++m)
#pragma unroll
                for (int n = 0; n < 2; ++n) acc[a][b][m][n] = (f32x4){0.f, 0.f, 0.f, 0.f};
    bf16x8 At[4][2], B0[2][2], B1[2][2];
    const char* cA = (const char*)g.A + (size_t)cur.pm * tstepA; const char* cB = (const char*)g.Bt + (size_t)cur.pn * tstepB;
    PG8_STAGE(PG8_SB(0, 0), cB, voffB); PG8_STAGE(PG8_SB(0, 1), cB + hstepB, voffB); PG8_STAGE(PG8_SA(0, 0), cA, voffA); PG8_STAGE(PG8_SA(0, 1), cA + hstepA, voffA);
    if (wr == 1) PG8_BAR;
    PG8_WAIT_V(2); PG8_BAR;
    PG8_STAGE(PG8_SB(1, 0), cB + kstep, voffB); PG8_STAGE(PG8_SA(1, 0), cA + kstep, voffA); PG8_STAGE(PG8_SB(1, 1), cB + hstepB + kstep, voffB);
    PG8_WAIT_V(6); PG8_BAR;
    for (;;) {
        const bool has_next = S.next(ui + 1, nxt);
        const char* nA = has_next ? (const char*)g.A + (size_t)nxt.pm * tstepA : cA; const char* nB = has_next ? (const char*)g.Bt + (size_t)nxt.pn * tstepB : cB;
        for (int t = 0; t < nt; t += 2) {
            const bool last = (t == nt - 2);
            const char* a1 = cA + (size_t)(t + 1) * kstep;
            const char* a2 = last ? nA : cA + (size_t)(t + 2) * kstep; const char* b2 = last ? nB : cB + (size_t)(t + 2) * kstep;
            const char* a3 = a2 + kstep; const char* b3 = b2 + kstep;
            PG8_LDB(B0, 0, 0); PG8_LDB(B1, 0, 1); PG8_SCHED; PG8_LDA(At, 0, 0); PG8_STAGE(PG8_SA(1, 1), a1 + hstepA, voffA);
            PG8_WAIT_V(8); PG8_WAIT_L(0); PG8_BAR; PG8_MMA(0, 0, At, B0); PG8_MMA(0, 1, At, B1); PG8_BAR; PG8_SCHED;
            PG8_LDA(At, 0, 1); PG8_STAGE(PG8_SB(0, 0), b2, voffB); PG8_STAGE(PG8_SB(0, 1), b2 + hstepB, voffB); PG8_STAGE(PG8_SA(0, 0), a2, voffA);
            PG8_WAIT_V(8); PG8_WAIT_L(0); PG8_BAR; PG8_MMA(1, 0, At, B0); PG8_MMA(1, 1, At, B1); PG8_BAR; PG8_SCHED;
            PG8_LDB(B0, 1, 0); PG8_LDB(B1, 1, 1); PG8_SCHED; PG8_LDA(At, 1, 0); PG8_STAGE(PG8_SA(0, 1), a2 + hstepA, voffA);
            PG8_WAIT_V(8); PG8_WAIT_L(0); PG8_BAR; PG8_MMA(0, 0, At, B0); PG8_MMA(0, 1, At, B1); PG8_BAR; PG8_SCHED;
            PG8_LDA(At, 1, 1); PG8_STAGE(PG8_SB(1, 0), b3, voffB); PG8_STAGE(PG8_SB(1, 1), b3 + hstepB, voffB); PG8_STAGE(PG8_SA(1, 0), a3, voffA);
            PG8_WAIT_V(8); PG8_WAIT_L(0); PG8_BAR; PG8_MMA(1, 0, At, B0); PG8_MMA(1, 1, At, B1); PG8_BAR; PG8_SCHED;
        }
        if (wr == 0) PG8_BAR;
        E(acc, cur, wr, wc, fr, fq);
        if (!has_next) break;
#pragma unroll
        for (int a = 0; a < 2; ++a)
#pragma unroll
            for (int b = 0; b < 2; ++b)
#pragma unroll
                for (int m = 0; m < 4; ++m)
#pragma unroll
                    for (int n = 0; n < 2; ++n) acc[a][b][m][n] = (f32x4){0.f, 0.f, 0.f, 0.f};
        cur = nxt; cA = nA; cB = nB; ++ui;
        if (wr == 1) PG8_BAR;
    }
    PG8_WAIT_V(0);
    PG8_BAR;

}

struct UnitX { int pm, pn, job, k; };
struct JobP { const bf16_t* A; const bf16_t* Bt; int lda, ldb, nt; };
template <class Prog>
DI void gemm_stream(LAS unsigned char* lds, Prog& P) {
    const int tid = fresh_tid(), wid = __builtin_amdgcn_readfirstlane(tid >> 6), lane = tid & 63, wr = wid >> 2, wc = wid & 3, fr = lane & 15, fq = lane >> 4;
    const size_t kstep = (size_t)(BK * 2);
    const unsigned ldsw = (unsigned)wid * 1024u;
    const int aoff = lds_byte(wr * 64 + fr, fq * 8), boff = lds_byte(wc * 32 + fr, fq * 8);
#define PG8_VOFF(vA, vB, j) do { _Pragma("unroll") for (int _i = 0; _i < 2; ++_i) { int sR_, sC_; stage_rc(tid * 16 + _i * 8192, sR_, sC_); const int sRb_ = (sR_ & ~31) + perm32(sR_ & 31); \
        vA[_i] = (unsigned)(sR_ * (j).lda + sC_) * 2u; vB[_i] = (unsigned)(sRb_ * (j).ldb + sC_) * 2u; } } while (0)
    UnitX cur, nxt;
    if (!P.next(cur)) return;
    JobP jc = P.job(cur.job);
    unsigned voffA[2], voffB[2], voffAn[2], voffBn[2];
    PG8_VOFF(voffA, voffB, jc);
    unsigned hstepA = (unsigned)(HALF * jc.lda * 2), hstepB = (unsigned)(HALF * jc.ldb * 2), hstepAn, hstepBn;
    int nt = jc.nt;
    f32x4 acc[2][2][4][2];
#pragma unroll
    for (int a = 0; a < 2; ++a)
#pragma unroll
        for (int b = 0; b < 2; ++b)
#pragma unroll
            for (int m = 0; m < 4; ++m)
#pragma unroll
                for (int n = 0; n < 2; ++n) acc[a][b][m][n] = (f32x4){0.f, 0.f, 0.f, 0.f};
    bf16x8 At[4][2], B0[2][2], B1[2][2];
    const char* cA = (const char*)jc.A + (size_t)cur.pm * 2 * hstepA; const char* cB = (const char*)jc.Bt + (size_t)cur.pn * 2 * hstepB;
    PG8_STAGE(PG8_SB(0, 0), cB, voffB); PG8_STAGE(PG8_SB(0, 1), cB + hstepB, voffB); PG8_STAGE(PG8_SA(0, 0), cA, voffA); PG8_STAGE(PG8_SA(0, 1), cA + hstepA, voffA);
    if (wr == 1) PG8_BAR;
    PG8_WAIT_V(2); PG8_BAR;
    PG8_STAGE(PG8_SB(1, 0), cB + kstep, voffB); PG8_STAGE(PG8_SA(1, 0), cA + kstep, voffA); PG8_STAGE(PG8_SB(1, 1), cB + hstepB + kstep, voffB);
    PG8_WAIT_V(6); PG8_BAR;
    for (;;) {
        const bool has_next = P.next(nxt);
        const char* nA = cA; const char* nB = cB; int ntn = nt;
        hstepAn = hstepA; hstepBn = hstepB; voffAn[0] = voffA[0]; voffAn[1] = voffA[1]; voffBn[0] = voffB[0]; voffBn[1] = voffB[1];
        if (has_next) { const JobP jn = P.job(nxt.job); PG8_VOFF(voffAn, voffBn, jn); hstepAn = (unsigned)(HALF * jn.lda * 2); hstepBn = (unsigned)(HALF * jn.ldb * 2); ntn = jn.nt;
            nA = (const char*)jn.A + (size_t)nxt.pm * 2 * hstepAn; nB = (const char*)jn.Bt + (size_t)nxt.pn * 2 * hstepBn; }
        for (int t = 0; t < nt; t += 2) {
            const bool last = (t == nt - 2);
            const char* a1 = cA + (size_t)(t + 1) * kstep;
            const char* a2 = last ? nA : cA + (size_t)(t + 2) * kstep; const char* b2 = last ? nB : cB + (size_t)(t + 2) * kstep;
            const char* a3 = a2 + kstep; const char* b3 = b2 + kstep;
            const unsigned hA2 = last ? hstepAn : hstepA, hB2 = last ? hstepBn : hstepB;
            unsigned vA2[2], vB2[2];
            vA2[0] = last ? voffAn[0] : voffA[0]; vA2[1] = last ? voffAn[1] : voffA[1]; vB2[0] = last ? voffBn[0] : voffB[0]; vB2[1] = last ? voffBn[1] : voffB[1];
            PG8_LDB(B0, 0, 0); PG8_LDB(B1, 0, 1); PG8_SCHED; PG8_LDA(At, 0, 0); PG8_STAGE(PG8_SA(1, 1), a1 + hstepA, voffA);
            PG8_WAIT_V(8); PG8_WAIT_L(0); PG8_BAR; PG8_MMA(0, 0, At, B0); PG8_MMA(0, 1, At, B1); PG8_BAR; PG8_SCHED;
            PG8_LDA(At, 0, 1); PG8_STAGE(PG8_SB(0, 0), b2, vB2); PG8_STAGE(PG8_SB(0, 1), b2 + hB2, vB2); PG8_STAGE(PG8_SA(0, 0), a2, vA2);
            PG8_WAIT_V(8); PG8_WAIT_L(0); PG8_BAR; PG8_MMA(1, 0, At, B0); PG8_MMA(1, 1, At, B1); PG8_BAR; PG8_SCHED;
            PG8_LDB(B0, 1, 0); PG8_LDB(B1, 1, 1); PG8_SCHED; PG8_LDA(At, 1, 0); PG8_STAGE(PG8_SA(0, 1), a2 + hA2, vA2);
            PG8_WAIT_V(8); PG8_WAIT_L(0); PG8_BAR; PG8_MMA(0, 0, At, B0); PG8_MMA(0, 1, At, B1); PG8_BAR; PG8_SCHED;
            PG8_LDA(At, 1, 1); PG8_STAGE(PG8_SB(1, 0), b3, vB2); PG8_STAGE(PG8_SB(1, 1), b3 + hB2, vB2); PG8_STAGE(PG8_SA(1, 0), a3, vA2);
            PG8_WAIT_V(8); PG8_WAIT_L(0); PG8_BAR; PG8_MMA(1, 0, At, B0); PG8_MMA(1, 1, At, B1); PG8_BAR; PG8_SCHED;
        }
        if (wr == 0) PG8_BAR;
        P.epilogue(acc, cur, wr, wc, fr, fq);
        if (!has_next) break;
#pragma unroll
        for (int a = 0; a < 2; ++a)
#pragma unroll
            for (int b = 0; b < 2; ++b)
#pragma unroll
                for (int m = 0; m < 4; ++m)
#pragma unroll
                    for (int n = 0; n < 2; ++n) acc[a][b][m][n] = (f32x4){0.f, 0.f, 0.f, 0.f};
        cur = nxt; cA = nA; cB = nB; nt = ntn; hstepA = hstepAn; hstepB = hstepBn; voffA[0] = voffAn[0]; voffA[1] = voffAn[1]; voffB[0] = voffBn[0]; voffB[1] = voffBn[1];
        if (wr == 1) PG8_BAR;
    }
    PG8_WAIT_V(0);
    PG8_BAR;
#undef PG8_VOFF
}
#undef PG8_SA
#undef PG8_SB
#undef PG8_STAGE
#undef PG8_LDA
#undef PG8_LDB
#undef PG8_MMA
#undef PG8_WAIT_V
#undef PG8_WAIT_L
#undef PG8_BAR
#undef PG8_SCHED
}

constexpr int NWAVES = 8, NTHREADS = 512;
constexpr int LDS_BYTES = 147456;

DI float wave_sum(float v) {
#pragma unroll
    for (int o = 1; o < 64; o <<= 1) v += __shfl_xor(v, o);
    return v;
}

DI void transpose_item(const float* W, int K, int N, const float* gk, bf16_t* WT, int dst_row0, int k0, int n0, LAS float* scr, int lane) {
    f32x4 wv[8]; float gv[8];
#pragma unroll
    for (int i = 0; i < 8; ++i) { const int kk = 8 * i + (lane >> 3), nq = (lane & 7) * 4; wv[i] = *(const f32x4*)(W + (size_t)(k0 + kk) * N + n0 + nq); gv[i] = gk ? gk[k0 + kk] : 1.0f; }
    asm volatile("" ::: "memory");
#pragma unroll
    for (int i = 0; i < 8; ++i) { const int kk = 8 * i + (lane >> 3), nq = (lane & 7) * 4; const f32x4 w = wv[i] * gv[i];
        LAS float* d = scr + kk * 33 + nq; d[0] = w[0]; d[1] = w[1]; d[2] = w[2]; d[3] = w[3]; }
    asm volatile("s_waitcnt lgkmcnt(0)" ::: "memory");
    const int c = lane & 7;
#pragma unroll
    for (int j = 0; j < 4; ++j) { const int n = (lane >> 3) + 8 * j; const LAS float* s = scr + (8 * c) * 33 + n;
        u32x4 o; o.x = pkbf(s[0 * 33], s[1 * 33]); o.y = pkbf(s[2 * 33], s[3 * 33]); o.z = pkbf(s[4 * 33], s[5 * 33]); o.w = pkbf(s[6 * 33], s[7 * 33]);
        *(u32x4*)(WT + (size_t)(dst_row0 + n) * K + k0 + 8 * c) = o; }
    asm volatile("s_waitcnt lgkmcnt(0)" ::: "memory");
}

struct Args { const float* in[22]; float* out; unsigned char* ws; };
constexpr int PTR_OFF = 131072;
DI unsigned long long ldq(LAS unsigned char* lds, int i) {
    unsigned off = (unsigned)(PTR_OFF + 8 * i); asm volatile("" : "+v"(off));
    const unsigned long long v = *(const LAS unsigned long long*)(lds + off);
    const unsigned lo = __builtin_amdgcn_readfirstlane((unsigned)v), hi = __builtin_amdgcn_readfirstlane((unsigned)(v >> 32));
    return ((unsigned long long)hi << 32) | lo;
}
#define GAS __attribute__((address_space(1)))
#define INP(i) ((const float*)(const GAS float*)ldq(lds, (i)))
#define OUTP ((float*)(GAS float*)ldq(lds, 22))
#define WSP ((unsigned char*)(GAS unsigned char*)ldq(lds, 23))

DI void prep_weights(int l, LAS unsigned char* lds, int gw, int NGW, int wave, int lane, int part = 0) {
    LAS float* scr = (LAS float*)(lds + wave * 16384);
    unsigned char* ws = WSP;
    constexpr int I_IN = 16 * 224, I_BR = 8 * 32, I_SQ = 16 * 32, I_GU = 16 * 88, I_DN = 44 * 32;
    constexpr int NSQ = 7; constexpr int NITEMS = I_IN + 3 * I_BR + NSQ * I_SQ + 2 * I_GU + I_DN;
    const int it_lo = part == 2 ? NITEMS - I_DN : 0, it_hi = part == 1 ? NITEMS - I_DN : NITEMS;
    for (int it = it_lo + gw; it < it_hi; it += NGW) {
        int r = it;
        if (r < I_IN) { const int kb = r / 224, nb = r % 224, n0 = nb * 32, seg = n0 >> 9;
            int base;
            switch (seg) { case 0: base = 0; break; case 1: base = 512; break; case 2: base = 3072; break; case 3: base = 1024; break; case 4: base = 3584; break;
                           case 5: base = 1536; break; case 6: base = 2048; break; case 7: base = 2560; break; default: base = seg * 512; break; }
            transpose_item(INP(3) + (size_t)l * D * INC, D, INC, INP(2) + l * D, (bf16_t*)(ws + WS_WIN), base + (n0 & 511), kb * 64, n0, scr, lane); continue; }
        r -= I_IN;
        if (r < 3 * I_BR) { const int n = r / I_BR, q = r % I_BR, kb = q / 32, nb = q % 32;
            transpose_item(INP(9) + ((size_t)l * 3 + n) * 512 * D, 512, D, nullptr, (bf16_t*)(ws + WS_WB) + (size_t)n * D * 512, nb * 32, kb * 64, nb * 32, scr, lane); continue; }
        r -= 3 * I_BR;
        if (r < NSQ * I_SQ) { const int w = r / I_SQ, q = r % I_SQ, kb = q / 32, nb = q % 32;
            const float* src; const float* gk = nullptr; size_t dst;
            if (l == 0 && w >= 5) {
                transpose_item(INP(w == 5 ? 14 : 15) + (size_t)D * D, D, D, nullptr, (bf16_t*)(ws + (w == 5 ? WS_WK1 : WS_WV1)), nb * 32, kb * 64, nb * 32, scr, lane); continue; }
            if (w >= 5 || (l == 1 && (w == 2 || w == 3))) continue;
            switch (w) { case 0: src = INP(10); dst = WS_WOUT; break; case 1: src = INP(13); dst = WS_WQ; gk = INP(11) + l * D; break; case 2: src = INP(14); dst = WS_WK; break;
                         case 3: src = INP(15); dst = WS_WV; break; default: src = INP(16); dst = WS_WOX; break; }
            transpose_item(src + (size_t)l * D * D, D, D, gk, (bf16_t*)(ws + dst), nb * 32, kb * 64, nb * 32, scr, lane); continue; }
        r -= NSQ * I_SQ;
        if (r < 2 * I_GU) { const int w = r / I_GU, q = r % I_GU, kb = q / 88, nb = q % 88, n0 = nb * 32;
            transpose_item(INP(18 + w) + (size_t)l * D * FF, D, FF, INP(17) + l * D, (bf16_t*)(ws + WS_WGU), (n0 >> 7) * 256 + w * 128 + (n0 & 127), kb * 64, n0, scr, lane); continue; }
        r -= 2 * I_GU;
        { const int kb = r / 32, nb = r % 32;
          transpose_item(INP(20) + (size_t)l * FF * D, FF, D, nullptr, (bf16_t*)(ws + WS_WD), nb * 32, kb * 64, nb * 32, scr, lane); }
    }
    if (l == 0) {
        for (int row2 = gw; row2 < 2 * NBATCH * 256; row2 += NGW) {
            const int lay = row2 >> 10, row = row2 & 1023; const float* mg = INP(12) + lay * D;
            const f32x4* xr = (const f32x4*)(INP(1) + (size_t)row * D) + lane; f32x4 v[4]; float s = 0.f;
#pragma unroll
            for (int j = 0; j < 4; ++j) { v[j] = xr[64 * j]; s += (v[j][0] * v[j][0] + v[j][1] * v[j][1]) + (v[j][2] * v[j][2] + v[j][3] * v[j][3]); }
            const float rs = 1.0f / sqrtf(wave_sum(s) * (1.0f / D) + RMS_EPS);
            u32x2* o = (u32x2*)((bf16_t*)(ws + (lay ? WS_MB1 : WS_MB)) + (size_t)row * D) + lane;
#pragma unroll
            for (int j = 0; j < 4; ++j) { const f32x4 gv = *((const f32x4*)mg + lane + 64 * j); u32x2 w; w.x = pkbf(v[j][0] * rs * gv[0], v[j][1] * rs * gv[1]); w.y = pkbf(v[j][2] * rs * gv[2], v[j][3] * rs * gv[3]); o[64 * j] = w; }
        }
    }
}

DI void prep_x(LAS unsigned char* lds, int gw, int NGW, int lane) {
    unsigned char* ws = WSP; const float* xin = INP(0);
    float* ssp = (float*)(ws + WS_SSP);
    for (int row = gw; row < M; row += NGW) {
        const f32x4* xr = (const f32x4*)(xin + (size_t)row * D) + lane; f32x4 v[4]; float s = 0.f;
#pragma unroll
        for (int j = 0; j < 4; ++j) { v[j] = xr[64 * j]; s += (v[j][0] * v[j][0] + v[j][1] * v[j][1]) + (v[j][2] * v[j][2] + v[j][3] * v[j][3]); }
        s = wave_sum(s);
        u32x2* o = (u32x2*)((bf16_t*)(ws + WS_XB) + (size_t)row * D) + lane;
#pragma unroll
        for (int j = 0; j < 4; ++j) { u32x2 w; w.x = pkbf(v[j][0], v[j][1]); w.y = pkbf(v[j][2], v[j][3]); o[64 * j] = w; }
        if (lane < 16) ssp[(size_t)row * 16 + lane] = lane == 0 ? s : 0.f;
    }
}

DI void final_norm(LAS unsigned char* lds, int gw, int NGW, int lane) {
    const float* fg = INP(21); float* outp = OUTP; const float* ssp = (const float*)(WSP + WS_SSP);
    for (int row = gw; row < M; row += NGW) {
        f32x4* xr = (f32x4*)(outp + (size_t)row * D) + lane; const u32x2* xbr = (const u32x2*)((const bf16_t*)(WSP + WS_XB) + (size_t)row * D) + lane;
        float s = lane < 16 ? ssp[(size_t)row * 16 + lane] : 0.f; s = wave_sum(s);
        const float rs = 1.0f / sqrtf(s * (1.0f / D) + RMS_EPS);
#pragma unroll
        for (int j = 0; j < 4; ++j) { const f32x4 gv = *((const f32x4*)fg + lane + 64 * j); const u32x2 w = xbr[64 * j]; xr[64 * j] = (f32x4){bflo(w.x), bfhi(w.x), bflo(w.y), bfhi(w.y)} * rs * gv; }
    }
}

DI void sb_attn_item(bf16_t* p, const bf16_t* T, int item, int lane) {
    const int b = item >> 10, h = (item >> 7) & 7, qb = item & 127;
    const int hl = lane >> 5, li = lane & 31;
    const size_t rowbase = (size_t)b * SEQ;
    const int kperm = (li & 16) | ((li & 4) << 1) | ((li & 8) >> 1) | (li & 3);
    const bf16_t* qrow = p + (rowbase + qb * 32 + li) * PC + h * 64 + 8 * hl;
    bf16x8 qf[4];
#pragma unroll
    for (int kk = 0; kk < 4; ++kk) qf[kk] = *(const bf16x8*)(qrow + 16 * kk);
    bf16x8 U[2];
#pragma unroll
    for (int c = 0; c < 2; ++c)
#pragma unroll
        for (int e = 0; e < 8; ++e) U[c][e] = (16 * c + 8 * hl + e >= kperm) ? (short)0x3f80 : (short)0;
    f32x16 o0, o1;
#pragma unroll
    for (int r = 0; r < 16; ++r) { o0[r] = 0.f; o1[r] = 0.f; }
    float carry = 0.f;
    const bf16_t* vt0 = T + (size_t)(h * 64 + li) * M + rowbase + 8 * hl;
    for (int kb = qb; kb >= 0; --kb) {
        const int s0 = kb * 32;
        const bf16_t* krow = p + (rowbase + s0 + kperm) * PC + 512 + h * 64 + 8 * hl;
        bf16x8 kf[4], vf[4];
#pragma unroll
        for (int kk = 0; kk < 4; ++kk) kf[kk] = *(const bf16x8*)(krow + 16 * kk);
#pragma unroll
        for (int c = 0; c < 2; ++c) { vf[c] = *(const bf16x8*)(vt0 + s0 + 16 * c); vf[2 + c] = *(const bf16x8*)(vt0 + (size_t)32 * M + s0 + 16 * c); }
        f32x16 z;
#pragma unroll
        for (int r = 0; r < 16; ++r) z[r] = 0.f;
#pragma unroll
        for (int kk = 0; kk < 4; ++kk) z = MFMA32(kf[kk], qf[kk], z);
        const bool diag = (kb == qb);
        float Lv[16];
#pragma unroll
        for (int r = 0; r < 16; ++r) {
            const float zz = z[r];
            float L = fmaxf(zz, 0.f) + LN2 * __builtin_amdgcn_logf(1.0f + __builtin_amdgcn_exp2f(-fabsf(zz) * LOG2E));
            if (diag && !(16 * (r >> 3) + 8 * hl + (r & 7) < li)) L = 0.f;
            Lv[r] = L;
        }
        bf16x8 Lh[2], Ll[2];
#pragma unroll
        for (int c = 0; c < 2; ++c) { u32x4 wh, wl;
#pragma unroll
            for (int e = 0; e < 4; ++e) { const float a0 = Lv[8 * c + 2 * e], a1 = Lv[8 * c + 2 * e + 1]; const unsigned hp = pkbf(a0, a1); wh[e] = hp; wl[e] = pkbf(a0 - bflo(hp), a1 - bfhi(hp)); }
            Lh[c] = __builtin_bit_cast(bf16x8, wh); Ll[c] = __builtin_bit_cast(bf16x8, wl); }
        f32x16 C;
#pragma unroll
        for (int r = 0; r < 16; ++r) C[r] = carry;
        C = MFMA32(U[0], Lh[0], C); C = MFMA32(U[1], Lh[1], C); C = MFMA32(U[0], Ll[0], C); C = MFMA32(U[1], Ll[1], C);
        bf16x8 pf[2];
#pragma unroll
        for (int c = 0; c < 2; ++c) { u32x4 w;
#pragma unroll
            for (int e = 0; e < 4; ++e) { float a0, a1; { const int r = 8 * c + 2 * e; a0 = __builtin_amdgcn_exp2f((z[r] - C[r]) * LOG2E); a1 = __builtin_amdgcn_exp2f((z[r + 1] - C[r + 1]) * LOG2E);
                    if (diag) { if (!(16 * c + 8 * hl + 2 * e < li)) a0 = 0.f; if (!(16 * c + 8 * hl + 2 * e + 1 < li)) a1 = 0.f; } }
                w[e] = pkbf(a0, a1); }
            pf[c] = __builtin_bit_cast(bf16x8, w); }
        carry = __shfl(C[0], li);
        o0 = MFMA32(vf[0], pf[0], o0); o0 = MFMA32(vf[1], pf[1], o0);
        o1 = MFMA32(vf[2], pf[0], o1); o1 = MFMA32(vf[3], pf[1], o1);
        if (__all(carry > SB_EXIT)) break;
    }
    bf16_t* orow = p + (rowbase + qb * 32 + li) * PC + h * 64 + 4 * hl;
#pragma unroll
    for (int g = 0; g < 4; ++g) {
        u32x2 w0, w1; w0.x = pkbf(o0[4 * g], o0[4 * g + 1]); w0.y = pkbf(o0[4 * g + 2], o0[4 * g + 3]); w1.x = pkbf(o1[4 * g], o1[4 * g + 1]); w1.y = pkbf(o1[4 * g + 2], o1[4 * g + 3]);
        *(u32x2*)(orow + 8 * g) = w0; *(u32x2*)(orow + 32 + 8 * g) = w1; }
}

DI void sgu_item(int l, bf16_t* p, const bf16_t* T, int item, LAS unsigned char* lds, int tid, int wave, int lane) {
    const int g = item & 3, n = (item >> 2) & 31, b = item >> 7;
    const size_t tok0 = (size_t)b * SEQ + n * 128;
    const bf16_t* zv = T + (size_t)512 * M;
    LAS float* red = (LAS float*)lds;
    LAS float* mean = (LAS float*)(lds + 8192);
    LAS float* rstd = (LAS float*)(lds + 8192 + 512);
    {
        float s0 = 0.f, s1 = 0.f, q0 = 0.f, q1 = 0.f;
        const bf16_t* src = zv + (size_t)(wave * 64) * M + tok0 + 2 * lane;
#pragma unroll 1
        for (int jb = 0; jb < 64; jb += 16) {
            unsigned wv[16];
#pragma unroll
            for (int j = 0; j < 16; ++j) wv[j] = *(const unsigned*)(src + (size_t)(jb + j) * M);
            asm volatile("" ::: "memory");
#pragma unroll
            for (int j = 0; j < 16; ++j) { const float a0 = bflo(wv[j]), a1 = bfhi(wv[j]); s0 += a0; s1 += a1; q0 += a0 * a0; q1 += a1 * a1; }
        }
        *(LAS f32x4*)(red + (wave * 64 + lane) * 4) = (f32x4){s0, q0, s1, q1};
    }
    __syncthreads();
    if (tid < 128) { float s = 0.f, q = 0.f;
#pragma unroll
        for (int w = 0; w < 8; ++w) { const f32x2 v = *(LAS f32x2*)(red + (w * 64 + (tid >> 1)) * 4 + (tid & 1) * 2); s += v.x; q += v.y; }
        const float mu = s * (1.0f / 512.0f), var = fmaxf(q * (1.0f / 512.0f) - mu * mu, 0.f);
        mean[tid] = mu; rstd[tid] = 1.0f / sqrtf(var + LN_EPS); }
    __syncthreads();
    const int cblk = wave & 3, th = wave >> 2, hl = lane >> 5, li = lane & 31;
    const int cch = g * 128 + cblk * 32 + li;
    const float lg = INP(4)[l * 512 + cch], lb = INP(5)[l * 512 + cch];
    const bf16_t* arow = zv + (size_t)cch * M + tok0 + 8 * hl;
    const float* wsp = INP(6) + ((size_t)(l * 4 + g) * 128) * 128;
    f32x16 acc0, acc1;
#pragma unroll
    for (int r = 0; r < 16; ++r) { acc0[r] = 0.f; acc1[r] = 0.f; }
#pragma unroll
    for (int hf = 0; hf < 2; ++hf) if (hf == 0 || th) {
        u32x4 raw[4]; f32x4 wv[4][2][2];
#pragma unroll
        for (int k4 = 0; k4 < 4; ++k4) { const int kk = 4 * hf + k4, sb = 16 * kk + 8 * hl;
            raw[k4] = *(const u32x4*)(arow + 16 * kk);
#pragma unroll
            for (int tb = 0; tb < 2; ++tb) { const int t = th * 64 + tb * 32 + li; wv[k4][tb][0] = *(const f32x4*)(wsp + (size_t)t * 128 + sb); wv[k4][tb][1] = *(const f32x4*)(wsp + (size_t)t * 128 + sb + 4); } }
        asm volatile("" ::: "memory");
#pragma unroll
        for (int k4 = 0; k4 < 4; ++k4) { const int kk = 4 * hf + k4, sb = 16 * kk + 8 * hl;
            const f32x4 m0 = *(LAS f32x4*)(mean + sb), m1 = *(LAS f32x4*)(mean + sb + 4), r0 = *(LAS f32x4*)(rstd + sb), r1 = *(LAS f32x4*)(rstd + sb + 4);
            const u32x4 rw = raw[k4]; u32x4 aw;
            aw.x = pkbf((bflo(rw.x) - m0[0]) * r0[0] * lg + lb, (bfhi(rw.x) - m0[1]) * r0[1] * lg + lb);
            aw.y = pkbf((bflo(rw.y) - m0[2]) * r0[2] * lg + lb, (bfhi(rw.y) - m0[3]) * r0[3] * lg + lb);
            aw.z = pkbf((bflo(rw.z) - m1[0]) * r1[0] * lg + lb, (bfhi(rw.z) - m1[1]) * r1[1] * lg + lb);
            aw.w = pkbf((bflo(rw.w) - m1[2]) * r1[2] * lg + lb, (bfhi(rw.w) - m1[3]) * r1[3] * lg + lb);
            const bf16x8 af = __builtin_bit_cast(bf16x8, aw);
#pragma unroll
            for (int tb = 0; tb < 2; ++tb) { const f32x4 w0 = wv[k4][tb][0], w1 = wv[k4][tb][1];
                u32x4 bw; bw.x = pkbf(w0[0], w0[1]); bw.y = pkbf(w0[2], w0[3]); bw.z = pkbf(w1[0], w1[1]); bw.w = pkbf(w1[2], w1[3]);
                const bf16x8 bfr = __builtin_bit_cast(bf16x8, bw);
                if (tb == 0) acc0 = MFMA32(af, bfr, acc0); else acc1 = MFMA32(af, bfr, acc1); } }
    }
#pragma unroll
    for (int tb = 0; tb < 2; ++tb) {
        const int t = th * 64 + tb * 32 + li; const float bs = INP(7)[(l * 4 + g) * 128 + t];
        bf16_t* urow = p + (tok0 + t) * PC + 1024 + g * 128 + cblk * 32 + 4 * hl;
        u32x2 uws[4];
#pragma unroll
        for (int q = 0; q < 4; ++q) uws[q] = *(const u32x2*)(urow + 8 * q);
#pragma unroll
        for (int q = 0; q < 4; ++q) { const u32x2 uw = uws[q];
            float v0, v1, v2, v3;
            if (tb == 0) { v0 = acc0[4 * q]; v1 = acc0[4 * q + 1]; v2 = acc0[4 * q + 2]; v3 = acc0[4 * q + 3]; } else { v0 = acc1[4 * q]; v1 = acc1[4 * q + 1]; v2 = acc1[4 * q + 2]; v3 = acc1[4 * q + 3]; }
            u32x2 ow; ow.x = pkbf(bflo(uw.x) * (v0 + bs), bfhi(uw.x) * (v1 + bs)); ow.y = pkbf(bflo(uw.y) * (v2 + bs), bfhi(uw.y) * (v3 + bs));
            *(u32x2*)(urow + 8 * q) = ow; }
    }
    __syncthreads();
}

DI void conv_phase(int l, bf16_t* p, LAS unsigned char* lds, int gtid, int NGT) {
    const float* cw = INP(8) + (size_t)l * 3 * 512;
    for (int it = gtid; it < M * 64; it += NGT) {
        const int row = it >> 6, c8 = (it & 63) * 8, t = row & (SEQ - 1);
        bf16_t* pr = p + (size_t)row * PC;
        float accv[8];
#pragma unroll
        for (int e = 0; e < 8; ++e) accv[e] = 0.f;
        u32x4 ccv[3], cxv[3];
#pragma unroll
        for (int j = 0; j < 3; ++j) { const int dt = (t - (2 - j) >= 0) ? 2 - j : 0;
            ccv[j] = *(const u32x4*)(pr - (size_t)dt * PC + 2048 + c8); cxv[j] = *(const u32x4*)(pr - (size_t)dt * PC + 2560 + c8); }
        const u32x4 cb = *(const u32x4*)(pr + 1536 + c8);
        asm volatile("" ::: "memory");
#pragma unroll
        for (int j = 0; j < 3; ++j) { const int dt = 2 - j;
            if (t - dt >= 0) {
                const u32x4 cc = ccv[j], cx = cxv[j];
                const f32x4 w0 = *(const f32x4*)(cw + j * 512 + c8), w1 = *(const f32x4*)(cw + j * 512 + c8 + 4);
                accv[0] += w0[0] * bflo(cc.x) * bflo(cx.x); accv[1] += w0[1] * bfhi(cc.x) * bfhi(cx.x); accv[2] += w0[2] * bflo(cc.y) * bflo(cx.y); accv[3] += w0[3] * bfhi(cc.y) * bfhi(cx.y);
                accv[4] += w1[0] * bflo(cc.z) * bflo(cx.z); accv[5] += w1[1] * bfhi(cc.z) * bfhi(cx.z); accv[6] += w1[2] * bflo(cc.w) * bflo(cx.w); accv[7] += w1[3] * bfhi(cc.w) * bfhi(cx.w); } }
        u32x4 o; o.x = pkbf(bflo(cb.x) * accv[0], bfhi(cb.x) * accv[1]); o.y = pkbf(bflo(cb.y) * accv[2], bfhi(cb.y) * accv[3]); o.z = pkbf(bflo(cb.z) * accv[4], bfhi(cb.z) * accv[5]); o.w = pkbf(bflo(cb.w) * accv[6], bfhi(cb.w) * accv[7]);
        *(u32x4*)(pr + 1536 + c8) = o;
    }
}

DI void xattn_wg(const bf16_t* qx, const bf16_t* memK, const bf16_t* memVT, bf16_t* ox, int item, int tid, int wave, int lane, LAS unsigned char* lds) {
    const int b = item >> 6, h = (item >> 4) & 3, qb = (item & 15) * 8 + wave;
    const int hl = lane >> 5, li = lane & 31;
    const size_t qrow = (size_t)b * SEQ + qb * 32 + li;
    bf16x8 qf[16];
#pragma unroll
    for (int kk = 0; kk < 16; ++kk) qf[kk] = *(const bf16x8*)(qx + qrow * D + h * 256 + 16 * kk + 8 * hl);
    const int sr = tid >> 4, sp0 = (tid & 15) * 2;
    const int kperm_sr = (sr & 16) | ((sr & 4) << 1) | ((sr & 8) >> 1) | (sr & 3);
    const bf16_t* kbase = memK + (size_t)(b * 256) * D + h * 256;
    const bf16_t* vbase = memVT + (size_t)(h * 256) * D + b * 256;
    u32x4 st[2], sn[2];
#define XA_LOAD(R, c) do { if ((c) < 8) { _Pragma("unroll") for (int e = 0; e < 2; ++e) R[e] = *(const u32x4*)(kbase + (size_t)((c) * 32 + sr) * D + (sp0 + e) * 8); } \
                           else { _Pragma("unroll") for (int e = 0; e < 2; ++e) R[e] = *(const u32x4*)(vbase + (size_t)(((c) - 8) * 32 + sr) * D + (sp0 + e) * 8); } } while (0)
#define XA_STORE(R, c) do { const int rl = (c) < 8 ? kperm_sr : sr; _Pragma("unroll") for (int e = 0; e < 2; ++e) { const int p = sp0 + e; \
                           *(LAS u32x4*)(lds + ((c) & 1) * 16384 + (((p >> 1) * 64) + (p & 1) * 32 + rl) * 16) = R[e]; } } while (0)
    XA_LOAD(st, 0); XA_STORE(st, 0); XA_LOAD(st, 1);
    __syncthreads();
    f32x16 S[8];
#pragma unroll
    for (int c = 0; c < 8; ++c) {
        XA_LOAD(sn, c + 2);
        f32x16 z;
#pragma unroll
        for (int r = 0; r < 16; ++r) z[r] = 0.f;
        const LAS unsigned char* buf = lds + (c & 1) * 16384 + lane * 16;
#pragma unroll
        for (int kk = 0; kk < 16; ++kk) { const bf16x8 kf = *(const LAS bf16x8*)(buf + kk * 1024); z = MFMA32(kf, qf[kk], z); }
        S[c] = z;
        XA_STORE(st, c + 1);
        __syncthreads();
        st[0] = sn[0]; st[1] = sn[1];
    }
    float mx = -3.0e38f;
#pragma unroll
    for (int kb = 0; kb < 8; ++kb)
#pragma unroll
        for (int r = 0; r < 16; ++r) mx = fmaxf(mx, S[kb][r]);
    mx = fmaxf(mx, __shfl_xor(mx, 32));
    float sum = 0.f;
    bf16x8 pf[16];
#pragma unroll
    for (int kb = 0; kb < 8; ++kb)
#pragma unroll
        for (int c = 0; c < 2; ++c) { u32x4 w;
#pragma unroll
            for (int e = 0; e < 4; ++e) { const float a0 = __builtin_amdgcn_exp2f((S[kb][8 * c + 2 * e] - mx) * LOG2E), a1 = __builtin_amdgcn_exp2f((S[kb][8 * c + 2 * e + 1] - mx) * LOG2E); sum += a0 + a1; w[e] = pkbf(a0, a1); }
            pf[2 * kb + c] = __builtin_bit_cast(bf16x8, w); }
    sum += __shfl_xor(sum, 32);
    const float inv = 1.0f / sum;
    bf16_t* orow = ox + qrow * D + h * 256 + 4 * hl;
#pragma unroll 1
    for (int c = 8; c < 16; ++c) {
        if (c + 2 < 16) XA_LOAD(sn, c + 2);
        f32x16 o;
#pragma unroll
        for (int r = 0; r < 16; ++r) o[r] = 0.f;
        const LAS unsigned char* buf = lds + (c & 1) * 16384 + lane * 16;
#pragma unroll
        for (int s = 0; s < 16; ++s) { const bf16x8 vf = *(const LAS bf16x8*)(buf + s * 1024); o = MFMA32(vf, pf[s], o); }
        const int db = c - 8;
#pragma unroll
        for (int g = 0; g < 4; ++g) { u32x2 w; w.x = pkbf(o[4 * g] * inv, o[4 * g + 1] * inv); w.y = pkbf(o[4 * g + 2] * inv, o[4 * g + 3] * inv); *(u32x2*)(orow + db * 32 + 8 * g) = w; }
        if (c + 1 < 16) XA_STORE(st, c + 1);
        __syncthreads();
        st[0] = sn[0]; st[1] = sn[1];
    }
#undef XA_LOAD
#undef XA_STORE
}

constexpr int RSD_OFF = 131072 + 768, RS_OFF = 131072 + 1024, RS_MAXU = 15;
template <class Prog>
DI void fill_rs(LAS unsigned char* lds, Prog P2, const float* ssp, int tid) {
    LAS int* desc = (LAS int*)(lds + RSD_OFF);
    if (tid == 0) { pg8::UnitX x; int n = 0; while (n < RS_MAXU && P2.next(x)) { desc[n] = P2.rs_base(x); ++n; } desc[RS_MAXU] = n; }
    __syncthreads();
    const int n = desc[RS_MAXU];
    for (int kb = 0; kb < n; kb += 8) {
        f32x4 sv[4][4]; int ok[4];
#pragma unroll
        for (int j = 0; j < 4; ++j) { const int k = kb + 2 * j + (tid >> 8); const int base = k < n ? desc[k] : -1; ok[j] = base >= 0;
            const f32x4* sp = (const f32x4*)(ssp + (size_t)((ok[j] ? base : 0) + (tid & 255)) * 16);
#pragma unroll
            for (int q = 0; q < 4; ++q) sv[j][q] = ok[j] ? sp[q] : (f32x4){0.f, 0.f, 0.f, 0.f}; }
        asm volatile("" ::: "memory");
#pragma unroll
        for (int j = 0; j < 4; ++j) if (ok[j]) { const int k = kb + 2 * j + (tid >> 8); float s = 0.f;
#pragma unroll
            for (int q = 0; q < 4; ++q) s += (sv[j][q][0] + sv[j][q][1]) + (sv[j][q][2] + sv[j][q][3]);
            ((LAS float*)(lds + RS_OFF))[k * 256 + (tid & 255)] = 1.0f / sqrtf(s * (1.0f / D) + RMS_EPS); }
    }
    __syncthreads();
}
struct ProgC {
    unsigned char* ws; LAS unsigned char* lds; int G, c; int j, i, kk; pg8::Unit u; bool have;
    DI int rs_base(const pg8::UnitX& x) const { return (x.job & 1) ? -1 : x.pm * 256; }
    DI void init(unsigned char* ws_, int G_, int c_, LAS unsigned char* lds_) { lds = lds_; kk = 0; ws = ws_; G = G_; c = c_; j = 0; i = 0; pg8::StaticOrder S; S.init(M, D, G, c); have = S.next(0, u); }
    DI bool next(pg8::UnitX& x) {
        if (have && j >= 6) { pg8::StaticOrder S; S.init(M, D, G, c); ++i; j = 0; have = S.next(i, u); }
        if (!have) return false;
        x.pm = u.pm; x.pn = u.pn; x.job = j; x.k = kk; ++kk; ++j; return true; }
    DI pg8::JobP job(int jj) const { const int n = jj >> 1; pg8::JobP p;
        if ((jj & 1) == 0) { p.A = (const bf16_t*)(ws + WS_XB); p.Bt = (const bf16_t*)(ws + WS_WIN) + (size_t)(4096 + n * 1024) * D; p.lda = D; p.ldb = D; p.nt = D / 64; }
        else { const int acol = n == 0 ? 0 : (n == 1 ? 1024 : 1536); p.A = (const bf16_t*)(ws + WS_P) + acol; p.Bt = (const bf16_t*)(ws + WS_WB) + (size_t)n * D * 512; p.lda = PC; p.ldb = 512; p.nt = 512 / 64; }
        return p; }
    DI void epilogue(const f32x4 (&acc)[2][2][4][2], const pg8::UnitX& x, int wr, int wc, int fr, int fq) const {
        pg8::EpiArgs ea{}; const pg8::Unit uu{x.pm, x.pn};
        if ((x.job & 1) == 0) { ea.O = (bf16_t*)(ws + WS_T); ea.ldc = D; ea.ssp = (const float*)(ws + WS_SSP); ea.rstab = x.k < RS_MAXU ? (const LAS float*)(lds + RS_OFF) + x.k * 256 : nullptr; ea.cscale = 1.f; pg8::Epi<pg8::E_GATE> E{ea}; E(acc, uu, wr, wc, fr, fq); }
        else { ea.O = (bf16_t*)(ws + WS_X2); ea.ldc = D; ea.G = (const bf16_t*)(ws + WS_T);
            if (x.job == 1) { pg8::Epi<pg8::E_BR0> E{ea}; E(acc, uu, wr, wc, fr, fq); } else { pg8::Epi<pg8::E_BRN> E{ea}; E(acc, uu, wr, wc, fr, fq); } }
    }
};
struct ProgA {
    unsigned char* ws; LAS unsigned char* lds; int G, c; int jb, i, njobs, kk;
    DI int rs_base(const pg8::UnitX& x) const { return x.job == 0 ? x.pm * 256 : (x.job == 1 ? x.pn * 256 : -1); }
    DI void init(unsigned char* ws_, int G_, int c_, int l, LAS unsigned char* lds_) { lds = lds_; kk = 0; ws = ws_; G = G_; c = c_; jb = 0; i = 0; njobs = l == 0 ? 4 : 2; }
    DI bool next(pg8::UnitX& x) {
        for (; jb < njobs; ++jb, i = 0) {
            pg8::StaticOrder S; pg8::Unit u;
            if (jb == 0) S.init(M, 3072, G, c); else if (jb == 1) S.init(1024, M, G, c); else if (jb == 2) S.init(1024, D, G, (c + 64) % G); else S.init(D, 1024, G, (c + 192) % G);
            if (S.next(i, u)) { x.pm = u.pm; x.pn = u.pn; x.job = jb; x.k = kk; ++kk; ++i; return true; }
        }
        return false;
    }
    DI pg8::JobP job(int jj) const { pg8::JobP p; p.lda = D; p.ldb = D; p.nt = D / 64;
        if (jj == 0) { p.A = (const bf16_t*)(ws + WS_XB); p.Bt = (const bf16_t*)(ws + WS_WIN); }
        else if (jj == 1) { p.A = (const bf16_t*)(ws + WS_WIN) + (size_t)3072 * D; p.Bt = (const bf16_t*)(ws + WS_XB); }
        else if (jj == 2) { p.A = (const bf16_t*)(ws + WS_MB); p.Bt = (const bf16_t*)(ws + WS_WK); }
        else { p.A = (const bf16_t*)(ws + WS_WV); p.Bt = (const bf16_t*)(ws + WS_MB); }
        return p; }
    DI void epilogue(const f32x4 (&acc)[2][2][4][2], const pg8::UnitX& x, int wr, int wc, int fr, int fq) const {
        pg8::EpiArgs ea{}; const pg8::Unit uu{x.pm, x.pn};
        const LAS float* rst = x.k < RS_MAXU ? (const LAS float*)(lds + RS_OFF) + x.k * 256 : nullptr;
        if (x.job == 0) { ea.O = (bf16_t*)(ws + WS_P); ea.ldc = PC; ea.ssp = (const float*)(ws + WS_SSP); ea.rstab = rst; ea.cscale = 1.f; pg8::Epi<pg8::E_INPROJ> E{ea}; E(acc, uu, wr, wc, fr, fq); }
        else if (x.job == 2) { ea.O = (bf16_t*)(ws + WS_MEMK); ea.ldc = D; ea.ssp = nullptr; ea.cscale = 1.f; pg8::Epi<pg8::E_ROWSCALE> E{ea}; E(acc, uu, wr, wc, fr, fq); }
        else { if (x.job == 1) { ea.O = (bf16_t*)(ws + WS_T); ea.ldc = M; ea.ssp = (const float*)(ws + WS_SSP); ea.rstab = rst; } else { ea.O = (bf16_t*)(ws + WS_MEMVT); ea.ldc = 1024; ea.ssp = nullptr; }
            pg8::Epi<pg8::E_TRANS> E{ea}; E(acc, uu, wr, wc, fr, fq); }
    }
};
struct ProgJ {
    unsigned char* ws; LAS unsigned char* lds; int G, c; int jb, i, njobs, kk;
    DI int rs_base(const pg8::UnitX& x) const { return x.job == 0 ? x.pm * 256 : -1; }
    DI void init(unsigned char* ws_, int G_, int c_, int l, LAS unsigned char* lds_) { lds = lds_; kk = 0; ws = ws_; G = G_; c = c_; jb = 0; i = 0; njobs = l == 0 ? 3 : 1; }
    DI bool next(pg8::UnitX& x) {
        for (; jb < njobs; ++jb, i = 0) {
            pg8::StaticOrder S; pg8::Unit u;
            if (jb == 0) S.init(M, 2 * FF, G, c); else if (jb == 1) S.init(1024, D, G, (c + 128) % G); else S.init(D, 1024, G, (c + 96) % G);
            if (S.next(i, u)) { x.pm = u.pm; x.pn = u.pn; x.job = jb; x.k = kk; ++kk; ++i; return true; }
        }
        return false;
    }
    DI pg8::JobP job(int jj) const { pg8::JobP p; p.lda = D; p.ldb = D; p.nt = D / 64;
        if (jj == 0) { p.A = (const bf16_t*)(ws + WS_XB); p.Bt = (const bf16_t*)(ws + WS_WGU); }
        else if (jj == 1) { p.A = (const bf16_t*)(ws + WS_MB1); p.Bt = (const bf16_t*)(ws + WS_WK1); }
        else { p.A = (const bf16_t*)(ws + WS_WV1); p.Bt = (const bf16_t*)(ws + WS_MB1); }
        return p; }
    DI void epilogue(const f32x4 (&acc)[2][2][4][2], const pg8::UnitX& x, int wr, int wc, int fr, int fq) const {
        pg8::EpiArgs ea{}; const pg8::Unit uu{x.pm, x.pn};
        if (x.job == 0) { ea.O = (bf16_t*)(ws + WS_P); ea.ldc = FF; ea.ssp = (const float*)(ws + WS_SSP) + (size_t)2 * M * 16; ea.rstab = x.k < RS_MAXU ? (const LAS float*)(lds + RS_OFF) + x.k * 256 : nullptr; pg8::Epi<pg8::E_SWIGLU> E{ea}; E(acc, uu, wr, wc, fr, fq); }
        else if (x.job == 1) { ea.O = (bf16_t*)(ws + WS_MEMK1); ea.ldc = D; ea.ssp = nullptr; ea.cscale = 1.f; pg8::Epi<pg8::E_ROWSCALE> E{ea}; E(acc, uu, wr, wc, fr, fq); }
        else { ea.O = (bf16_t*)(ws + WS_MEMVT1); ea.ldc = 1024; ea.ssp = nullptr; pg8::Epi<pg8::E_TRANS> E{ea}; E(acc, uu, wr, wc, fr, fq); }
    }
};
#define XB_TMO      128
#define XB_XCNT(j)  (256  + 64 * (j))
#define XB_XSUB(j)  (1280 + 64 * (j))
#define XB_XGEN(j)  (2304 + 64 * (j))
#define XB_TOP      3328
#define XB_TOPGEN   3392
#define XCD_BAR_WORDS 3456
#define XB_SPIN_CAP (1u << 18)

__device__ __forceinline__ unsigned xb_ld(unsigned* p)              { return __hip_atomic_load(p, __ATOMIC_RELAXED, __HIP_MEMORY_SCOPE_AGENT); }
__device__ __forceinline__ unsigned xb_add(unsigned* p, unsigned v) { return __hip_atomic_fetch_add(p, v, __ATOMIC_RELAXED, __HIP_MEMORY_SCOPE_AGENT); }
__device__ __forceinline__ unsigned xb_xcc_id() { return (unsigned)__builtin_amdgcn_s_getreg((3 << 11) | 20) & 0xFu; }
#define XB_SPIN(cond, bar) do { unsigned _sp = 0; while (cond) { __builtin_amdgcn_s_sleep(1); \
    if ((++_sp & 255u) == 0u) { if (xb_ld(&(bar)[XB_TMO])) break; if (_sp > XB_SPIN_CAP) { atomicAdd(&(bar)[XB_TMO], 1u); break; } } } } while (0)

struct XcdBarrier {
    unsigned* bar; unsigned x;
    volatile LAS unsigned* st;
};

__device__ __forceinline__ XcdBarrier xcd_barrier_post(unsigned* bar, volatile LAS unsigned* st) {
    XcdBarrier b; b.bar = bar; b.x = xb_xcc_id(); b.st = st;
    if (threadIdx.x == 0) (void)xb_add(&bar[XB_XCNT(b.x)], 1u);
    return b;
}
__device__ __forceinline__ void xcd_barrier_complete(unsigned* bar, unsigned x, unsigned& nloc, unsigned& nx) {
    const unsigned G = gridDim.x * gridDim.y * gridDim.z;
    unsigned sum, cnt, mine, sp = 0u;
    for (;;) {
        sum = 0u; cnt = 0u; mine = 0u;
#pragma unroll
        for (unsigned j = 0; j < 16; ++j) { const unsigned c = xb_ld(&bar[XB_XCNT(j)]); sum += c; cnt += (c > 0u) ? 1u : 0u; mine = (j == x) ? c : mine; }
        if (sum == G) break;
        __builtin_amdgcn_s_sleep(1);
        if ((++sp & 255u) == 0u) { if (xb_ld(&bar[XB_TMO])) break; if (sp > XB_SPIN_CAP) { atomicAdd(&bar[XB_TMO], 1u); break; } }
    }
    nloc = mine > 0u ? mine : 1u; nx = cnt > 0u ? cnt : 1u;
}

__device__ __forceinline__ void xcd_barrier(const XcdBarrier& b) {
    asm volatile("s_waitcnt vmcnt(0)" ::: "memory");
    __syncthreads();
    if (threadIdx.x == 0) {
        unsigned* bar = b.bar;
        __builtin_amdgcn_s_waitcnt(0);
        unsigned nloc = b.st[0], nx = b.st[1];
        if (nloc == 0u) { xcd_barrier_complete(bar, b.x, nloc, nx); b.st[0] = nloc; b.st[1] = nx; }
        const unsigned old = xb_add(&bar[XB_XSUB(b.x)], 1u);
        const unsigned gen = old / nloc;
        if (old + 1u == (gen + 1u) * nloc) {
            __builtin_amdgcn_fence(__ATOMIC_RELEASE, "agent");
            asm volatile("s_waitcnt vmcnt(0)" ::: "memory");
            const unsigned og = xb_add(&bar[XB_TOP], 1u);
            const unsigned tg = og / nx;
            if (og + 1u == (tg + 1u) * nx) xb_add(&bar[XB_TOPGEN], 1u);
            else XB_SPIN(xb_ld(&bar[XB_TOPGEN]) == tg, bar);
            __builtin_amdgcn_fence(__ATOMIC_ACQUIRE, "agent");
            xb_add(&bar[XB_XGEN(b.x)], 1u);
            asm volatile("s_waitcnt vmcnt(0)" ::: "memory");
        } else {
            XB_SPIN(xb_ld(&bar[XB_XGEN(b.x)]) == gen, bar);
            __builtin_amdgcn_fence(__ATOMIC_ACQUIRE, "agent");
            asm volatile("s_waitcnt vmcnt(0)" ::: "memory");
        }
    }
    __syncthreads();
}

#define WSB(off) ((bf16_t*)(WSP + (off)))
#define WSF(off) ((float*)(WSP + (off)))
__global__ void __launch_bounds__(NTHREADS, 2) fwd_megakernel(Args A_unused) {
    extern __shared__ __attribute__((aligned(16))) unsigned char lds_raw[];
    LAS unsigned char* lds = (LAS unsigned char*)lds_raw;
    cg::grid_group grid = cg::this_grid();
    { const int tid = threadIdx.x;
    if (tid < 24) { const unsigned long long* ka = (const unsigned long long*)__builtin_amdgcn_kernarg_segment_ptr(); *(LAS unsigned long long*)(lds + PTR_OFF + 8 * tid) = ka[tid]; } }
    if (threadIdx.x < 8) ((LAS unsigned*)(lds + PTR_OFF + 256))[threadIdx.x] = 0u;
    __syncthreads();
    if (blockIdx.x == 0) { unsigned* bw = (unsigned*)ldq(lds, 23); for (int w = threadIdx.x; w < XCD_BAR_WORDS; w += NTHREADS) __hip_atomic_store(bw + w, 0u, __ATOMIC_RELAXED, __HIP_MEMORY_SCOPE_AGENT); }
    asm volatile("s_waitcnt vmcnt(0)" ::: "memory");
    __syncthreads();
    grid.sync();
    const XcdBarrier bar = xcd_barrier_post((unsigned*)ldq(lds, 23), (volatile LAS unsigned*)(lds + PTR_OFF + 256));
#define XBAR() do { XcdBarrier b2_ = bar; asm volatile("" : "+s"(b2_.x)); xcd_barrier(b2_); } while (0)
#define FRESH_IDS const int tid = fresh_tid(), lane = tid & 63, wave = __builtin_amdgcn_readfirstlane(tid >> 6); (void)lane; (void)wave
#define GRID_ ((int)gridDim.x)
#define BID_ ((int)blockIdx.x)
#define GW_ (BID_ * NWAVES + wave)
#define NGW_ (GRID_ * NWAVES)
    constexpr size_t SSPB = (size_t)M * 16 * 4;
    using namespace pg8;

    { FRESH_IDS; prep_x(lds, GW_, NGW_, lane); }
    { FRESH_IDS; prep_weights(0, lds, GW_, NGW_, wave, lane); }
    XBAR();
    for (int l = 0; l < DEPTH; ++l) {
        { ProgA PA; PA.init(WSP, GRID_, BID_, l, lds); { FRESH_IDS; fill_rs(lds, PA, WSF(WS_SSP), tid); } gemm_stream(lds, PA); }
        XBAR();
        if (l > 0) { FRESH_IDS; prep_weights(l, lds, GW_, NGW_, wave, lane, 2); __syncthreads(); }
        { FRESH_IDS; for (int it = BID_; it < NBATCH * 32 * 4; it += GRID_) sgu_item(l, WSB(WS_P), WSB(WS_T), it, lds, tid, wave, lane); }
        { FRESH_IDS; for (int it = GW_; it < NBATCH * 8 * 128; it += NGW_) sb_attn_item(WSB(WS_P), WSB(WS_T), it, lane); }
        { FRESH_IDS; conv_phase(l, WSB(WS_P), lds, BID_ * NTHREADS + tid, GRID_ * NTHREADS); }
        XBAR();
        { ProgC PCg; PCg.init(WSP, GRID_, BID_, lds); { FRESH_IDS; fill_rs(lds, PCg, WSF(WS_SSP), tid); } gemm_stream(lds, PCg); }
        XBAR();
        {
            StaticOrder S; S.init(M, D, GRID_, BID_);
            EpiArgs ea{}; Gemm g{WSB(WS_X2), WSB(WS_WOUT), M, D, D, D, D}; ea.xb = WSB(WS_XB); ea.sspo = WSF(WS_SSP + SSPB); Epi<E_RESID> E{ea}; gemm_phase(lds, g, S, E);
        }
        XBAR();
        {
            StaticOrder S; S.init(M, D, GRID_, BID_);
            EpiArgs ea{}; Gemm g{WSB(WS_XB), WSB(WS_WQ), M, D, D, D, D}; ea.O = WSB(WS_T); ea.ldc = D; ea.ssp = WSF(WS_SSP + SSPB); ea.cscale = 0.0625f; Epi<E_ROWSCALE> E{ea}; gemm_phase(lds, g, S, E);
            Unit u;
            for (int i = 0; S.next(i, u); ++i) { FRESH_IDS; xattn_wg(WSB(WS_T), WSB(l ? WS_MEMK1 : WS_MEMK), WSB(l ? WS_MEMVT1 : WS_MEMVT), WSB(WS_X2), (u.pm >> 4) * 64 + u.pn * 16 + (u.pm & 15), tid, wave, lane, lds); }
        }
        XBAR();
        {
            StaticOrder S; S.init(M, D, GRID_, BID_);
            EpiArgs ea{}; Gemm g{WSB(WS_X2), WSB(WS_WOX), M, D, D, D, D}; ea.xb = WSB(WS_XB); ea.sspo = WSF(WS_SSP + 2 * SSPB); Epi<E_RESID> E{ea}; gemm_phase(lds, g, S, E);
        }
        XBAR();
        { ProgJ PJ; PJ.init(WSP, GRID_, BID_, l, lds); { FRESH_IDS; fill_rs(lds, PJ, WSF(WS_SSP + 2 * SSPB), tid); } gemm_stream(lds, PJ); }
        XBAR();
        {
            StaticOrder S; S.init(M, D, GRID_, BID_);
            EpiArgs ea{}; Gemm g{WSB(WS_P), WSB(WS_WD), M, D, FF, FF, FF}; ea.xb = WSB(WS_XB); ea.sspo = WSF(WS_SSP); Epi<E_RESID> E{ea}; gemm_phase(lds, g, S, E);
        }
        if (l + 1 < DEPTH) { FRESH_IDS; prep_weights(l + 1, lds, GW_, NGW_, wave, lane, 1); }
        XBAR();
    }
    { FRESH_IDS; final_norm(lds, GW_, NGW_, lane); }
}

extern "C" void kernel_launch(void* const* d_in, const int* in_sizes, int n_in, void* d_out, int out_size, void* d_ws, size_t ws_size, hipStream_t stream) {
    static int grid = 0;
    if (grid == 0) {
        if (n_in != 22 || in_sizes[0] != M * D || out_size != M * D || ws_size < WS_END) { fprintf(stderr, "kernel_launch: unexpected shapes (n_in %d, in0 %d, out %d, ws %zu)\n", n_in, n_in > 0 ? in_sizes[0] : -1, out_size, ws_size); grid = -1; return; }
        int dev = 0, cus = 0, per_cu = 0;
        hipGetDevice(&dev); hipDeviceGetAttribute(&cus, hipDeviceAttributeMultiprocessorCount, dev);
        hipFuncSetAttribute((const void*)fwd_megakernel, hipFuncAttributeMaxDynamicSharedMemorySize, LDS_BYTES);
        hipOccupancyMaxActiveBlocksPerMultiprocessor(&per_cu, (const void*)fwd_megakernel, NTHREADS, LDS_BYTES);
        if (per_cu < 1) { fprintf(stderr, "kernel_launch: occupancy query says %d blocks per CU\n", per_cu); per_cu = 1; }
        (void)hipGetLastError();
        grid = cus;
    }
    if (grid < 0) return;
    Args a{};
    for (int i = 0; i < 22; ++i) a.in[i] = (const float*)d_in[i];
    a.out = (float*)d_out; a.ws = (unsigned char*)d_ws;
    void* args[] = {&a};
    hipError_t e = hipLaunchCooperativeKernel((const void*)fwd_megakernel, dim3(grid), dim3(NTHREADS), args, LDS_BYTES, stream);
    if (e != hipSuccess) fprintf(stderr, "cooperative launch failed: %s (grid %d)\n", hipGetErrorString(e), grid);
}
```

```cpp
#include <hip/hip_runtime.h>
#include <hip/hip_cooperative_groups.h>
#include <cstdio>
#include <cstdint>
namespace cg = cooperative_groups;

#define LAS __attribute__((address_space(3)))
typedef unsigned short bf16_t;
typedef short bf16x8 __attribute__((ext_vector_type(8)));
typedef float f32x4 __attribute__((ext_vector_type(4)));
typedef float f32x2 __attribute__((ext_vector_type(2)));
typedef float f32x16 __attribute__((ext_vector_type(16)));
typedef unsigned u32x4 __attribute__((ext_vector_type(4)));
typedef unsigned u32x2 __attribute__((ext_vector_type(2)));
typedef __bf16 bf16x2n __attribute__((ext_vector_type(2)));

#define DI __device__ __forceinline__
DI unsigned pkbf(float lo, float hi) { f32x2 v = {lo, hi}; bf16x2n b = __builtin_convertvector(v, bf16x2n); return __builtin_bit_cast(unsigned, b); }
DI float bflo(unsigned u) { return __uint_as_float(u << 16); }
DI float bfhi(unsigned u) { return __uint_as_float(u & 0xffff0000u); }
DI int fresh_tid() { int t = threadIdx.x; asm volatile("" : "+v"(t)); return t; }
#define MFMA32(a, b, c) __builtin_amdgcn_mfma_f32_32x32x16_bf16((a), (b), (c), 0, 0, 0)

constexpr int M = 16384, D = 1024, SEQ = 4096, NBATCH = 4, DEPTH = 2;
constexpr int PC = 3072;
constexpr int FF = 2816;
constexpr int INC = 7168;
constexpr float RMS_EPS = 1e-6f, LN_EPS = 1e-5f;
constexpr float LOG2E = 1.4426950408889634f, LN2 = 0.6931471805599453f;
constexpr float SB_EXIT = 110.0f;

constexpr size_t MiB = (size_t)1 << 20;
constexpr size_t WS_WIN = 1 * MiB;
constexpr size_t WS_WB = 15 * MiB;
constexpr size_t WS_WOUT = 18 * MiB, WS_WQ = 20 * MiB, WS_WK = 22 * MiB, WS_WV = 24 * MiB, WS_WOX = 26 * MiB;
constexpr size_t WS_WGU = 28 * MiB;
constexpr size_t WS_WD = 39 * MiB;
constexpr size_t WS_MB = 45 * MiB, WS_MEMK = 47 * MiB, WS_MEMVT = 49 * MiB;
constexpr size_t WS_XB = 51 * MiB;
constexpr size_t WS_P = 83 * MiB;
constexpr size_t WS_T = 179 * MiB;
constexpr size_t WS_X2 = 211 * MiB;
constexpr size_t WS_SSP = 243 * MiB;
constexpr size_t WS_WK1 = 246 * MiB, WS_WV1 = 248 * MiB, WS_MB1 = 250 * MiB, WS_MEMK1 = 252 * MiB, WS_MEMVT1 = 254 * MiB;
constexpr size_t WS_END = 256 * MiB;

namespace pg8 {
constexpr int BM = 256, BK = 64, HALF = 128, HTB = HALF * BK * 2, STAGE_BYTES = 8 * HTB, NXCD = 8, WGM = 8;
DI int lds_byte(int r, int c) { const int st = (r >> 4) * 2 + (c >> 5), rr = r & 15, cc = c & 31, ob = rr * 64 + cc * 2; return st * 1024 + (ob ^ (((ob >> 9) & 1) << 5)); }
DI void stage_rc(int b, int& R, int& C) { const int st = b / 1024, sb = b % 1024, swz = sb ^ (((sb >> 9) & 1) << 5); R = (st >> 1) * 16 + swz / 64; C = (st & 1) * 32 + (swz % 64) / 2; }
DI int perm32(int rho) { const int n = rho >> 4, i = rho & 15; return 8 * (i >> 2) + 4 * n + (i & 3); }

struct Unit { int pm, pn; };
struct Gemm { const bf16_t* A; const bf16_t* Bt; int M, N, K, lda, ldb; };

struct StaticOrder {
    int nM, nN, nwg, G, c;
    DI void init(int M_, int N_, int G_, int c_) { nM = M_ / BM; nN = N_ / BM; nwg = nM * nN; G = G_; c = c_; }
    DI bool next(int i, Unit& u) const {
        const long L = (long)i * G + c; if (L >= nwg) return false;
        int wgid = (int)L; { const int q = nwg / NXCD, r = nwg % NXCD, xcd = wgid % NXCD, off = wgid / NXCD; wgid = (xcd < r ? xcd * (q + 1) : r * (q + 1) + (xcd - r) * q) + off; }
        const int nig = WGM * nN, gid = wgid / nig, fm = gid * WGM, gsz = (nM - fm) < WGM ? (nM - fm) : WGM;
        u.pm = fm + ((wgid % nig) % gsz); u.pn = (wgid % nig) / gsz; return true;
    }
};

DI f32x2 gelu_pk(f32x2 v) {
    const f32x2 av = __builtin_elementwise_abs(v), d = av * 0.2316418882f + 1.0f;
    f32x2 t; t.x = __builtin_amdgcn_rcpf(d.x); t.y = __builtin_amdgcn_rcpf(d.y);
    f32x2 q = t * 0.5307027145f + (-0.7265760135f); q = q * t + 0.7107068705f; q = q * t + (-0.142248368f); q = q * t + 0.127414796f; q = q * t;
    const f32x2 s = (v * v) * (-0.72134752044f);
    f32x2 e; e.x = __builtin_amdgcn_exp2f(s.x); e.y = __builtin_amdgcn_exp2f(s.y);
    const f32x2 m = v * (q * e), r = v - m;
    f32x2 o; o.x = v.x < 0.f ? m.x : r.x; o.y = v.y < 0.f ? m.y : r.y; return o;
}
DI f32x4 gelu4(f32x4 v) { f32x2 a = gelu_pk((f32x2){v[0], v[1]}), b = gelu_pk((f32x2){v[2], v[3]}); return (f32x4){a.x, a.y, b.x, b.y}; }
DI float sigmoidf_(float x) { return __builtin_amdgcn_rcpf(1.0f + __builtin_amdgcn_exp2f(-x * LOG2E)); }
DI f32x4 sigmoid4(f32x4 v) { return (f32x4){sigmoidf_(v[0]), sigmoidf_(v[1]), sigmoidf_(v[2]), sigmoidf_(v[3])}; }

DI float row_rs(const float* ssp, int row, int fq) {
    const f32x4 v = *(const f32x4*)(ssp + (size_t)row * 16 + fq * 4);
    float s = (v[0] + v[1]) + (v[2] + v[3]);
    s += __shfl_xor(s, 16); s += __shfl_xor(s, 32);
    return 1.0f / sqrtf(s * (1.0f / D) + RMS_EPS);
}

DI void row_rs8(const float* ssp, int row0, int fq, float (&rs)[2][4]) {
    f32x4 v[2][4];
#pragma unroll
    for (int ai = 0; ai < 2; ++ai)
#pragma unroll
        for (int m = 0; m < 4; ++m) v[ai][m] = *(const f32x4*)(ssp + (size_t)(row0 + ai * HALF + m * 16) * 16 + fq * 4);
    asm volatile("" ::: "memory");
#pragma unroll
    for (int ai = 0; ai < 2; ++ai)
#pragma unroll
        for (int m = 0; m < 4; ++m) { float s = (v[ai][m][0] + v[ai][m][1]) + (v[ai][m][2] + v[ai][m][3]); s += __shfl_xor(s, 16); s += __shfl_xor(s, 32); rs[ai][m] = 1.0f / sqrtf(s * (1.0f / D) + RMS_EPS); }
}

DI void row_rs8_lds(const LAS float* tab, int wr, int fr, float (&rs)[2][4]) {
#pragma unroll
    for (int ai = 0; ai < 2; ++ai)
#pragma unroll
        for (int m = 0; m < 4; ++m) rs[ai][m] = tab[ai * HALF + wr * 64 + m * 16 + fr];
}

enum { E_INPROJ = 0, E_TRANS = 1, E_GATE = 2, E_BR0 = 3, E_BRN = 4, E_RESID = 5, E_ROWSCALE = 6, E_SWIGLU = 7 };
struct EpiArgs {
    bf16_t* O; int ldc;
    const float* ssp;
    float cscale;
    const float* xsrc; float* xdst; bf16_t* xb; float* sspo;
    const bf16_t* G;
    const LAS float* rstab;
};
template <int MODE> struct Epi {
    static constexpr bool PERM = true;
    EpiArgs a;
    DI void store8(bf16_t* p, f32x4 v0, f32x4 v1) const { u32x4 w; w.x = pkbf(v0[0], v0[1]); w.y = pkbf(v0[2], v0[3]); w.z = pkbf(v1[0], v1[1]); w.w = pkbf(v1[2], v1[3]); *(u32x4*)p = w; }
    DI void operator()(const f32x4 (&acc)[2][2][4][2], const Unit& u, int wr, int wc, int fr, int fq) const {
        const int row0 = u.pm * BM + wr * 64 + fr, col0 = u.pn * BM + wc * 32 + 8 * fq;
        if constexpr (MODE == E_TRANS) {
            float rsc[2][8];
            if (a.rstab) {
#pragma unroll
                for (int bj = 0; bj < 2; ++bj) { const f32x4 t0 = *(const LAS f32x4*)(a.rstab + bj * HALF + wc * 32 + 8 * fq), t1 = *(const LAS f32x4*)(a.rstab + bj * HALF + wc * 32 + 8 * fq + 4);
                    rsc[bj][0] = t0[0]; rsc[bj][1] = t0[1]; rsc[bj][2] = t0[2]; rsc[bj][3] = t0[3]; rsc[bj][4] = t1[0]; rsc[bj][5] = t1[1]; rsc[bj][6] = t1[2]; rsc[bj][7] = t1[3]; }
            } else if (a.ssp) {
                const int lane = fq * 16 + fr, tok = u.pn * BM + (lane >> 5) * HALF + wc * 32 + (lane & 31);
                const f32x4* sp = (const f32x4*)(a.ssp + (size_t)tok * 16);
                const f32x4 s0 = sp[0], s1 = sp[1], s2 = sp[2], s3 = sp[3];
                const float s = ((s0[0] + s0[1]) + (s0[2] + s0[3])) + ((s1[0] + s1[1]) + (s1[2] + s1[3])) + ((s2[0] + s2[1]) + (s2[2] + s2[3])) + ((s3[0] + s3[1]) + (s3[2] + s3[3]));
                const float rs = 1.0f / sqrtf(s * (1.0f / D) + RMS_EPS);
#pragma unroll
                for (int bj = 0; bj < 2; ++bj)
#pragma unroll
                    for (int e = 0; e < 8; ++e) rsc[bj][e] = __shfl(rs, bj * 32 + 8 * fq + e);
            } else {
#pragma unroll
                for (int bj = 0; bj < 2; ++bj)
#pragma unroll
                    for (int e = 0; e < 8; ++e) rsc[bj][e] = 1.0f;
            }
            const bool act = a.ssp != nullptr && u.pm >= 2;
#pragma unroll
            for (int ai = 0; ai < 2; ++ai)
#pragma unroll
                for (int m = 0; m < 4; ++m) { bf16_t* rowp = a.O + (size_t)(row0 + ai * HALF + m * 16) * a.ldc + col0;
#pragma unroll
                    for (int bj = 0; bj < 2; ++bj) {
                        f32x4 v0 = acc[ai][bj][m][0], v1 = acc[ai][bj][m][1];
                        v0 = v0 * (f32x4){rsc[bj][0], rsc[bj][1], rsc[bj][2], rsc[bj][3]}; v1 = v1 * (f32x4){rsc[bj][4], rsc[bj][5], rsc[bj][6], rsc[bj][7]};
                        if (act) { v0 = gelu4(v0); v1 = gelu4(v1); }
                        store8(rowp + bj * HALF, v0, v1); } }
        } else if constexpr (MODE == E_RESID) {
#pragma unroll
            for (int ai = 0; ai < 2; ++ai) {
                u32x4 xw[4][2];
#pragma unroll
                for (int m = 0; m < 4; ++m)
#pragma unroll
                    for (int bj = 0; bj < 2; ++bj) xw[m][bj] = *(const u32x4*)(a.xb + (size_t)(row0 + ai * HALF + m * 16) * D + col0 + bj * HALF);
                asm volatile("" ::: "memory");
#pragma unroll
                for (int m = 0; m < 4; ++m) { const int row = row0 + ai * HALF + m * 16; const size_t off = (size_t)row * D + col0; float ss = 0.f;
#pragma unroll
                    for (int bj = 0; bj < 2; ++bj) { const u32x4 w = xw[m][bj];
                        const f32x4 v0 = (f32x4){bflo(w.x), bfhi(w.x), bflo(w.y), bfhi(w.y)} + acc[ai][bj][m][0], v1 = (f32x4){bflo(w.z), bfhi(w.z), bflo(w.w), bfhi(w.w)} + acc[ai][bj][m][1];
                        store8(a.xb + off + bj * HALF, v0, v1);
                        ss += (v0[0] * v0[0] + v0[1] * v0[1]) + (v0[2] * v0[2] + v0[3] * v0[3]) + (v1[0] * v1[0] + v1[1] * v1[1]) + (v1[2] * v1[2] + v1[3] * v1[3]); }
                    ss += __shfl_xor(ss, 16); ss += __shfl_xor(ss, 32);
                    if (fq == 0) a.sspo[(size_t)row * 16 + u.pn * 4 + wc] = ss; }
            }
        } else if constexpr (MODE == E_SWIGLU) {
            const int ocol = u.pn * HALF + wc * 32 + 8 * fq;
            float rs8[2][4]; if (a.rstab) row_rs8_lds(a.rstab, wr, fr, rs8); else row_rs8(a.ssp, row0, fq, rs8);
#pragma unroll
            for (int ai = 0; ai < 2; ++ai)
#pragma unroll
                for (int m = 0; m < 4; ++m) { const int row = row0 + ai * HALF + m * 16; const float rs = rs8[ai][m];
                    const f32x4 g0 = acc[ai][0][m][0] * rs, g1 = acc[ai][0][m][1] * rs, u0 = acc[ai][1][m][0] * rs, u1 = acc[ai][1][m][1] * rs;
                    store8(a.O + (size_t)row * a.ldc + ocol, g0 * sigmoid4(g0) * u0, g1 * sigmoid4(g1) * u1); }
        } else {
            float sc = a.cscale; bool gelu = false;
            if constexpr (MODE == E_INPROJ) { sc = (u.pn < 2) ? 0.125f : 1.0f; gelu = (u.pn == 4 || u.pn == 5); }
            if constexpr (MODE == E_INPROJ || MODE == E_GATE || MODE == E_ROWSCALE) {
                float rs8[2][4];
                if (a.rstab) row_rs8_lds(a.rstab, wr, fr, rs8); else if (a.ssp) row_rs8(a.ssp, row0, fq, rs8); else {
#pragma unroll
                    for (int ai = 0; ai < 2; ++ai)
#pragma unroll
                        for (int m = 0; m < 4; ++m) rs8[ai][m] = 1.0f; }
#pragma unroll
                for (int ai = 0; ai < 2; ++ai)
#pragma unroll
                    for (int m = 0; m < 4; ++m) { const int row = row0 + ai * HALF + m * 16; const float rs = sc * rs8[ai][m];
#pragma unroll
                        for (int bj = 0; bj < 2; ++bj) { const size_t off = (size_t)row * a.ldc + col0 + bj * HALF;
                            f32x4 v0 = acc[ai][bj][m][0] * rs, v1 = acc[ai][bj][m][1] * rs;
                            if constexpr (MODE == E_INPROJ) { if (gelu) { v0 = gelu4(v0); v1 = gelu4(v1); } }
                            else if constexpr (MODE == E_GATE) { v0 = sigmoid4(v0); v1 = sigmoid4(v1); }
                            store8(a.O + off, v0, v1); } }
            } else {
#pragma unroll
                for (int ai = 0; ai < 2; ++ai) {
                    u32x4 gw[4][2], pw[4][2];
#pragma unroll
                    for (int m = 0; m < 4; ++m)
#pragma unroll
                        for (int bj = 0; bj < 2; ++bj) { const size_t off = (size_t)(row0 + ai * HALF + m * 16) * a.ldc + col0 + bj * HALF;
                            gw[m][bj] = *(const u32x4*)(a.G + off); if constexpr (MODE == E_BRN) pw[m][bj] = *(const u32x4*)(a.O + off); }
                    asm volatile("" ::: "memory");
#pragma unroll
                    for (int m = 0; m < 4; ++m)
#pragma unroll
                        for (int bj = 0; bj < 2; ++bj) { const size_t off = (size_t)(row0 + ai * HALF + m * 16) * a.ldc + col0 + bj * HALF; const u32x4 g = gw[m][bj];
                            f32x4 v0 = acc[ai][bj][m][0] * (f32x4){bflo(g.x), bfhi(g.x), bflo(g.y), bfhi(g.y)}, v1 = acc[ai][bj][m][1] * (f32x4){bflo(g.z), bfhi(g.z), bflo(g.w), bfhi(g.w)};
                            if constexpr (MODE == E_BRN) { const u32x4 q = pw[m][bj];
                                v0 = v0 + (f32x4){bflo(q.x), bfhi(q.x), bflo(q.y), bfhi(q.y)}; v1 = v1 + (f32x4){bflo(q.z), bfhi(q.z), bflo(q.w), bfhi(q.w)}; }
                            store8(a.O + off, v0, v1); }
                }
            }
        }
    }
};

template <class EpiT>
DI void gemm_phase(LAS unsigned char* lds, const Gemm g, const StaticOrder& S, const EpiT& E) {
    const int tid = fresh_tid(), wid = __builtin_amdgcn_readfirstlane(tid >> 6), lane = tid & 63, wr = wid >> 2, wc = wid & 3, fr = lane & 15, fq = lane >> 4;
    const int nt = g.K / BK;
    unsigned voffA[2], voffB[2];
#pragma unroll
    for (int i = 0; i < 2; ++i) { int R, C; stage_rc(tid * 16 + i * 8192, R, C); const int Rb = EpiT::PERM ? ((R & ~31) + perm32(R & 31)) : R;
        voffA[i] = (unsigned)(R * g.lda + C) * 2u; voffB[i] = (unsigned)(Rb * g.ldb + C) * 2u; }
    const size_t kstep = (size_t)(BK * 2);
    const size_t hstepA = (size_t)HALF * g.lda * 2, hstepB = (size_t)HALF * g.ldb * 2;
    const size_t tstepA = 2 * hstepA, tstepB = 2 * hstepB;
    const unsigned ldsw = (unsigned)wid * 1024u;
    const int aoff = lds_byte(wr * 64 + fr, fq * 8), boff = lds_byte(wc * 32 + fr, fq * 8);
#define PG8_SA(b, h) (((b) * 2 + (h)) * HTB)
#define PG8_SB(b, h) ((4 + (b) * 2 + (h)) * HTB)
#define PG8_STAGE(bufoff, gbase, voff) do { _Pragma("unroll") for (int _i = 0; _i < 2; ++_i) \
        __builtin_amdgcn_global_load_lds((const unsigned*)((const char*)(gbase) + (voff)[_i]), (LAS unsigned*)(lds + (bufoff) + ldsw + _i * 8192), 16, 0, 0); } while (0)
#define PG8_LDA(dst, b, h) do { _Pragma("unroll") for (int m = 0; m < 4; ++m) _Pragma("unroll") for (int k = 0; k < 2; ++k) dst[m][k] = *(const LAS bf16x8*)(lds + PG8_SA(b, h) + aoff + m * 2048 + k * 1024); } while (0)
#define PG8_LDB(dst, b, h) do { _Pragma("unroll") for (int n = 0; n < 2; ++n) _Pragma("unroll") for (int k = 0; k < 2; ++k) dst[n][k] = *(const LAS bf16x8*)(lds + PG8_SB(b, h) + boff + n * 2048 + k * 1024); } while (0)
#define PG8_MMA(ai, bj, At, Bt) do { __builtin_amdgcn_s_setprio(1); _Pragma("unroll") for (int m = 0; m < 4; ++m) _Pragma("unroll") for (int n = 0; n < 2; ++n) _Pragma("unroll") for (int k = 0; k < 2; ++k) \
        acc[ai][bj][m][n] = __builtin_amdgcn_mfma_f32_16x16x32_bf16(Bt[n][k], At[m][k], acc[ai][bj][m][n], 0, 0, 0); __builtin_amdgcn_s_setprio(0); } while (0)
#define PG8_WAIT_V(n) asm volatile("s_waitcnt vmcnt(" #n ")" ::: "memory")
#define PG8_WAIT_L(n) asm volatile("s_waitcnt lgkmcnt(" #n ")" ::: "memory")
#define PG8_BAR __builtin_amdgcn_s_barrier()
#define PG8_SCHED __builtin_amdgcn_sched_barrier(0)
    Unit cur, nxt; int ui = 0;
    if (!S.next(0, cur)) return;
    f32x4 acc[2][2][4][2];
#pragma unroll
    for (int a = 0; a < 2; ++a)
#pragma unroll
        for (int b = 0; b < 2; ++b)
#pragma unroll
            for (int m = 0; m < 4; ++m)
#pragma unroll
                for (int n = 0; n < 2; ++n) acc[a][b][m][n] = (f32x4){0.f, 0.f, 0.f, 0.f};
    bf16x8 At[4][2], B0[2][2], B1[2][2];
    const char* cA = (const char*)g.A + (size_t)cur.pm * tstepA; const char* cB = (const char*)g.Bt + (size_t)cur.pn * tstepB;
    PG8_STAGE(PG8_SB(0, 0), cB, voffB); PG8_STAGE(PG8_SB(0, 1), cB + hstepB, voffB); PG8_STAGE(PG8_SA(0, 0), cA, voffA); PG8_STAGE(PG8_SA(0, 1), cA + hstepA, voffA);
    if (wr == 1) PG8_BAR;
    PG8_WAIT_V(2); PG8_BAR;
    PG8_STAGE(PG8_SB(1, 0), cB + kstep, voffB); PG8_STAGE(PG8_SA(1, 0), cA + kstep, voffA); PG8_STAGE(PG8_SB(1, 1), cB + hstepB + kstep, voffB);
    PG8_WAIT_V(6); PG8_BAR;
    for (;;) {
        const bool has_next = S.next(ui + 1, nxt);
        const char* nA = has_next ? (const char*)g.A + (size_t)nxt.pm * tstepA : cA; const char* nB = has_next ? (const char*)g.Bt + (size_t)nxt.pn * tstepB : cB;
        for (int t = 0; t < nt; t += 2) {
            const bool last = (t == nt - 2);
            const char* a1 = cA + (size_t)(t + 1) * kstep;
            const char* a2 = last ? nA : cA + (size_t)(t + 2) * kstep; const char* b2 = last ? nB : cB + (size_t)(t + 2) * kstep;
            const char* a3 = a2 + kstep; const char* b3 = b2 + kstep;
            PG8_LDB(B0, 0, 0); PG8_LDB(B1, 0, 1); PG8_SCHED; PG8_LDA(At, 0, 0); PG8_STAGE(PG8_SA(1, 1), a1 + hstepA, voffA);
            PG8_WAIT_V(8); PG8_WAIT_L(0); PG8_BAR; PG8_MMA(0, 0, At, B0); PG8_MMA(0, 1, At, B1); PG8_BAR; PG8_SCHED;
            PG8_LDA(At, 0, 1); PG8_STAGE(PG8_SB(0, 0), b2, voffB); PG8_STAGE(PG8_SB(0, 1), b2 + hstepB, voffB); PG8_STAGE(PG8_SA(0, 0), a2, voffA);
            PG8_WAIT_V(8); PG8_WAIT_L(0); PG8_BAR; PG8_MMA(1, 0, At, B0); PG8_MMA(1, 1, At, B1); PG8_BAR; PG8_SCHED;
            PG8_LDB(B0, 1, 0); PG8_LDB(B1, 1, 1); PG8_SCHED; PG8_LDA(At, 1, 0); PG8_STAGE(PG8_SA(0, 1), a2 + hstepA, voffA);
            PG8_WAIT_V(8); PG8_WAIT_L(0); PG8_BAR; PG8_MMA(0, 0, At, B0); PG8_MMA(0, 1, At, B1); PG8_BAR; PG8_SCHED;
            PG8_LDA(At, 1, 1); PG8_STAGE(PG8_SB(1, 0), b3, voffB); PG8_STAGE(PG8_SB(1, 1), b3 + hstepB, voffB); PG8_STAGE(PG8_SA(1, 0), a3, voffA);
            PG8_WAIT_V(8); PG8_WAIT_L(0); PG8_BAR; PG8_MMA(1, 0, At, B0); PG8_MMA(1, 1, At, B1); PG8_BAR; PG8_SCHED;
        }
        if (wr == 0) PG8_BAR;
        E(acc, cur, wr, wc, fr, fq);
        if (!has_next) break;
#pragma unroll
        for (int a = 0; a < 2; ++a)
#pragma unroll
            for (int b = 0; b < 2; ++b)
#pragma unroll
                for (int m = 0; m < 4; ++m)
#pragma unroll
                    for (int n = 0; n < 2; ++n) acc[a][b][m][n] = (f32x4){0.f, 0.f, 0.f, 0.f};
        cur = nxt; cA = nA; cB = nB; ++ui;
        if (wr == 1) PG8_BAR;
    }
    PG8_WAIT_V(0);
    PG8_BAR;

}

struct UnitX { int pm, pn, job, k; };
struct JobP { const bf16_t* A; const bf16_t* Bt; int lda, ldb, nt; };
template <class Prog>
DI void gemm_stream(LAS unsigned char* lds, Prog& P) {
    const int tid = fresh_tid(), wid = __builtin_amdgcn_readfirstlane(tid >> 6), lane = tid & 63, wr = wid >> 2, wc = wid & 3, fr = lane & 15, fq = lane >> 4;
    const size_t kstep = (size_t)(BK * 2);
    const unsigned ldsw = (unsigned)wid * 1024u;
    const int aoff = lds_byte(wr * 64 + fr, fq * 8), boff = lds_byte(wc * 32 + fr, fq * 8);
#define PG8_VOFF(vA, vB, j) do { _Pragma("unroll") for (int _i = 0; _i < 2; ++_i) { int sR_, sC_; stage_rc(tid * 16 + _i * 8192, sR_, sC_); const int sRb_ = (sR_ & ~31) + perm32(sR_ & 31); \
        vA[_i] = (unsigned)(sR_ * (j).lda + sC_) * 2u; vB[_i] = (unsigned)(sRb_ * (j).ldb + sC_) * 2u; } } while (0)
    UnitX cur, nxt;
    if (!P.next(cur)) return;
    JobP jc = P.job(cur.job);
    unsigned voffA[2], voffB[2], voffAn[2], voffBn[2];
    PG8_VOFF(voffA, voffB, jc);
    unsigned hstepA = (unsigned)(HALF * jc.lda * 2), hstepB = (unsigned)(HALF * jc.ldb * 2), hstepAn, hstepBn;
    int nt = jc.nt;
    f32x4 acc[2][2][4][2];
#pragma unroll
    for (int a = 0; a < 2; ++a)
#pragma unroll
        for (int b = 0; b < 2; ++b)
#pragma unroll
            for (int m = 0; m < 4; ++m)
#pragma unroll
                for (int n = 0; n < 2; ++n) acc[a][b][m][n] = (f32x4){0.f, 0.f, 0.f, 0.f};
    bf16x8 At[4][2], B0[2][2], B1[2][2];
    const char* cA = (const char*)jc.A + (size_t)cur.pm * 2 * hstepA; const char* cB = (const char*)jc.Bt + (size_t)cur.pn * 2 * hstepB;
    PG8_STAGE(PG8_SB(0, 0), cB, voffB); PG8_STAGE(PG8_SB(0, 1), cB + hstepB, voffB); PG8_STAGE(PG8_SA(0, 0), cA, voffA); PG8_STAGE(PG8_SA(0, 1), cA + hstepA, voffA);
    if (wr == 1) PG8_BAR;
    PG8_WAIT_V(2); PG8_BAR;
    PG8_STAGE(PG8_SB(1, 0), cB + kstep, voffB); PG8_STAGE(PG8_SA(1, 0), cA + kstep, voffA); PG8_STAGE(PG8_SB(1, 1), cB + hstepB + kstep, voffB);
    PG8_WAIT_V(6); PG8_BAR;
    for (;;) {
        const bool has_next = P.next(nxt);
        const char* nA = cA; const char* nB = cB; int ntn = nt;
        hstepAn = hstepA; hstepBn = hstepB; voffAn[0] = voffA[0]; voffAn[1] = voffA[1]; voffBn[0] = voffB[0]; voffBn[1] = voffB[1];
        if (has_next) { const JobP jn = P.job(nxt.job); PG8_VOFF(voffAn, voffBn, jn); hstepAn = (unsigned)(HALF * jn.lda * 2); hstepBn = (unsigned)(HALF * jn.ldb * 2); ntn = jn.nt;
            nA = (const char*)jn.A + (size_t)nxt.pm * 2 * hstepAn; nB = (const char*)jn.Bt + (size_t)nxt.pn * 2 * hstepBn; }
        for (int t = 0; t < nt; t += 2) {
            const bool last = (t == nt - 2);
            const char* a1 = cA + (size_t)(t + 1) * kstep;
            const char* a2 = last ? nA : cA + (size_t)(t + 2) * kstep; const char* b2 = last ? nB : cB + (size_t)(t + 2) * kstep;
            const char* a3 = a2 + kstep; const char* b3 = b2 + kstep;
            const unsigned hA2 = last ? hstepAn : hstepA, hB2 = last ? hstepBn : hstepB;
            unsigned vA2[2], vB2[2];
            vA2[0] = last ? voffAn[0] : voffA[0]; vA2[1] = last ? voffAn[1] : voffA[1]; vB2[0] = last ? voffBn[0] : voffB[0]; vB2[1] = last ? voffBn[1] : voffB[1];
            PG8_LDB(B0, 0, 0); PG8_LDB(B1, 0, 1); PG8_SCHED; PG8_LDA(At, 0, 0); PG8_STAGE(PG8_SA(1, 1), a1 + hstepA, voffA);
            PG8_WAIT_V(8); PG8_WAIT_L(0); PG8_BAR; PG8_MMA(0, 0, At, B0); PG8_MMA(0, 1, At, B1); PG8_BAR; PG8_SCHED;
            PG8_LDA(At, 0, 1); PG8_STAGE(PG8_SB(0, 0), b2, vB2); PG8_STAGE(PG8_SB(0, 1), b2 + hB2, vB2); PG8_STAGE(PG8_SA(0, 0), a2, vA2);
            PG8_WAIT_V(8); PG8_WAIT_L(0); PG8_BAR; PG8_MMA(1, 0, At, B0); PG8_MMA(1, 1, At, B1); PG8_BAR; PG8_SCHED;
            PG8_LDB(B0, 1, 0); PG8_LDB(B1, 1, 1); PG8_SCHED; PG8_LDA(At, 1, 0); PG8_STAGE(PG8_SA(0, 1), a2 + hA2, vA2);
            PG8_WAIT_V(8); PG8_WAIT_L(0); PG8_BAR; PG8_MMA(0, 0, At, B0); PG8_MMA(0, 1, At, B1); PG8_BAR; PG8_SCHED;
            PG8_LDA(At, 1, 1); PG8_STAGE(PG8_SB(1, 0), b3, vB2); PG8_STAGE(PG8_SB(1, 1), b3 + hB2, vB2); PG8_STAGE(PG8_SA(1, 0), a3, vA2);
            PG8_WAIT_V(8); PG8_WAIT_L(0); PG8_BAR; PG8_MMA(1, 0, At, B0); PG8_MMA(1, 1, At, B1); PG8_BAR; PG8_SCHED;
        }
        if (wr == 0) PG8_BAR;
        P.epilogue(acc, cur, wr, wc, fr, fq);
        if (!has_next) break;
#pragma unroll
        for (int a = 0; a < 2; ++a)
#pragma unroll
            for (int b = 0; b < 2; ++b)
#pragma unroll
                for (int m = 0; m < 4; ++m)
#pragma unroll
                    for (int n = 0; n < 2; ++n) acc[a][b][m][n] = (f32x4){0.f, 0.f, 0.f, 0.f};
        cur = nxt; cA = nA; cB = nB; nt = ntn; hstepA = hstepAn; hstepB = hstepBn; voffA[0] = voffAn[0]; voffA[1] = voffAn[1]; voffB[0] = voffBn[0]; voffB[1] = voffBn[1];
        if (wr == 1) PG8_BAR;
    }
    PG8_WAIT_V(0);
    PG8_BAR;
#undef PG8_VOFF
}
#undef PG8_SA
#undef PG8_SB
#undef PG8_STAGE
#undef PG8_LDA
#undef PG8_LDB
#undef PG8_MMA
#undef PG8_WAIT_V
#undef PG8_WAIT_L
#undef PG8_BAR
#undef PG8_SCHED
}

constexpr int NWAVES = 8, NTHREADS = 512;
constexpr int LDS_BYTES = 147456;

DI float wave_sum(float v) {
#pragma unroll
    for (int o = 1; o < 64; o <<= 1) v += __shfl_xor(v, o);
    return v;
}

DI void transpose_item(const float* W, int K, int N, const float* gk, bf16_t* WT, int dst_row0, int k0, int n0, LAS float* scr, int lane) {
    f32x4 wv[8]; float gv[8];
#pragma unroll
    for (int i = 0; i < 8; ++i) { const int kk = 8 * i + (lane >> 3), nq = (lane & 7) * 4; wv[i] = *(const f32x4*)(W + (size_t)(k0 + kk) * N + n0 + nq); gv[i] = gk ? gk[k0 + kk] : 1.0f; }
    asm volatile("" ::: "memory");
#pragma unroll
    for (int i = 0; i < 8; ++i) { const int kk = 8 * i + (lane >> 3), nq = (lane & 7) * 4; const f32x4 w = wv[i] * gv[i];
        LAS float* d = scr + kk * 33 + nq; d[0] = w[0]; d[1] = w[1]; d[2] = w[2]; d[3] = w[3]; }
    asm volatile("s_waitcnt lgkmcnt(0)" ::: "memory");
    const int c = lane & 7;
#pragma unroll
    for (int j = 0; j < 4; ++j) { const int n = (lane >> 3) + 8 * j; const LAS float* s = scr + (8 * c) * 33 + n;
        u32x4 o; o.x = pkbf(s[0 * 33], s[1 * 33]); o.y = pkbf(s[2 * 33], s[3 * 33]); o.z = pkbf(s[4 * 33], s[5 * 33]); o.w = pkbf(s[6 * 33], s[7 * 33]);
        *(u32x4*)(WT + (size_t)(dst_row0 + n) * K + k0 + 8 * c) = o; }
    asm volatile("s_waitcnt lgkmcnt(0)" ::: "memory");
}

struct Args { const float* in[22]; float* out; unsigned char* ws; };
constexpr int PTR_OFF = 131072;
DI unsigned long long ldq(LAS unsigned char* lds, int i) {
    unsigned off = (unsigned)(PTR_OFF + 8 * i); asm volatile("" : "+v"(off));
    const unsigned long long v = *(const LAS unsigned long long*)(lds + off);
    const unsigned lo = __builtin_amdgcn_readfirstlane((unsigned)v), hi = __builtin_amdgcn_readfirstlane((unsigned)(v >> 32));
    return ((unsigned long long)hi << 32) | lo;
}
#define GAS __attribute__((address_space(1)))
#define INP(i) ((const float*)(const GAS float*)ldq(lds, (i)))
#define OUTP ((float*)(GAS float*)ldq(lds, 22))
#define WSP ((unsigned char*)(GAS unsigned char*)ldq(lds, 23))

DI void prep_weights(int l, LAS unsigned char* lds, int gw, int NGW, int wave, int lane, int part = 0) {
    LAS float* scr = (LAS float*)(lds + wave * 16384);
    unsigned char* ws = WSP;
    constexpr int I_IN = 16 * 224, I_BR = 8 * 32, I_SQ = 16 * 32, I_GU = 16 * 88, I_DN = 44 * 32;
    constexpr int NSQ = 7; constexpr int NITEMS = I_IN + 3 * I_BR + NSQ * I_SQ + 2 * I_GU + I_DN;
    const int it_lo = part == 2 ? NITEMS - I_DN : 0, it_hi = part == 1 ? NITEMS - I_DN : NITEMS;
    for (int it = it_lo + gw; it < it_hi; it += NGW) {
        int r = it;
        if (r < I_IN) { const int kb = r / 224, nb = r % 224, n0 = nb * 32, seg = n0 >> 9;
            int base;
            switch (seg) { case 0: base = 0; break; case 1: base = 512; break; case 2: base = 3072; break; case 3: base = 1024; break; case 4: base = 3584; break;
                           case 5: base = 1536; break; case 6: base = 2048; break; case 7: base = 2560; break; default: base = seg * 512; break; }
            transpose_item(INP(3) + (size_t)l * D * INC, D, INC, INP(2) + l * D, (bf16_t*)(ws + WS_WIN), base + (n0 & 511), kb * 64, n0, scr, lane); continue; }
        r -= I_IN;
        if (r < 3 * I_BR) { const int n = r / I_BR, q = r % I_BR, kb = q / 32, nb = q % 32;
            transpose_item(INP(9) + ((size_t)l * 3 + n) * 512 * D, 512, D, nullptr, (bf16_t*)(ws + WS_WB) + (size_t)n * D * 512, nb * 32, kb * 64, nb * 32, scr, lane); continue; }
        r -= 3 * I_BR;
        if (r < NSQ * I_SQ) { const int w = r / I_SQ, q = r % I_SQ, kb = q / 32, nb = q % 32;
            const float* src; const float* gk = nullptr; size_t dst;
            if (l == 0 && w >= 5) {
                transpose_item(INP(w == 5 ? 14 : 15) + (size_t)D * D, D, D, nullptr, (bf16_t*)(ws + (w == 5 ? WS_WK1 : WS_WV1)), nb * 32, kb * 64, nb * 32, scr, lane); continue; }
            if (w >= 5 || (l == 1 && (w == 2 || w == 3))) continue;
            switch (w) { case 0: src = INP(10); dst = WS_WOUT; break; case 1: src = INP(13); dst = WS_WQ; gk = INP(11) + l * D; break; case 2: src = INP(14); dst = WS_WK; break;
                         case 3: src = INP(15); dst = WS_WV; break; default: src = INP(16); dst = WS_WOX; break; }
            transpose_item(src + (size_t)l * D * D, D, D, gk, (bf16_t*)(ws + dst), nb * 32, kb * 64, nb * 32, scr, lane); continue; }
        r -= NSQ * I_SQ;
        if (r < 2 * I_GU) { const int w = r / I_GU, q = r % I_GU, kb = q / 88, nb = q % 88, n0 = nb * 32;
            transpose_item(INP(18 + w) + (size_t)l * D * FF, D, FF, INP(17) + l * D, (bf16_t*)(ws + WS_WGU), (n0 >> 7) * 256 + w * 128 + (n0 & 127), kb * 64, n0, scr, lane); continue; }
        r -= 2 * I_GU;
        { const int kb = r / 32, nb = r % 32;
          transpose_item(INP(20) + (size_t)l * FF * D, FF, D, nullptr, (bf16_t*)(ws + WS_WD), nb * 32, kb * 64, nb * 32, scr, lane); }
    }
    if (l == 0) {
        for (int row2 = gw; row2 < 2 * NBATCH * 256; row2 += NGW) {
            const int lay = row2 >> 10, row = row2 & 1023; const float* mg = INP(12) + lay * D;
            const f32x4* xr = (const f32x4*)(INP(1) + (size_t)row * D) + lane; f32x4 v[4]; float s = 0.f;
#pragma unroll
            for (int j = 0; j < 4; ++j) { v[j] = xr[64 * j]; s += (v[j][0] * v[j][0] + v[j][1] * v[j][1]) + (v[j][2] * v[j][2] + v[j][3] * v[j][3]); }
            const float rs = 1.0f / sqrtf(wave_sum(s) * (1.0f / D) + RMS_EPS);
            u32x2* o = (u32x2*)((bf16_t*)(ws + (lay ? WS_MB1 : WS_MB)) + (size_t)row * D) + lane;
#pragma unroll
            for (int j = 0; j < 4; ++j) { const f32x4 gv = *((const f32x4*)mg + lane + 64 * j); u32x2 w; w.x = pkbf(v[j][0] * rs * gv[0], v[j][1] * rs * gv[1]); w.y = pkbf(v[j][2] * rs * gv[2], v[j][3] * rs * gv[3]); o[64 * j] = w; }
        }
    }
}

DI void prep_x(LAS unsigned char* lds, int gw, int NGW, int lane) {
    unsigned char* ws = WSP; const float* xin = INP(0);
    float* ssp = (float*)(ws + WS_SSP);
    for (int row = gw; row < M; row += NGW) {
        const f32x4* xr = (const f32x4*)(xin + (size_t)row * D) + lane; f32x4 v[4]; float s = 0.f;
#pragma unroll
        for (int j = 0; j < 4; ++j) { v[j] = xr[64 * j]; s += (v[j][0] * v[j][0] + v[j][1] * v[j][1]) + (v[j][2] * v[j][2] + v[j][3] * v[j][3]); }
        s = wave_sum(s);
        u32x2* o = (u32x2*)((bf16_t*)(ws + WS_XB) + (size_t)row * D) + lane;
#pragma unroll
        for (int j = 0; j < 4; ++j) { u32x2 w; w.x = pkbf(v[j][0], v[j][1]); w.y = pkbf(v[j][2], v[j][3]); o[64 * j] = w; }
        if (lane < 16) ssp[(size_t)row * 16 + lane] = lane == 0 ? s : 0.f;
    }
}

DI void final_norm(LAS unsigned char* lds, int gw, int NGW, int lane) {
    const float* fg = INP(21); float* outp = OUTP; const float* ssp = (const float*)(WSP + WS_SSP);
    for (int row = gw; row < M; row += NGW) {
        f32x4* xr = (f32x4*)(outp + (size_t)row * D) + lane; const u32x2* xbr = (const u32x2*)((const bf16_t*)(WSP + WS_XB) + (size_t)row * D) + lane;
        float s = lane < 16 ? ssp[(size_t)row * 16 + lane] : 0.f; s = wave_sum(s);
        const float rs = 1.0f / sqrtf(s * (1.0f / D) + RMS_EPS);
#pragma unroll
        for (int j = 0; j < 4; ++j) { const f32x4 gv = *((const f32x4*)fg + lane + 64 * j); const u32x2 w = xbr[64 * j]; xr[64 * j] = (f32x4){bflo(w.x), bfhi(w.x), bflo(w.y), bfhi(w.y)} * rs * gv; }
    }
}

DI void sb_attn_item(bf16_t* p, const bf16_t* T, int item, int lane) {
    const int b = item >> 10, h = (item >> 7) & 7, qb = item & 127;
    const int hl = lane >> 5, li = lane & 31;
    const size_t rowbase = (size_t)b * SEQ;
    const int kperm = (li & 16) | ((li & 4) << 1) | ((li & 8) >> 1) | (li & 3);
    const bf16_t* qrow = p + (rowbase + qb * 32 + li) * PC + h * 64 + 8 * hl;
    bf16x8 qf[4];
#pragma unroll
    for (int kk = 0; kk < 4; ++kk) qf[kk] = *(const bf16x8*)(qrow + 16 * kk);
    bf16x8 U[2];
#pragma unroll
    for (int c = 0; c < 2; ++c)
#pragma unroll
        for (int e = 0; e < 8; ++e) U[c][e] = (16 * c + 8 * hl + e >= kperm) ? (short)0x3f80 : (short)0;
    f32x16 o0, o1;
#pragma unroll
    for (int r = 0; r < 16; ++r) { o0[r] = 0.f; o1[r] = 0.f; }
    float carry = 0.f;
    const bf16_t* vt0 = T + (size_t)(h * 64 + li) * M + rowbase + 8 * hl;
    for (int kb = qb; kb >= 0; --kb) {
        const int s0 = kb * 32;
        const bf16_t* krow = p + (rowbase + s0 + kperm) * PC + 512 + h * 64 + 8 * hl;
        bf16x8 kf[4], vf[4];
#pragma unroll
        for (int kk = 0; kk < 4; ++kk) kf[kk] = *(const bf16x8*)(krow + 16 * kk);
#pragma unroll
        for (int c = 0; c < 2; ++c) { vf[c] = *(const bf16x8*)(vt0 + s0 + 16 * c); vf[2 + c] = *(const bf16x8*)(vt0 + (size_t)32 * M + s0 + 16 * c); }
        f32x16 z;
#pragma unroll
        for (int r = 0; r < 16; ++r) z[r] = 0.f;
#pragma unroll
        for (int kk = 0; kk < 4; ++kk) z = MFMA32(kf[kk], qf[kk], z);
        const bool diag = (kb == qb);
        float Lv[16];
#pragma unroll
        for (int r = 0; r < 16; ++r) {
            const float zz = z[r];
            float L = fmaxf(zz, 0.f) + LN2 * __builtin_amdgcn_logf(1.0f + __builtin_amdgcn_exp2f(-fabsf(zz) * LOG2E));
            if (diag && !(16 * (r >> 3) + 8 * hl + (r & 7) < li)) L = 0.f;
            Lv[r] = L;
        }
        bf16x8 Lh[2], Ll[2];
#pragma unroll
        for (int c = 0; c < 2; ++c) { u32x4 wh, wl;
#pragma unroll
            for (int e = 0; e < 4; ++e) { const float a0 = Lv[8 * c + 2 * e], a1 = Lv[8 * c + 2 * e + 1]; const unsigned hp = pkbf(a0, a1); wh[e] = hp; wl[e] = pkbf(a0 - bflo(hp), a1 - bfhi(hp)); }
            Lh[c] = __builtin_bit_cast(bf16x8, wh); Ll[c] = __builtin_bit_cast(bf16x8, wl); }
        f32x16 C;
#pragma unroll
        for (int r = 0; r < 16; ++r) C[r] = carry;
        C = MFMA32(U[0], Lh[0], C); C = MFMA32(U[1], Lh[1], C); C = MFMA32(U[0], Ll[0], C); C = MFMA32(U[1], Ll[1], C);
        bf16x8 pf[2];
#pragma unroll
        for (int c = 0; c < 2; ++c) { u32x4 w;
#pragma unroll
            for (int e = 0; e < 4; ++e) { float a0, a1; { const int r = 8 * c + 2 * e; a0 = __builtin_amdgcn_exp2f((z[r] - C[r]) * LOG2E); a1 = __builtin_amdgcn_exp2f((z[r + 1] - C[r + 1]) * LOG2E);
                    if (diag) { if (!(16 * c + 8 * hl + 2 * e < li)) a0 = 0.f; if (!(16 * c + 8 * hl + 2 * e + 1 < li)) a1 = 0.f; } }
                w[e] = pkbf(a0, a1); }
            pf[c] = __builtin_bit_cast(bf16x8, w); }
        carry = __shfl(C[0], li);
        o0 = MFMA32(vf[0], pf[0], o0); o0 = MFMA32(vf[1], pf[1], o0);
        o1 = MFMA32(vf[2], pf[0], o1); o1 = MFMA32(vf[3], pf[1], o1);
        if (__all(carry > SB_EXIT)) break;
    }
    bf16_t* orow = p + (rowbase + qb * 32 + li) * PC + h * 64 + 4 * hl;
#pragma unroll
    for (int g = 0; g < 4; ++g) {
        u32x2 w0, w1; w0.x = pkbf(o0[4 * g], o0[4 * g + 1]); w0.y = pkbf(o0[4 * g + 2], o0[4 * g + 3]); w1.x = pkbf(o1[4 * g], o1[4 * g + 1]); w1.y = pkbf(o1[4 * g + 2], o1[4 * g + 3]);
        *(u32x2*)(orow + 8 * g) = w0; *(u32x2*)(orow + 32 + 8 * g) = w1; }
}

DI void sgu_item(int l, bf16_t* p, const bf16_t* T, int item, LAS unsigned char* lds, int tid, int wave, int lane) {
    const int g = item & 3, n = (item >> 2) & 31, b = item >> 7;
    const size_t tok0 = (size_t)b * SEQ + n * 128;
    const bf16_t* zv = T + (size_t)512 * M;
    LAS float* red = (LAS float*)lds;
    LAS float* mean = (LAS float*)(lds + 8192);
    LAS float* rstd = (LAS float*)(lds + 8192 + 512);
    {
        float s0 = 0.f, s1 = 0.f, q0 = 0.f, q1 = 0.f;
        const bf16_t* src = zv + (size_t)(wave * 64) * M + tok0 + 2 * lane;
#pragma unroll 1
        for (int jb = 0; jb < 64; jb += 16) {
            unsigned wv[16];
#pragma unroll
            for (int j = 0; j < 16; ++j) wv[j] = *(const unsigned*)(src + (size_t)(jb + j) * M);
            asm volatile("" ::: "memory");
#pragma unroll
            for (int j = 0; j < 16; ++j) { const float a0 = bflo(wv[j]), a1 = bfhi(wv[j]); s0 += a0; s1 += a1; q0 += a0 * a0; q1 += a1 * a1; }
        }
        *(LAS f32x4*)(red + (wave * 64 + lane) * 4) = (f32x4){s0, q0, s1, q1};
    }
    __syncthreads();
    if (tid < 128) { float s = 0.f, q = 0.f;
#pragma unroll
        for (int w = 0; w < 8; ++w) { const f32x2 v = *(LAS f32x2*)(red + (w * 64 + (tid >> 1)) * 4 + (tid & 1) * 2); s += v.x; q += v.y; }
        const float mu = s * (1.0f / 512.0f), var = fmaxf(q * (1.0f / 512.0f) - mu * mu, 0.f);
        mean[tid] = mu; rstd[tid] = 1.0f / sqrtf(var + LN_EPS); }
    __syncthreads();
    const int cblk = wave & 3, th = wave >> 2, hl = lane >> 5, li = lane & 31;
    const int cch = g * 128 + cblk * 32 + li;
    const float lg = INP(4)[l * 512 + cch], lb = INP(5)[l * 512 + cch];
    const bf16_t* arow = zv + (size_t)cch * M + tok0 + 8 * hl;
    const float* wsp = INP(6) + ((size_t)(l * 4 + g) * 128) * 128;
    f32x16 acc0, acc1;
#pragma unroll
    for (int r = 0; r < 16; ++r) { acc0[r] = 0.f; acc1[r] = 0.f; }
#pragma unroll
    for (int hf = 0; hf < 2; ++hf) if (hf == 0 || th) {
        u32x4 raw[4]; f32x4 wv[4][2][2];
#pragma unroll
        for (int k4 = 0; k4 < 4; ++k4) { const int kk = 4 * hf + k4, sb = 16 * kk + 8 * hl;
            raw[k4] = *(const u32x4*)(arow + 16 * kk);
#pragma unroll
            for (int tb = 0; tb < 2; ++tb) { const int t = th * 64 + tb * 32 + li; wv[k4][tb][0] = *(const f32x4*)(wsp + (size_t)t * 128 + sb); wv[k4][tb][1] = *(const f32x4*)(wsp + (size_t)t * 128 + sb + 4); } }
        asm volatile("" ::: "memory");
#pragma unroll
        for (int k4 = 0; k4 < 4; ++k4) { const int kk = 4 * hf + k4, sb = 16 * kk + 8 * hl;
            const f32x4 m0 = *(LAS f32x4*)(mean + sb), m1 = *(LAS f32x4*)(mean + sb + 4), r0 = *(LAS f32x4*)(rstd + sb), r1 = *(LAS f32x4*)(rstd + sb + 4);
            const u32x4 rw = raw[k4]; u32x4 aw;
            aw.x = pkbf((bflo(rw.x) - m0[0]) * r0[0] * lg + lb, (bfhi(rw.x) - m0[1]) * r0[1] * lg + lb);
            aw.y = pkbf((bflo(rw.y) - m0[2]) * r0[2] * lg + lb, (bfhi(rw.y) - m0[3]) * r0[3] * lg + lb);
            aw.z = pkbf((bflo(rw.z) - m1[0]) * r1[0] * lg + lb, (bfhi(rw.z) - m1[1]) * r1[1] * lg + lb);
            aw.w = pkbf((bflo(rw.w) - m1[2]) * r1[2] * lg + lb, (bfhi(rw.w) - m1[3]) * r1[3] * lg + lb);
            const bf16x8 af = __builtin_bit_cast(bf16x8, aw);
#pragma unroll
            for (int tb = 0; tb < 2; ++tb) { const f32x4 w0 = wv[k4][tb][0], w1 = wv[k4][tb][1];
                u32x4 bw; bw.x = pkbf(w0[0], w0[1]); bw.y = pkbf(w0[2], w0[3]); bw.z = pkbf(w1[0], w1[1]); bw.w = pkbf(w1[2], w1[3]);
                const bf16x8 bfr = __builtin_bit_cast(bf16x8, bw);
                if (tb == 0) acc0 = MFMA32(af, bfr, acc0); else acc1 = MFMA32(af, bfr, acc1); } }
    }
#pragma unroll
    for (int tb = 0; tb < 2; ++tb) {
        const int t = th * 64 + tb * 32 + li; const float bs = INP(7)[(l * 4 + g) * 128 + t];
        bf16_t* urow = p + (tok0 + t) * PC + 1024 + g * 128 + cblk * 32 + 4 * hl;
        u32x2 uws[4];
#pragma unroll
        for (int q = 0; q < 4; ++q) uws[q] = *(const u32x2*)(urow + 8 * q);
#pragma unroll
        for (int q = 0; q < 4; ++q) { const u32x2 uw = uws[q];
            float v0, v1, v2, v3;
            if (tb == 0) { v0 = acc0[4 * q]; v1 = acc0[4 * q + 1]; v2 = acc0[4 * q + 2]; v3 = acc0[4 * q + 3]; } else { v0 = acc1[4 * q]; v1 = acc1[4 * q + 1]; v2 = acc1[4 * q + 2]; v3 = acc1[4 * q + 3]; }
            u32x2 ow; ow.x = pkbf(bflo(uw.x) * (v0 + bs), bfhi(uw.x) * (v1 + bs)); ow.y = pkbf(bflo(uw.y) * (v2 + bs), bfhi(uw.y) * (v3 + bs));
            *(u32x2*)(urow + 8 * q) = ow; }
    }
    __syncthreads();
}

DI void conv_phase(int l, bf16_t* p, LAS unsigned char* lds, int gtid, int NGT) {
    const float* cw = INP(8) + (size_t)l * 3 * 512;
    for (int it = gtid; it < M * 64; it += NGT) {
        const int row = it >> 6, c8 = (it & 63) * 8, t = row & (SEQ - 1);
        bf16_t* pr = p + (size_t)row * PC;
        float accv[8];
#pragma unroll
        for (int e = 0; e < 8; ++e) accv[e] = 0.f;
        u32x4 ccv[3], cxv[3];
#pragma unroll
        for (int j = 0; j < 3; ++j) { const int dt = (t - (2 - j) >= 0) ? 2 - j : 0;
            ccv[j] = *(const u32x4*)(pr - (size_t)dt * PC + 2048 + c8); cxv[j] = *(const u32x4*)(pr - (size_t)dt * PC + 2560 + c8); }
        const u32x4 cb = *(const u32x4*)(pr + 1536 + c8);
        asm volatile("" ::: "memory");
#pragma unroll
        for (int j = 0; j < 3; ++j) { const int dt = 2 - j;
            if (t - dt >= 0) {
                const u32x4 cc = ccv[j], cx = cxv[j];
                const f32x4 w0 = *(const f32x4*)(cw + j * 512 + c8), w1 = *(const f32x4*)(cw + j * 512 + c8 + 4);
                accv[0] += w0[0] * bflo(cc.x) * bflo(cx.x); accv[1] += w0[1] * bfhi(cc.x) * bfhi(cx.x); accv[2] += w0[2] * bflo(cc.y) * bflo(cx.y); accv[3] += w0[3] * bfhi(cc.y) * bfhi(cx.y);
                accv[4] += w1[0] * bflo(cc.z) * bflo(cx.z); accv[5] += w1[1] * bfhi(cc.z) * bfhi(cx.z); accv[6] += w1[2] * bflo(cc.w) * bflo(cx.w); accv[7] += w1[3] * bfhi(cc.w) * bfhi(cx.w); } }
        u32x4 o; o.x = pkbf(bflo(cb.x) * accv[0], bfhi(cb.x) * accv[1]); o.y = pkbf(bflo(cb.y) * accv[2], bfhi(cb.y) * accv[3]); o.z = pkbf(bflo(cb.z) * accv[4], bfhi(cb.z) * accv[5]); o.w = pkbf(bflo(cb.w) * accv[6], bfhi(cb.w) * accv[7]);
        *(u32x4*)(pr + 1536 + c8) = o;
    }
}

DI void xattn_wg(const bf16_t* qx, const bf16_t* memK, const bf16_t* memVT, bf16_t* ox, int item, int tid, int wave, int lane, LAS unsigned char* lds) {
    const int b = item >> 6, h = (item >> 4) & 3, qb = (item & 15) * 8 + wave;
    const int hl = lane >> 5, li = lane & 31;
    const size_t qrow = (size_t)b * SEQ + qb * 32 + li;
    bf16x8 qf[16];
#pragma unroll
    for (int kk = 0; kk < 16; ++kk) qf[kk] = *(const bf16x8*)(qx + qrow * D + h * 256 + 16 * kk + 8 * hl);
    const int sr = tid >> 4, sp0 = (tid & 15) * 2;
    const int kperm_sr = (sr & 16) | ((sr & 4) << 1) | ((sr & 8) >> 1) | (sr & 3);
    const bf16_t* kbase = memK + (size_t)(b * 256) * D + h * 256;
    const bf16_t* vbase = memVT + (size_t)(h * 256) * D + b * 256;
    u32x4 st[2], sn[2];
#define XA_LOAD(R, c) do { if ((c) < 8) { _Pragma("unroll") for (int e = 0; e < 2; ++e) R[e] = *(const u32x4*)(kbase + (size_t)((c) * 32 + sr) * D + (sp0 + e) * 8); } \
                           else { _Pragma("unroll") for (int e = 0; e < 2; ++e) R[e] = *(const u32x4*)(vbase + (size_t)(((c) - 8) * 32 + sr) * D + (sp0 + e) * 8); } } while (0)
#define XA_STORE(R, c) do { const int rl = (c) < 8 ? kperm_sr : sr; _Pragma("unroll") for (int e = 0; e < 2; ++e) { const int p = sp0 + e; \
                           *(LAS u32x4*)(lds + ((c) & 1) * 16384 + (((p >> 1) * 64) + (p & 1) * 32 + rl) * 16) = R[e]; } } while (0)
    XA_LOAD(st, 0); XA_STORE(st, 0); XA_LOAD(st, 1);
    __syncthreads();
    f32x16 S[8];
#pragma unroll
    for (int c = 0; c < 8; ++c) {
        XA_LOAD(sn, c + 2);
        f32x16 z;
#pragma unroll
        for (int r = 0; r < 16; ++r) z[r] = 0.f;
        const LAS unsigned char* buf = lds + (c & 1) * 16384 + lane * 16;
#pragma unroll
        for (int kk = 0; kk < 16; ++kk) { const bf16x8 kf = *(const LAS bf16x8*)(buf + kk * 1024); z = MFMA32(kf, qf[kk], z); }
        S[c] = z;
        XA_STORE(st, c + 1);
        __syncthreads();
        st[0] = sn[0]; st[1] = sn[1];
    }
    float mx = -3.0e38f;
#pragma unroll
    for (int kb = 0; kb < 8; ++kb)
#pragma unroll
        for (int r = 0; r < 16; ++r) mx = fmaxf(mx, S[kb][r]);
    mx = fmaxf(mx, __shfl_xor(mx, 32));
    float sum = 0.f;
    bf16x8 pf[16];
#pragma unroll
    for (int kb = 0; kb < 8; ++kb)
#pragma unroll
        for (int c = 0; c < 2; ++c) { u32x4 w;
#pragma unroll
            for (int e = 0; e < 4; ++e) { const float a0 = __builtin_amdgcn_exp2f((S[kb][8 * c + 2 * e] - mx) * LOG2E), a1 = __builtin_amdgcn_exp2f((S[kb][8 * c + 2 * e + 1] - mx) * LOG2E); sum += a0 + a1; w[e] = pkbf(a0, a1); }
            pf[2 * kb + c] = __builtin_bit_cast(bf16x8, w); }
    sum += __shfl_xor(sum, 32);
    const float inv = 1.0f / sum;
    bf16_t* orow = ox + qrow * D + h * 256 + 4 * hl;
#pragma unroll 1
    for (int c = 8; c < 16; ++c) {
        if (c + 2 < 16) XA_LOAD(sn, c + 2);
        f32x16 o;
#pragma unroll
        for (int r = 0; r < 16; ++r) o[r] = 0.f;
        const LAS unsigned char* buf = lds + (c & 1) * 16384 + lane * 16;
#pragma unroll
        for (int s = 0; s < 16; ++s) { const bf16x8 vf = *(const LAS bf16x8*)(buf + s * 1024); o = MFMA32(vf, pf[s], o); }
        const int db = c - 8;
#pragma unroll
        for (int g = 0; g < 4; ++g) { u32x2 w; w.x = pkbf(o[4 * g] * inv, o[4 * g + 1] * inv); w.y = pkbf(o[4 * g + 2] * inv, o[4 * g + 3] * inv); *(u32x2*)(orow + db * 32 + 8 * g) = w; }
        if (c + 1 < 16) XA_STORE(st, c + 1);
        __syncthreads();
        st[0] = sn[0]; st[1] = sn[1];
    }
#undef XA_LOAD
#undef XA_STORE
}

constexpr int RSD_OFF = 131072 + 768, RS_OFF = 131072 + 1024, RS_MAXU = 15;
template <class Prog>
DI void fill_rs(LAS unsigned char* lds, Prog P2, const float* ssp, int tid) {
    LAS int* desc = (LAS int*)(lds + RSD_OFF);
    if (tid == 0) { pg8::UnitX x; int n = 0; while (n < RS_MAXU && P2.next(x)) { desc[n] = P2.rs_base(x); ++n; } desc[RS_MAXU] = n; }
    __syncthreads();
    const int n = desc[RS_MAXU];
    for (int kb = 0; kb < n; kb += 8) {
        f32x4 sv[4][4]; int ok[4];
#pragma unroll
        for (int j = 0; j < 4; ++j) { const int k = kb + 2 * j + (tid >> 8); const int base = k < n ? desc[k] : -1; ok[j] = base >= 0;
            const f32x4* sp = (const f32x4*)(ssp + (size_t)((ok[j] ? base : 0) + (tid & 255)) * 16);
#pragma unroll
            for (int q = 0; q < 4; ++q) sv[j][q] = ok[j] ? sp[q] : (f32x4){0.f, 0.f, 0.f, 0.f}; }
        asm volatile("" ::: "memory");
#pragma unroll
        for (int j = 0; j < 4; ++j) if (ok[j]) { const int k = kb + 2 * j + (tid >> 8); float s = 0.f;
#pragma unroll
            for (int q = 0; q < 4; ++q) s += (sv[j][q][0] + sv[j][q][1]) + (sv[j][q][2] + sv[j][q][3]);
            ((LAS float*)(lds + RS_OFF))[k * 256 + (tid & 255)] = 1.0f / sqrtf(s * (1.0f / D) + RMS_EPS); }
    }
    __syncthreads();
}
struct ProgC {
    unsigned char* ws; LAS unsigned char* lds; int G, c; int j, i, kk; pg8::Unit u; bool have;
    DI int rs_base(const pg8::UnitX& x) const { return (x.job & 1) ? -1 : x.pm * 256; }
    DI void init(unsigned char* ws_, int G_, int c_, LAS unsigned char* lds_) { lds = lds_; kk = 0; ws = ws_; G = G_; c = c_; j = 0; i = 0; pg8::StaticOrder S; S.init(M, D, G, c); have = S.next(0, u); }
    DI bool next(pg8::UnitX& x) {
        if (have && j >= 6) { pg8::StaticOrder S; S.init(M, D, G, c); ++i; j = 0; have = S.next(i, u); }
        if (!have) return false;
        x.pm = u.pm; x.pn = u.pn; x.job = j; x.k = kk; ++kk; ++j; return true; }
    DI pg8::JobP job(int jj) const { const int n = jj >> 1; pg8::JobP p;
        if ((jj & 1) == 0) { p.A = (const bf16_t*)(ws + WS_XB); p.Bt = (const bf16_t*)(ws + WS_WIN) + (size_t)(4096 + n * 1024) * D; p.lda = D; p.ldb = D; p.nt = D / 64; }
        else { const int acol = n == 0 ? 0 : (n == 1 ? 1024 : 1536); p.A = (const bf16_t*)(ws + WS_P) + acol; p.Bt = (const bf16_t*)(ws + WS_WB) + (size_t)n * D * 512; p.lda = PC; p.ldb = 512; p.nt = 512 / 64; }
        return p; }
    DI void epilogue(const f32x4 (&acc)[2][2][4][2], const pg8::UnitX& x, int wr, int wc, int fr, int fq) const {
        pg8::EpiArgs ea{}; const pg8::Unit uu{x.pm, x.pn};
        if ((x.job & 1) == 0) { ea.O = (bf16_t*)(ws + WS_T); ea.ldc = D; ea.ssp = (const float*)(ws + WS_SSP); ea.rstab = x.k < RS_MAXU ? (const LAS float*)(lds + RS_OFF) + x.k * 256 : nullptr; ea.cscale = 1.f; pg8::Epi<pg8::E_GATE> E{ea}; E(acc, uu, wr, wc, fr, fq); }
        else { ea.O = (bf16_t*)(ws + WS_X2); ea.ldc = D; ea.G = (const bf16_t*)(ws + WS_T);
            if (x.job == 1) { pg8::Epi<pg8::E_BR0> E{ea}; E(acc, uu, wr, wc, fr, fq); } else { pg8::Epi<pg8::E_BRN> E{ea}; E(acc, uu, wr, wc, fr, fq); } }
    }
};
struct ProgA {
    unsigned char* ws; LAS unsigned char* lds; int G, c; int jb, i, njobs, kk;
    DI int rs_base(const pg8::UnitX& x) const { return x.job == 0 ? x.pm * 256 : (x.job == 1 ? x.pn * 256 : -1); }
    DI void init(unsigned char* ws_, int G_, int c_, int l, LAS unsigned char* lds_) { lds = lds_; kk = 0; ws = ws_; G = G_; c = c_; jb = 0; i = 0; njobs = l == 0 ? 4 : 2; }
    DI bool next(pg8::UnitX& x) {
        for (; jb < njobs; ++jb, i = 0) {
            pg8::StaticOrder S; pg8::Unit u;
            if (jb == 0) S.init(M, 3072, G, c); else if (jb == 1) S.init(1024, M, G, c); else if (jb == 2) S.init(1024, D, G, (c + 64) % G); else S.init(D, 1024, G, (c + 192) % G);
            if (S.next(i, u)) { x.pm = u.pm; x.pn = u.pn; x.job = jb; x.k = kk; ++kk; ++i; return true; }
        }
        return false;
    }
    DI pg8::JobP job(int jj) const { pg8::JobP p; p.lda = D; p.ldb = D; p.nt = D / 64;
        if (jj == 0) { p.A = (const bf16_t*)(ws + WS_XB); p.Bt = (const bf16_t*)(ws + WS_WIN); }
        else if (jj == 1) { p.A = (const bf16_t*)(ws + WS_WIN) + (size_t)3072 * D; p.Bt = (const bf16_t*)(ws + WS_XB); }
        else if (jj == 2) { p.A = (const bf16_t*)(ws + WS_MB); p.Bt = (const bf16_t*)(ws + WS_WK); }
        else { p.A = (const bf16_t*)(ws + WS_WV); p.Bt = (const bf16_t*)(ws + WS_MB); }
        return p; }
    DI void epilogue(const f32x4 (&acc)[2][2][4][2], const pg8::UnitX& x, int wr, int wc, int fr, int fq) const {
        pg8::EpiArgs ea{}; const pg8::Unit uu{x.pm, x.pn};
        const LAS float* rst = x.k < RS_MAXU ? (const LAS float*)(lds + RS_OFF) + x.k * 256 : nullptr;
        if (x.job == 0) { ea.O = (bf16_t*)(ws + WS_P); ea.ldc = PC; ea.ssp = (const float*)(ws + WS_SSP); ea.rstab = rst; ea.cscale = 1.f; pg8::Epi<pg8::E_INPROJ> E{ea}; E(acc, uu, wr, wc, fr, fq); }
        else if (x.job == 2) { ea.O = (bf16_t*)(ws + WS_MEMK); ea.ldc = D; ea.ssp = nullptr; ea.cscale = 1.f; pg8::Epi<pg8::E_ROWSCALE> E{ea}; E(acc, uu, wr, wc, fr, fq); }
        else { if (x.job == 1) { ea.O = (bf16_t*)(ws + WS_T); ea.ldc = M; ea.ssp = (const float*)(ws + WS_SSP); ea.rstab = rst; } else { ea.O = (bf16_t*)(ws + WS_MEMVT); ea.ldc = 1024; ea.ssp = nullptr; }
            pg8::Epi<pg8::E_TRANS> E{ea}; E(acc, uu, wr, wc, fr, fq); }
    }
};
struct ProgJ {
    unsigned char* ws; LAS unsigned char* lds; int G, c; int jb, i, njobs, kk;
    DI int rs_base(const pg8::UnitX& x) const { return x.job == 0 ? x.pm * 256 : -1; }
    DI void init(unsigned char* ws_, int G_, int c_, int l, LAS unsigned char* lds_) { lds = lds_; kk = 0; ws = ws_; G = G_; c = c_; jb = 0; i = 0; njobs = l == 0 ? 3 : 1; }
    DI bool next(pg8::UnitX& x) {
        for (; jb < njobs; ++jb, i = 0) {
            pg8::StaticOrder S; pg8::Unit u;
            if (jb == 0) S.init(M, 2 * FF, G, c); else if (jb == 1) S.init(1024, D, G, (c + 128) % G); else S.init(D, 1024, G, (c + 96) % G);
            if (S.next(i, u)) { x.pm = u.pm; x.pn = u.pn; x.job = jb; x.k = kk; ++kk; ++i; return true; }
        }
        return false;
    }
    DI pg8::JobP job(int jj) const { pg8::JobP p; p.lda = D; p.ldb = D; p.nt = D / 64;
        if (jj == 0) { p.A = (const bf16_t*)(ws + WS_XB); p.Bt = (const bf16_t*)(ws + WS_WGU); }
        else if (jj == 1) { p.A = (const bf16_t*)(ws + WS_MB1); p.Bt = (const bf16_t*)(ws + WS_WK1); }
        else { p.A = (const bf16_t*)(ws + WS_WV1); p.Bt = (const bf16_t*)(ws + WS_MB1); }
        return p; }
    DI void epilogue(const f32x4 (&acc)[2][2][4][2], const pg8::UnitX& x, int wr, int wc, int fr, int fq) const {
        pg8::EpiArgs ea{}; const pg8::Unit uu{x.pm, x.pn};
        if (x.job == 0) { ea.O = (bf16_t*)(ws + WS_P); ea.ldc = FF; ea.ssp = (const float*)(ws + WS_SSP) + (size_t)2 * M * 16; ea.rstab = x.k < RS_MAXU ? (const LAS float*)(lds + RS_OFF) + x.k * 256 : nullptr; pg8::Epi<pg8::E_SWIGLU> E{ea}; E(acc, uu, wr, wc, fr, fq); }
        else if (x.job == 1) { ea.O = (bf16_t*)(ws + WS_MEMK1); ea.ldc = D; ea.ssp = nullptr; ea.cscale = 1.f; pg8::Epi<pg8::E_ROWSCALE> E{ea}; E(acc, uu, wr, wc, fr, fq); }
        else { ea.O = (bf16_t*)(ws + WS_MEMVT1); ea.ldc = 1024; ea.ssp = nullptr; pg8::Epi<pg8::E_TRANS> E{ea}; E(acc, uu, wr, wc, fr, fq); }
    }
};
#define XB_TMO      128
#define XB_XCNT(j)  (256  + 64 * (j))
#define XB_XSUB(j)  (1280 + 64 * (j))
#define XB_XGEN(j)  (2304 + 64 * (j))
#define XB_TOP      3328
#define XB_TOPGEN   3392
#define XCD_BAR_WORDS 3456
#define XB_SPIN_CAP (1u << 18)

__device__ __forceinline__ unsigned xb_ld(unsigned* p)              { return __hip_atomic_load(p, __ATOMIC_RELAXED, __HIP_MEMORY_SCOPE_AGENT); }
__device__ __forceinline__ unsigned xb_add(unsigned* p, unsigned v) { return __hip_atomic_fetch_add(p, v, __ATOMIC_RELAXED, __HIP_MEMORY_SCOPE_AGENT); }
__device__ __forceinline__ unsigned xb_xcc_id() { return (unsigned)__builtin_amdgcn_s_getreg((3 << 11) | 20) & 0xFu; }
#define XB_SPIN(cond, bar) do { unsigned _sp = 0; while (cond) { __builtin_amdgcn_s_sleep(1); \
    if ((++_sp & 255u) == 0u) { if (xb_ld(&(bar)[XB_TMO])) break; if (_sp > XB_SPIN_CAP) { atomicAdd(&(bar)[XB_TMO], 1u); break; } } } } while (0)

struct XcdBarrier {
    unsigned* bar; unsigned x;
    volatile LAS unsigned* st;
};

__device__ __forceinline__ XcdBarrier xcd_barrier_post(unsigned* bar, volatile LAS unsigned* st) {
    XcdBarrier b; b.bar = bar; b.x = xb_xcc_id(); b.st = st;
    if (threadIdx.x == 0) (void)xb_add(&bar[XB_XCNT(b.x)], 1u);
    return b;
}
__device__ __forceinline__ void xcd_barrier_complete(unsigned* bar, unsigned x, unsigned& nloc, unsigned& nx) {
    const unsigned G = gridDim.x * gridDim.y * gridDim.z;
    unsigned sum, cnt, mine, sp = 0u;
    for (;;) {
        sum = 0u; cnt = 0u; mine = 0u;
#pragma unroll
        for (unsigned j = 0; j < 16; ++j) { const unsigned c = xb_ld(&bar[XB_XCNT(j)]); sum += c; cnt += (c > 0u) ? 1u : 0u; mine = (j == x) ? c : mine; }
        if (sum == G) break;
        __builtin_amdgcn_s_sleep(1);
        if ((++sp & 255u) == 0u) { if (xb_ld(&bar[XB_TMO])) break; if (sp > XB_SPIN_CAP) { atomicAdd(&bar[XB_TMO], 1u); break; } }
    }
    nloc = mine > 0u ? mine : 1u; nx = cnt > 0u ? cnt : 1u;
}

__device__ __forceinline__ void xcd_barrier(const XcdBarrier& b) {
    asm volatile("s_waitcnt vmcnt(0)" ::: "memory");
    __syncthreads();
    if (threadIdx.x == 0) {
        unsigned* bar = b.bar;
        __builtin_amdgcn_s_waitcnt(0);
        unsigned nloc = b.st[0], nx = b.st[1];
        if (nloc == 0u) { xcd_barrier_complete(bar, b.x, nloc, nx); b.st[0] = nloc; b.st[1] = nx; }
        const unsigned old = xb_add(&bar[XB_XSUB(b.x)], 1u);
        const unsigned gen = old / nloc;
        if (old + 1u == (gen + 1u) * nloc) {
            __builtin_amdgcn_fence(__ATOMIC_RELEASE, "agent");
            asm volatile("s_waitcnt vmcnt(0)" ::: "memory");
            const unsigned og = xb_add(&bar[XB_TOP], 1u);
            const unsigned tg = og / nx;
            if (og + 1u == (tg + 1u) * nx) xb_add(&bar[XB_TOPGEN], 1u);
            else XB_SPIN(xb_ld(&bar[XB_TOPGEN]) == tg, bar);
            __builtin_amdgcn_fence(__ATOMIC_ACQUIRE, "agent");
            xb_add(&bar[XB_XGEN(b.x)], 1u);
            asm volatile("s_waitcnt vmcnt(0)" ::: "memory");
        } else {
            XB_SPIN(xb_ld(&bar[XB_XGEN(b.x)]) == gen, bar);
            __builtin_amdgcn_fence(__ATOMIC_ACQUIRE, "agent");
            asm volatile("s_waitcnt vmcnt(0)" ::: "memory");
        }
    }
    __syncthreads();
}

#define WSB(off) ((bf16_t*)(WSP + (off)))
#define WSF(off) ((float*)(WSP + (off)))
__global__ void __launch_bounds__(NTHREADS, 2) fwd_megakernel(Args A_unused) {
    extern __shared__ __attribute__((aligned(16))) unsigned char lds_raw[];
    LAS unsigned char* lds = (LAS unsigned char*)lds_raw;
    cg::grid_group grid = cg::this_grid();
    { const int tid = threadIdx.x;
    if (tid < 24) { const unsigned long long* ka = (const unsigned long long*)__builtin_amdgcn_kernarg_segment_ptr(); *(LAS unsigned long long*)(lds + PTR_OFF + 8 * tid) = ka[tid]; } }
    if (threadIdx.x < 8) ((LAS unsigned*)(lds + PTR_OFF + 256))[threadIdx.x] = 0u;
    __syncthreads();
    if (blockIdx.x == 0) { unsigned* bw = (unsigned*)ldq(lds, 23); for (int w = threadIdx.x; w < XCD_BAR_WORDS; w += NTHREADS) __hip_atomic_store(bw + w, 0u, __ATOMIC_RELAXED, __HIP_MEMORY_SCOPE_AGENT); }
    asm volatile("s_waitcnt vmcnt(0)" ::: "memory");
    __syncthreads();
    grid.sync();
    const XcdBarrier bar = xcd_barrier_post((unsigned*)ldq(lds, 23), (volatile LAS unsigned*)(lds + PTR_OFF + 256));
#define XBAR() do { XcdBarrier b2_ = bar; asm volatile("" : "+s"(b2_.x)); xcd_barrier(b2_); } while (0)
#define FRESH_IDS const int tid = fresh_tid(), lane = tid & 63, wave = __builtin_amdgcn_readfirstlane(tid >> 6); (void)lane; (void)wave
#define GRID_ ((int)gridDim.x)
#define BID_ ((int)blockIdx.x)
#define GW_ (BID_ * NWAVES + wave)
#define NGW_ (GRID_ * NWAVES)
    constexpr size_t SSPB = (size_t)M * 16 * 4;
    using namespace pg8;

    { FRESH_IDS; prep_x(lds, GW_, NGW_, lane); }
    { FRESH_IDS; prep_weights(0, lds, GW_, NGW_, wave, lane); }
    XBAR();
    for (int l = 0; l < DEPTH; ++l) {
        { ProgA PA; PA.init(WSP, GRID_, BID_, l, lds); { FRESH_IDS; fill_rs(lds, PA, WSF(WS_SSP), tid); } gemm_stream(lds, PA); }
        XBAR();
        if (l > 0) { FRESH_IDS; prep_weights(l, lds, GW_, NGW_, wave, lane, 2); __syncthreads(); }
        { FRESH_IDS;
          for (int it0 = BID_; it0 < NBATCH * 32 * 4; it0 += GRID_) { int it = it0;
              if (GRID_ == 256) { const int r = it0 >> 8, bx = it0 & 255, xcd = bx & 7, slot = bx >> 3; it = (r * 64 + xcd * 8 + (slot >> 2)) * 4 + (slot & 3); }
              sgu_item(l, WSB(WS_P), WSB(WS_T), it, lds, tid, wave, lane); } }
        { FRESH_IDS; for (int it = GW_; it < NBATCH * 8 * 128; it += NGW_) sb_attn_item(WSB(WS_P), WSB(WS_T), it, lane); }
        { FRESH_IDS; conv_phase(l, WSB(WS_P), lds, BID_ * NTHREADS + tid, GRID_ * NTHREADS); }
        XBAR();
        { ProgC PCg; PCg.init(WSP, GRID_, BID_, lds); { FRESH_IDS; fill_rs(lds, PCg, WSF(WS_SSP), tid); } gemm_stream(lds, PCg); }
        XBAR();
        {
            StaticOrder S; S.init(M, D, GRID_, BID_);
            EpiArgs ea{}; Gemm g{WSB(WS_X2), WSB(WS_WOUT), M, D, D, D, D}; ea.xb = WSB(WS_XB); ea.sspo = WSF(WS_SSP + SSPB); Epi<E_RESID> E{ea}; gemm_phase(lds, g, S, E);
        }
        XBAR();
        {
            StaticOrder S; S.init(M, D, GRID_, BID_);
            EpiArgs ea{}; Gemm g{WSB(WS_XB), WSB(WS_WQ), M, D, D, D, D}; ea.O = WSB(WS_T); ea.ldc = D; ea.ssp = WSF(WS_SSP + SSPB); ea.cscale = 0.0625f; Epi<E_ROWSCALE> E{ea}; gemm_phase(lds, g, S, E);
            Unit u;
            for (int i = 0; S.next(i, u); ++i) { FRESH_IDS; xattn_wg(WSB(WS_T), WSB(l ? WS_MEMK1 : WS_MEMK), WSB(l ? WS_MEMVT1 : WS_MEMVT), WSB(WS_X2), (u.pm >> 4) * 64 + u.pn * 16 + (u.pm & 15), tid, wave, lane, lds); }
        }
        XBAR();
        {
            StaticOrder S; S.init(M, D, GRID_, BID_);
            EpiArgs ea{}; Gemm g{WSB(WS_X2), WSB(WS_WOX), M, D, D, D, D}; ea.xb = WSB(WS_XB); ea.sspo = WSF(WS_SSP + 2 * SSPB); Epi<E_RESID> E{ea}; gemm_phase(lds, g, S, E);
        }
        XBAR();
        { ProgJ PJ; PJ.init(WSP, GRID_, BID_, l, lds); { FRESH_IDS; fill_rs(lds, PJ, WSF(WS_SSP + 2 * SSPB), tid); } gemm_stream(lds, PJ); }
        XBAR();
        {
            StaticOrder S; S.init(M, D, GRID_, BID_);
            EpiArgs ea{}; Gemm g{WSB(WS_P), WSB(WS_WD), M, D, FF, FF, FF}; ea.xb = WSB(WS_XB); ea.sspo = WSF(WS_SSP); Epi<E_RESID> E{ea}; gemm_phase(lds, g, S, E);
        }
        if (l + 1 < DEPTH) { FRESH_IDS; prep_weights(l + 1, lds, GW_, NGW_, wave, lane, 1); }
        XBAR();
    }
    { FRESH_IDS; final_norm(lds, GW_, NGW_, lane); }
}

extern "C" void kernel_launch(void* const* d_in, const int* in_sizes, int n_in, void* d_out, int out_size, void* d_ws, size_t ws_size, hipStream_t stream) {
    static int grid = 0;
    if (grid == 0) {
        if (n_in != 22 || in_sizes[0] != M * D || out_size != M * D || ws_size < WS_END) { fprintf(stderr, "kernel_launch: unexpected shapes (n_in %d, in0 %d, out %d, ws %zu)\n", n_in, n_in > 0 ? in_sizes[0] : -1, out_size, ws_size); grid = -1; return; }
        int dev = 0, cus = 0, per_cu = 0;
        hipGetDevice(&dev); hipDeviceGetAttribute(&cus, hipDeviceAttributeMultiprocessorCount, dev);
        hipFuncSetAttribute((const void*)fwd_megakernel, hipFuncAttributeMaxDynamicSharedMemorySize, LDS_BYTES);
        hipOccupancyMaxActiveBlocksPerMultiprocessor(&per_cu, (const void*)fwd_megakernel, NTHREADS, LDS_BYTES);
        if (per_cu < 1) { fprintf(stderr, "kernel_launch: occupancy query says %d blocks per CU\n", per_cu); per_cu = 1; }
        (void)hipGetLastError();
        grid = cus;
    }
    if (grid < 0) return;
    Args a{};
    for (int i = 0; i < 22; ++i) a.in[i] = (const float*)d_in[i];
    a.out = (float*)d_out; a.ws = (unsigned char*)d_ws;
    void* args[] = {&a};
    hipError_t e = hipLaunchCooperativeKernel((const void*)fwd_megakernel, dim3(grid), dim3(NTHREADS), args, LDS_BYTES, stream);
    if (e != hipSuccess) fprintf(stderr, "cooperative launch failed: %s (grid %d)\n", hipGetErrorString(e), grid);
}
```

```cpp
#include <hip/hip_runtime.h>
#include <hip/hip_cooperative_groups.h>
#include <cstdio>
#include <cstdint>
namespace cg = cooperative_groups;

#define LAS __attribute__((address_space(3)))
typedef unsigned short bf16_t;
typedef short bf16x8 __attribute__((ext_vector_type(8)));
typedef float f32x4 __attribute__((ext_vector_type(4)));
typedef float f32x2 __attribute__((ext_vector_type(2)));
typedef float f32x16 __attribute__((ext_vector_type(16)));
typedef unsigned u32x4 __attribute__((ext_vector_type(4)));
typedef unsigned u32x2 __attribute__((ext_vector_type(2)));
typedef __bf16 bf16x2n __attribute__((ext_vector_type(2)));

#define DI __device__ __forceinline__
DI unsigned pkbf(float lo, float hi) { f32x2 v = {lo, hi}; bf16x2n b = __builtin_convertvector(v, bf16x2n); return __builtin_bit_cast(unsigned, b); }
DI float bflo(unsigned u) { return __uint_as_float(u << 16); }
DI float bfhi(unsigned u) { return __uint_as_float(u & 0xffff0000u); }
DI int fresh_tid() { int t = threadIdx.x; asm volatile("" : "+v"(t)); return t; }
#define MFMA32(a, b, c) __builtin_amdgcn_mfma_f32_32x32x16_bf16((a), (b), (c), 0, 0, 0)

constexpr int M = 16384, D = 1024, SEQ = 4096, NBATCH = 4, DEPTH = 2;
constexpr int PC = 3072;
constexpr int FF = 2816;
constexpr int INC = 7168;
constexpr float RMS_EPS = 1e-6f, LN_EPS = 1e-5f;
constexpr float LOG2E = 1.4426950408889634f, LN2 = 0.6931471805599453f;
constexpr float SB_EXIT = 110.0f;

constexpr size_t MiB = (size_t)1 << 20;
constexpr size_t WS_WIN = 1 * MiB;
constexpr size_t WS_WB = 15 * MiB;
constexpr size_t WS_WOUT = 18 * MiB, WS_WQ = 20 * MiB, WS_WK = 22 * MiB, WS_WV = 24 * MiB, WS_WOX = 26 * MiB;
constexpr size_t WS_WGU = 28 * MiB;
constexpr size_t WS_WD = 39 * MiB;
constexpr size_t WS_MB = 45 * MiB, WS_MEMK = 47 * MiB, WS_MEMVT = 49 * MiB;
constexpr size_t WS_XB = 51 * MiB;
constexpr size_t WS_P = 83 * MiB;
constexpr size_t WS_T = 179 * MiB;
constexpr size_t WS_X2 = 211 * MiB;
constexpr size_t WS_SSP = 243 * MiB;
constexpr size_t WS_WK1 = 246 * MiB, WS_WV1 = 248 * MiB, WS_MB1 = 250 * MiB, WS_MEMK1 = 252 * MiB, WS_MEMVT1 = 254 * MiB;
constexpr size_t WS_END = 256 * MiB;

namespace pg8 {
constexpr int BM = 256, BK = 64, HALF = 128, HTB = HALF * BK * 2, STAGE_BYTES = 8 * HTB, NXCD = 8, WGM = 8;
DI int lds_byte(int r, int c) { const int st = (r >> 4) * 2 + (c >> 5), rr = r & 15, cc = c & 31, ob = rr * 64 + cc * 2; return st * 1024 + (ob ^ (((ob >> 9) & 1) << 5)); }
DI void stage_rc(int b, int& R, int& C) { const int st = b / 1024, sb = b % 1024, swz = sb ^ (((sb >> 9) & 1) << 5); R = (st >> 1) * 16 + swz / 64; C = (st & 1) * 32 + (swz % 64) / 2; }
DI int perm32(int rho) { const int n = rho >> 4, i = rho & 15; return 8 * (i >> 2) + 4 * n + (i & 3); }

struct Unit { int pm, pn; };
struct Gemm { const bf16_t* A; const bf16_t* Bt; int M, N, K, lda, ldb; };

struct StaticOrder {
    int nM, nN, nwg, G, c;
    DI void init(int M_, int N_, int G_, int c_) { nM = M_ / BM; nN = N_ / BM; nwg = nM * nN; G = G_; c = c_; }
    DI bool next(int i, Unit& u) const {
        const long L = (long)i * G + c; if (L >= nwg) return false;
        int wgid = (int)L; { const int q = nwg / NXCD, r = nwg % NXCD, xcd = wgid % NXCD, off = wgid / NXCD; wgid = (xcd < r ? xcd * (q + 1) : r * (q + 1) + (xcd - r) * q) + off; }
        const int nig = WGM * nN, gid = wgid / nig, fm = gid * WGM, gsz = (nM - fm) < WGM ? (nM - fm) : WGM;
        u.pm = fm + ((wgid % nig) % gsz); u.pn = (wgid % nig) / gsz; return true;
    }
};

DI f32x2 gelu_pk(f32x2 v) {
    const f32x2 av = __builtin_elementwise_abs(v), d = av * 0.2316418882f + 1.0f;
    f32x2 t; t.x = __builtin_amdgcn_rcpf(d.x); t.y = __builtin_amdgcn_rcpf(d.y);
    f32x2 q = t * 0.5307027145f + (-0.7265760135f); q = q * t + 0.7107068705f; q = q * t + (-0.142248368f); q = q * t + 0.127414796f; q = q * t;
    const f32x2 s = (v * v) * (-0.72134752044f);
    f32x2 e; e.x = __builtin_amdgcn_exp2f(s.x); e.y = __builtin_amdgcn_exp2f(s.y);
    const f32x2 m = v * (q * e), r = v - m;
    f32x2 o; o.x = v.x < 0.f ? m.x : r.x; o.y = v.y < 0.f ? m.y : r.y; return o;
}
DI f32x4 gelu4(f32x4 v) { f32x2 a = gelu_pk((f32x2){v[0], v[1]}), b = gelu_pk((f32x2){v[2], v[3]}); return (f32x4){a.x, a.y, b.x, b.y}; }
DI float sigmoidf_(float x) { return __builtin_amdgcn_rcpf(1.0f + __builtin_amdgcn_exp2f(-x * LOG2E)); }
DI f32x4 sigmoid4(f32x4 v) { return (f32x4){sigmoidf_(v[0]), sigmoidf_(v[1]), sigmoidf_(v[2]), sigmoidf_(v[3])}; }

DI float row_rs(const float* ssp, int row, int fq) {
    const f32x4 v = *(const f32x4*)(ssp + (size_t)row * 16 + fq * 4);
    float s = (v[0] + v[1]) + (v[2] + v[3]);
    s += __shfl_xor(s, 16); s += __shfl_xor(s, 32);
    return 1.0f / sqrtf(s * (1.0f / D) + RMS_EPS);
}

DI void row_rs8(const float* ssp, int row0, int fq, float (&rs)[2][4]) {
    f32x4 v[2][4];
#pragma unroll
    for (int ai = 0; ai < 2; ++ai)
#pragma unroll
        for (int m = 0; m < 4; ++m) v[ai][m] = *(const f32x4*)(ssp + (size_t)(row0 + ai * HALF + m * 16) * 16 + fq * 4);
    asm volatile("" ::: "memory");
#pragma unroll
    for (int ai = 0; ai < 2; ++ai)
#pragma unroll
        for (int m = 0; m < 4; ++m) { float s = (v[ai][m][0] + v[ai][m][1]) + (v[ai][m][2] + v[ai][m][3]); s += __shfl_xor(s, 16); s += __shfl_xor(s, 32); rs[ai][m] = 1.0f / sqrtf(s * (1.0f / D) + RMS_EPS); }
}

DI void row_rs8_lds(const LAS float* tab, int wr, int fr, float (&rs)[2][4]) {
#pragma unroll
    for (int ai = 0; ai < 2; ++ai)
#pragma unroll
        for (int m = 0; m < 4; ++m) rs[ai][m] = tab[ai * HALF + wr * 64 + m * 16 + fr];
}

enum { E_INPROJ = 0, E_TRANS = 1, E_GATE = 2, E_BR0 = 3, E_BRN = 4, E_RESID = 5, E_ROWSCALE = 6, E_SWIGLU = 7 };
struct EpiArgs {
    bf16_t* O; int ldc;
    const float* ssp;
    float cscale;
    const float* xsrc; float* xdst; bf16_t* xb; float* sspo;
    const bf16_t* G;
    const LAS float* rstab;
};
template <int MODE> struct Epi {
    static constexpr bool PERM = true;
    EpiArgs a;
    DI void store8(bf16_t* p, f32x4 v0, f32x4 v1) const { u32x4 w; w.x = pkbf(v0[0], v0[1]); w.y = pkbf(v0[2], v0[3]); w.z = pkbf(v1[0], v1[1]); w.w = pkbf(v1[2], v1[3]); *(u32x4*)p = w; }
    DI void operator()(const f32x4 (&acc)[2][2][4][2], const Unit& u, int wr, int wc, int fr, int fq) const {
        const int row0 = u.pm * BM + wr * 64 + fr, col0 = u.pn * BM + wc * 32 + 8 * fq;
        if constexpr (MODE == E_TRANS) {
            float rsc[2][8];
            if (a.rstab) {
#pragma unroll
                for (int bj = 0; bj < 2; ++bj) { const f32x4 t0 = *(const LAS f32x4*)(a.rstab + bj * HALF + wc * 32 + 8 * fq), t1 = *(const LAS f32x4*)(a.rstab + bj * HALF + wc * 32 + 8 * fq + 4);
                    rsc[bj][0] = t0[0]; rsc[bj][1] = t0[1]; rsc[bj][2] = t0[2]; rsc[bj][3] = t0[3]; rsc[bj][4] = t1[0]; rsc[bj][5] = t1[1]; rsc[bj][6] = t1[2]; rsc[bj][7] = t1[3]; }
            } else if (a.ssp) {
                const int lane = fq * 16 + fr, tok = u.pn * BM + (lane >> 5) * HALF + wc * 32 + (lane & 31);
                const f32x4* sp = (const f32x4*)(a.ssp + (size_t)tok * 16);
                const f32x4 s0 = sp[0], s1 = sp[1], s2 = sp[2], s3 = sp[3];
                const float s = ((s0[0] + s0[1]) + (s0[2] + s0[3])) + ((s1[0] + s1[1]) + (s1[2] + s1[3])) + ((s2[0] + s2[1]) + (s2[2] + s2[3])) + ((s3[0] + s3[1]) + (s3[2] + s3[3]));
                const float rs = 1.0f / sqrtf(s * (1.0f / D) + RMS_EPS);
#pragma unroll
                for (int bj = 0; bj < 2; ++bj)
#pragma unroll
                    for (int e = 0; e < 8; ++e) rsc[bj][e] = __shfl(rs, bj * 32 + 8 * fq + e);
            } else {
#pragma unroll
                for (int bj = 0; bj < 2; ++bj)
#pragma unroll
                    for (int e = 0; e < 8; ++e) rsc[bj][e] = 1.0f;
            }
            const bool act = a.ssp != nullptr && u.pm >= 2;
#pragma unroll
            for (int ai = 0; ai < 2; ++ai)
#pragma unroll
                for (int m = 0; m < 4; ++m) { bf16_t* rowp = a.O + (size_t)(row0 + ai * HALF + m * 16) * a.ldc + col0;
#pragma unroll
                    for (int bj = 0; bj < 2; ++bj) {
                        f32x4 v0 = acc[ai][bj][m][0], v1 = acc[ai][bj][m][1];
                        v0 = v0 * (f32x4){rsc[bj][0], rsc[bj][1], rsc[bj][2], rsc[bj][3]}; v1 = v1 * (f32x4){rsc[bj][4], rsc[bj][5], rsc[bj][6], rsc[bj][7]};
                        if (act) { v0 = gelu4(v0); v1 = gelu4(v1); }
                        store8(rowp + bj * HALF, v0, v1); } }
        } else if constexpr (MODE == E_RESID) {
#pragma unroll
            for (int ai = 0; ai < 2; ++ai) {
                u32x4 xw[4][2];
#pragma unroll
                for (int m = 0; m < 4; ++m)
#pragma unroll
                    for (int bj = 0; bj < 2; ++bj) xw[m][bj] = *(const u32x4*)(a.xb + (size_t)(row0 + ai * HALF + m * 16) * D + col0 + bj * HALF);
                asm volatile("" ::: "memory");
#pragma unroll
                for (int m = 0; m < 4; ++m) { const int row = row0 + ai * HALF + m * 16; const size_t off = (size_t)row * D + col0; float ss = 0.f;
#pragma unroll
                    for (int bj = 0; bj < 2; ++bj) { const u32x4 w = xw[m][bj];
                        const f32x4 v0 = (f32x4){bflo(w.x), bfhi(w.x), bflo(w.y), bfhi(w.y)} + acc[ai][bj][m][0], v1 = (f32x4){bflo(w.z), bfhi(w.z), bflo(w.w), bfhi(w.w)} + acc[ai][bj][m][1];
                        store8(a.xb + off + bj * HALF, v0, v1);
                        ss += (v0[0] * v0[0] + v0[1] * v0[1]) + (v0[2] * v0[2] + v0[3] * v0[3]) + (v1[0] * v1[0] + v1[1] * v1[1]) + (v1[2] * v1[2] + v1[3] * v1[3]); }
                    ss += __shfl_xor(ss, 16); ss += __shfl_xor(ss, 32);
                    if (fq == 0) a.sspo[(size_t)row * 16 + u.pn * 4 + wc] = ss; }
            }
        } else if constexpr (MODE == E_SWIGLU) {
            const int ocol = u.pn * HALF + wc * 32 + 8 * fq;
            float rs8[2][4]; if (a.rstab) row_rs8_lds(a.rstab, wr, fr, rs8); else row_rs8(a.ssp, row0, fq, rs8);
#pragma unroll
            for (int ai = 0; ai < 2; ++ai)
#pragma unroll
                for (int m = 0; m < 4; ++m) { const int row = row0 + ai * HALF + m * 16; const float rs = rs8[ai][m];
                    const f32x4 g0 = acc[ai][0][m][0] * rs, g1 = acc[ai][0][m][1] * rs, u0 = acc[ai][1][m][0] * rs, u1 = acc[ai][1][m][1] * rs;
                    store8(a.O + (size_t)row * a.ldc + ocol, g0 * sigmoid4(g0) * u0, g1 * sigmoid4(g1) * u1); }
        } else {
            float sc = a.cscale; bool gelu = false;
            if constexpr (MODE == E_INPROJ) { sc = (u.pn < 2) ? 0.125f : 1.0f; gelu = (u.pn == 4 || u.pn == 5); }
            if constexpr (MODE == E_INPROJ || MODE == E_GATE || MODE == E_ROWSCALE) {
                float rs8[2][4];
                if (a.rstab) row_rs8_lds(a.rstab, wr, fr, rs8); else if (a.ssp) row_rs8(a.ssp, row0, fq, rs8); else {
#pragma unroll
                    for (int ai = 0; ai < 2; ++ai)
#pragma unroll
                        for (int m = 0; m < 4; ++m) rs8[ai][m] = 1.0f; }
#pragma unroll
                for (int ai = 0; ai < 2; ++ai)
#pragma unroll
                    for (int m = 0; m < 4; ++m) { const int row = row0 + ai * HALF + m * 16; const float rs = sc * rs8[ai][m];
#pragma unroll
                        for (int bj = 0; bj < 2; ++bj) { const size_t off = (size_t)row * a.ldc + col0 + bj * HALF;
                            f32x4 v0 = acc[ai][bj][m][0] * rs, v1 = acc[ai][bj][m][1] * rs;
                            if constexpr (MODE == E_INPROJ) { if (gelu) { v0 = gelu4(v0); v1 = gelu4(v1); } }
                            else if constexpr (MODE == E_GATE) { v0 = sigmoid4(v0); v1 = sigmoid4(v1); }
                            store8(a.O + off, v0, v1); } }
            } else {
#pragma unroll
                for (int ai = 0; ai < 2; ++ai) {
                    u32x4 gw[4][2], pw[4][2];
#pragma unroll
                    for (int m = 0; m < 4; ++m)
#pragma unroll
                        for (int bj = 0; bj < 2; ++bj) { const size_t off = (size_t)(row0 + ai * HALF + m * 16) * a.ldc + col0 + bj * HALF;
                            gw[m][bj] = *(const u32x4*)(a.G + off); if constexpr (MODE == E_BRN) pw[m][bj] = *(const u32x4*)(a.O + off); }
                    asm volatile("" ::: "memory");
#pragma unroll
                    for (int m = 0; m < 4; ++m)
#pragma unroll
                        for (int bj = 0; bj < 2; ++bj) { const size_t off = (size_t)(row0 + ai * HALF + m * 16) * a.ldc + col0 + bj * HALF; const u32x4 g = gw[m][bj];
                            f32x4 v0 = acc[ai][bj][m][0] * (f32x4){bflo(g.x), bfhi(g.x), bflo(g.y), bfhi(g.y)}, v1 = acc[ai][bj][m][1] * (f32x4){bflo(g.z), bfhi(g.z), bflo(g.w), bfhi(g.w)};
                            if constexpr (MODE == E_BRN) { const u32x4 q = pw[m][bj];
                                v0 = v0 + (f32x4){bflo(q.x), bfhi(q.x), bflo(q.y), bfhi(q.y)}; v1 = v1 + (f32x4){bflo(q.z), bfhi(q.z), bflo(q.w), bfhi(q.w)}; }
                            store8(a.O + off, v0, v1); }
                }
            }
        }
    }
};

template <class EpiT>
DI void gemm_phase(LAS unsigned char* lds, const Gemm g, const StaticOrder& S, const EpiT& E) {
    const int tid = fresh_tid(), wid = __builtin_amdgcn_readfirstlane(tid >> 6), lane = tid & 63, wr = wid >> 2, wc = wid & 3, fr = lane & 15, fq = lane >> 4;
    const int nt = g.K / BK;
    unsigned voffA[2], voffB[2];
#pragma unroll
    for (int i = 0; i < 2; ++i) { int R, C; stage_rc(tid * 16 + i * 8192, R, C); const int Rb = EpiT::PERM ? ((R & ~31) + perm32(R & 31)) : R;
        voffA[i] = (unsigned)(R * g.lda + C) * 2u; voffB[i] = (unsigned)(Rb * g.ldb + C) * 2u; }
    const size_t kstep = (size_t)(BK * 2);
    const size_t hstepA = (size_t)HALF * g.lda * 2, hstepB = (size_t)HALF * g.ldb * 2;
    const size_t tstepA = 2 * hstepA, tstepB = 2 * hstepB;
    const unsigned ldsw = (unsigned)wid * 1024u;
    const int aoff = lds_byte(wr * 64 + fr, fq * 8), boff = lds_byte(wc * 32 + fr, fq * 8);
#define PG8_SA(b, h) (((b) * 2 + (h)) * HTB)
#define PG8_SB(b, h) ((4 + (b) * 2 + (h)) * HTB)
#define PG8_STAGE(bufoff, gbase, voff) do { _Pragma("unroll") for (int _i = 0; _i < 2; ++_i) \
        __builtin_amdgcn_global_load_lds((const unsigned*)((const char*)(gbase) + (voff)[_i]), (LAS unsigned*)(lds + (bufoff) + ldsw + _i * 8192), 16, 0, 0); } while (0)
#define PG8_LDA(dst, b, h) do { _Pragma("unroll") for (int m = 0; m < 4; ++m) _Pragma("unroll") for (int k = 0; k < 2; ++k) dst[m][k] = *(const LAS bf16x8*)(lds + PG8_SA(b, h) + aoff + m * 2048 + k * 1024); } while (0)
#define PG8_LDB(dst, b, h) do { _Pragma("unroll") for (int n = 0; n < 2; ++n) _Pragma("unroll") for (int k = 0; k < 2; ++k) dst[n][k] = *(const LAS bf16x8*)(lds + PG8_SB(b, h) + boff + n * 2048 + k * 1024); } while (0)
#define PG8_MMA(ai, bj, At, Bt) do { __builtin_amdgcn_s_setprio(1); _Pragma("unroll") for (int m = 0; m < 4; ++m) _Pragma("unroll") for (int n = 0; n < 2; ++n) _Pragma("unroll") for (int k = 0; k < 2; ++k) \
        acc[ai][bj][m][n] = __builtin_amdgcn_mfma_f32_16x16x32_bf16(Bt[n][k], At[m][k], acc[ai][bj][m][n], 0, 0, 0); __builtin_amdgcn_s_setprio(0); } while (0)
#define PG8_WAIT_V(n) asm volatile("s_waitcnt vmcnt(" #n ")" ::: "memory")
#define PG8_WAIT_L(n) asm volatile("s_waitcnt lgkmcnt(" #n ")" ::: "memory")
#define PG8_BAR __builtin_amdgcn_s_barrier()
#define PG8_SCHED __builtin_amdgcn_sched_barrier(0)
    Unit cur, nxt; int ui = 0;
    if (!S.next(0, cur)) return;
    f32x4 acc[2][2][4][2];
#pragma unroll
    for (int a = 0; a < 2; ++a)
#pragma unroll
        for (int b = 0; b < 2; ++b)
#pragma unroll
            for (int m = 0; m < 4; ++m)
#pragma unroll
                for (int n = 0; n < 2; ++n) acc[a][b][m][n] = (f32x4){0.f, 0.f, 0.f, 0.f};
    bf16x8 At[4][2], B0[2][2], B1[2][2];
    const char* cA = (const char*)g.A + (size_t)cur.pm * tstepA; const char* cB = (const char*)g.Bt + (size_t)cur.pn * tstepB;
    PG8_STAGE(PG8_SB(0, 0), cB, voffB); PG8_STAGE(PG8_SB(0, 1), cB + hstepB, voffB); PG8_STAGE(PG8_SA(0, 0), cA, voffA); PG8_STAGE(PG8_SA(0, 1), cA + hstepA, voffA);
    if (wr == 1) PG8_BAR;
    PG8_WAIT_V(2); PG8_BAR;
    PG8_STAGE(PG8_SB(1, 0), cB + kstep, voffB); PG8_STAGE(PG8_SA(1, 0), cA + kstep, voffA); PG8_STAGE(PG8_SB(1, 1), cB + hstepB + kstep, voffB);
    PG8_WAIT_V(6); PG8_BAR;
    for (;;) {
        const bool has_next = S.next(ui + 1, nxt);
        const char* nA = has_next ? (const char*)g.A + (size_t)nxt.pm * tstepA : cA; const char* nB = has_next ? (const char*)g.Bt + (size_t)nxt.pn * tstepB : cB;
        for (int t = 0; t < nt; t += 2) {
            const bool last = (t == nt - 2);
            const char* a1 = cA + (size_t)(t + 1) * kstep;
            const char* a2 = last ? nA : cA + (size_t)(t + 2) * kstep; const char* b2 = last ? nB : cB + (size_t)(t + 2) * kstep;
            const char* a3 = a2 + kstep; const char* b3 = b2 + kstep;
            PG8_LDB(B0, 0, 0); PG8_LDB(B1, 0, 1); PG8_SCHED; PG8_LDA(At, 0, 0); PG8_STAGE(PG8_SA(1, 1), a1 + hstepA, voffA);
            PG8_WAIT_V(8); PG8_WAIT_L(0); PG8_BAR; PG8_MMA(0, 0, At, B0); PG8_MMA(0, 1, At, B1); PG8_BAR; PG8_SCHED;
            PG8_LDA(At, 0, 1); PG8_STAGE(PG8_SB(0, 0), b2, voffB); PG8_STAGE(PG8_SB(0, 1), b2 + hstepB, voffB); PG8_STAGE(PG8_SA(0, 0), a2, voffA);
            PG8_WAIT_V(8); PG8_WAIT_L(0); PG8_BAR; PG8_MMA(1, 0, At, B0); PG8_MMA(1, 1, At, B1); PG8_BAR; PG8_SCHED;
            PG8_LDB(B0, 1, 0); PG8_LDB(B1, 1, 1); PG8_SCHED; PG8_LDA(At, 1, 0); PG8_STAGE(PG8_SA(0, 1), a2 + hstepA, voffA);
            PG8_WAIT_V(8); PG8_WAIT_L(0); PG8_BAR; PG8_MMA(0, 0, At, B0); PG8_MMA(0, 1, At, B1); PG8_BAR; PG8_SCHED;
            PG8_LDA(At, 1, 1); PG8_STAGE(PG8_SB(1, 0), b3, voffB); PG8_STAGE(PG8_SB(1, 1), b3 + hstepB, voffB); PG8_STAGE(PG8_SA(1, 0), a3, voffA);
            PG8_WAIT_V(8); PG8_WAIT_L(0); PG8_BAR; PG8_MMA(1, 0, At, B0); PG8_MMA(1, 1, At, B1); PG8_BAR; PG8_SCHED;
        }
        if (wr == 0) PG8_BAR;
        E(acc, cur, wr, wc, fr, fq);
        if (!has_next) break;
#pragma unroll
        for (int a = 0; a < 2; ++a)
#pragma unroll
            for (int b = 0; b < 2; ++b)
#pragma unroll
                for (int m = 0; m < 4; ++m)
#pragma unroll
                    for (int n = 0; n < 2; ++n) acc[a][b][m][n] = (f32x4){0.f, 0.f, 0.f, 0.f};
        cur = nxt; cA = nA; cB = nB; ++ui;
        if (wr == 1) PG8_BAR;
    }
    PG8_WAIT_V(0);
    PG8_BAR;

}

struct UnitX { int pm, pn, job, k; };
struct JobP { const bf16_t* A; const bf16_t* Bt; int lda, ldb, nt; };
template <class Prog>
DI void gemm_stream(LAS unsigned char* lds, Prog& P) {
    const int tid = fresh_tid(), wid = __builtin_amdgcn_readfirstlane(tid >> 6), lane = tid & 63, wr = wid >> 2, wc = wid & 3, fr = lane & 15, fq = lane >> 4;
    const size_t kstep = (size_t)(BK * 2);
    const unsigned ldsw = (unsigned)wid * 1024u;
    const int aoff = lds_byte(wr * 64 + fr, fq * 8), boff = lds_byte(wc * 32 + fr, fq * 8);
#define PG8_VOFF(vA, vB, j) do { _Pragma("unroll") for (int _i = 0; _i < 2; ++_i) { int sR_, sC_; stage_rc(tid * 16 + _i * 8192, sR_, sC_); const int sRb_ = (sR_ & ~31) + perm32(sR_ & 31); \
        vA[_i] = (unsigned)(sR_ * (j).lda + sC_) * 2u; vB[_i] = (unsigned)(sRb_ * (j).ldb + sC_) * 2u; } } while (0)
    UnitX cur, nxt;
    if (!P.next(cur)) return;
    JobP jc = P.job(cur.job);
    unsigned voffA[2], voffB[2], voffAn[2], voffBn[2];
    PG8_VOFF(voffA, voffB, jc);
    unsigned hstepA = (unsigned)(HALF * jc.lda * 2), hstepB = (unsigned)(HALF * jc.ldb * 2), hstepAn, hstepBn;
    int nt = jc.nt;
    f32x4 acc[2][2][4][2];
#pragma unroll
    for (int a = 0; a < 2; ++a)
#pragma unroll
        for (int b = 0; b < 2; ++b)
#pragma unroll
            for (int m = 0; m < 4; ++m)
#pragma unroll
                for (int n = 0; n < 2; ++n) acc[a][b][m][n] = (f32x4){0.f, 0.f, 0.f, 0.f};
    bf16x8 At[4][2], B0[2][2], B1[2][2];
    const char* cA = (const char*)jc.A + (size_t)cur.pm * 2 * hstepA; const char* cB = (const char*)jc.Bt + (size_t)cur.pn * 2 * hstepB;
    PG8_STAGE(PG8_SB(0, 0), cB, voffB); PG8_STAGE(PG8_SB(0, 1), cB + hstepB, voffB); PG8_STAGE(PG8_SA(0, 0), cA, voffA); PG8_STAGE(PG8_SA(0, 1), cA + hstepA, voffA);
    if (wr == 1) PG8_BAR;
    PG8_WAIT_V(2); PG8_BAR;
    PG8_STAGE(PG8_SB(1, 0), cB + kstep, voffB); PG8_STAGE(PG8_SA(1, 0), cA + kstep, voffA); PG8_STAGE(PG8_SB(1, 1), cB + hstepB + kstep, voffB);
    PG8_WAIT_V(6); PG8_BAR;
    for (;;) {
        const bool has_next = P.next(nxt);
        const char* nA = cA; const char* nB = cB; int ntn = nt;
        hstepAn = hstepA; hstepBn = hstepB; voffAn[0] = voffA[0]; voffAn[1] = voffA[1]; voffBn[0] = voffB[0]; voffBn[1] = voffB[1];
        if (has_next) { const JobP jn = P.job(nxt.job); PG8_VOFF(voffAn, voffBn, jn); hstepAn = (unsigned)(HALF * jn.lda * 2); hstepBn = (unsigned)(HALF * jn.ldb * 2); ntn = jn.nt;
            nA = (const char*)jn.A + (size_t)nxt.pm * 2 * hstepAn; nB = (const char*)jn.Bt + (size_t)nxt.pn * 2 * hstepBn; }
        for (int t = 0; t < nt; t += 2) {
            const bool last = (t == nt - 2);
            const char* a1 = cA + (size_t)(t + 1) * kstep;
            const char* a2 = last ? nA : cA + (size_t)(t + 2) * kstep; const char* b2 = last ? nB : cB + (size_t)(t + 2) * kstep;
            const char* a3 = a2 + kstep; const char* b3 = b2 + kstep;
            const unsigned hA2 = last ? hstepAn : hstepA, hB2 = last ? hstepBn : hstepB;
            unsigned vA2[2], vB2[2];
            vA2[0] = last ? voffAn[0] : voffA[0]; vA2[1] = last ? voffAn[1] : voffA[1]; vB2[0] = last ? voffBn[0] : voffB[0]; vB2[1] = last ? voffBn[1] : voffB[1];
            PG8_LDB(B0, 0, 0); PG8_LDB(B1, 0, 1); PG8_SCHED; PG8_LDA(At, 0, 0); PG8_STAGE(PG8_SA(1, 1), a1 + hstepA, voffA);
            PG8_WAIT_V(8); PG8_WAIT_L(0); PG8_BAR; PG8_MMA(0, 0, At, B0); PG8_MMA(0, 1, At, B1); PG8_BAR; PG8_SCHED;
            PG8_LDA(At, 0, 1); PG8_STAGE(PG8_SB(0, 0), b2, vB2); PG8_STAGE(PG8_SB(0, 1), b2 + hB2, vB2); PG8_STAGE(PG8_SA(0, 0), a2, vA2);
            PG8_WAIT_V(8); PG8_WAIT_L(0); PG8_BAR; PG8_MMA(1, 0, At, B0); PG8_MMA(1, 1, At, B1); PG8_BAR; PG8_SCHED;
            PG8_LDB(B0, 1, 0); PG8_LDB(B1, 1, 1); PG8_SCHED; PG8_LDA(At, 1, 0); PG8_STAGE(PG8_SA(0, 1), a2 + hA2, vA2);
            PG8_WAIT_V(8); PG8_WAIT_L(0); PG8_BAR; PG8_MMA(0, 0, At, B0); PG8_MMA(0, 1, At, B1); PG8_BAR; PG8_SCHED;
            PG8_LDA(At, 1, 1); PG8_STAGE(PG8_SB(1, 0), b3, vB2); PG8_STAGE(PG8_SB(1, 1), b3 + hB2, vB2); PG8_STAGE(PG8_SA(1, 0), a3, vA2);
            PG8_WAIT_V(8); PG8_WAIT_L(0); PG8_BAR; PG8_MMA(1, 0, At, B0); PG8_MMA(1, 1, At, B1); PG8_BAR; PG8_SCHED;
        }
        if (wr == 0) PG8_BAR;
        P.epilogue(acc, cur, wr, wc, fr, fq);
        if (!has_next) break;
#pragma unroll
        for (int a = 0; a < 2; ++a)
#pragma unroll
            for (int b = 0; b < 2; ++b)
#pragma unroll
                for (int m = 0; m < 4; ++m)
#pragma unroll
                    for (int n = 0; n < 2; ++n) acc[a][b][m][n] = (f32x4){0.f, 0.f, 0.f, 0.f};
        cur = nxt; cA = nA; cB = nB; nt = ntn; hstepA = hstepAn; hstepB = hstepBn; voffA[0] = voffAn[0]; voffA[1] = voffAn[1]; voffB[0] = voffBn[0]; voffB[1] = voffBn[1];
        if (wr == 1) PG8_BAR;
    }
    PG8_WAIT_V(0);
    PG8_BAR;
#undef PG8_VOFF
}
#undef PG8_SA
#undef PG8_SB
#undef PG8_STAGE
#undef PG8_LDA
#undef PG8_LDB
#undef PG8_MMA
#undef PG8_WAIT_V
#undef PG8_WAIT_L
#undef PG8_BAR
#undef PG8_SCHED
}

constexpr int NWAVES = 8, NTHREADS = 512;
constexpr int LDS_BYTES = 147456;

DI float wave_sum(float v) {
#pragma unroll
    for (int o = 1; o < 64; o <<= 1) v += __shfl_xor(v, o);
    return v;
}

DI void transpose_item(const float* W, int K, int N, const float* gk, bf16_t* WT, int dst_row0, int k0, int n0, LAS float* scr, int lane) {
    f32x4 wv[8]; float gv[8];
#pragma unroll
    for (int i = 0; i < 8; ++i) { const int kk = 8 * i + (lane >> 3), nq = (lane & 7) * 4; wv[i] = *(const f32x4*)(W + (size_t)(k0 + kk) * N + n0 + nq); gv[i] = gk ? gk[k0 + kk] : 1.0f; }
    asm volatile("" ::: "memory");
#pragma unroll
    for (int i = 0; i < 8; ++i) { const int kk = 8 * i + (lane >> 3), nq = (lane & 7) * 4; const f32x4 w = wv[i] * gv[i];
        LAS float* d = scr + kk * 33 + nq; d[0] = w[0]; d[1] = w[1]; d[2] = w[2]; d[3] = w[3]; }
    asm volatile("s_waitcnt lgkmcnt(0)" ::: "memory");
    const int c = lane & 7;
#pragma unroll
    for (int j = 0; j < 4; ++j) { const int n = (lane >> 3) + 8 * j; const LAS float* s = scr + (8 * c) * 33 + n;
        u32x4 o; o.x = pkbf(s[0 * 33], s[1 * 33]); o.y = pkbf(s[2 * 33], s[3 * 33]); o.z = pkbf(s[4 * 33], s[5 * 33]); o.w = pkbf(s[6 * 33], s[7 * 33]);
        *(u32x4*)(WT + (size_t)(dst_row0 + n) * K + k0 + 8 * c) = o; }
    asm volatile("s_waitcnt lgkmcnt(0)" ::: "memory");
}

struct Args { const float* in[22]; float* out; unsigned char* ws; };
constexpr int PTR_OFF = 131072;
DI unsigned long long ldq(LAS unsigned char* lds, int i) {
    unsigned off = (unsigned)(PTR_OFF + 8 * i); asm volatile("" : "+v"(off));
    const unsigned long long v = *(const LAS unsigned long long*)(lds + off);
    const unsigned lo = __builtin_amdgcn_readfirstlane((unsigned)v), hi = __builtin_amdgcn_readfirstlane((unsigned)(v >> 32));
    return ((unsigned long long)hi << 32) | lo;
}
#define GAS __attribute__((address_space(1)))
#define INP(i) ((const float*)(const GAS float*)ldq(lds, (i)))
#define OUTP ((float*)(GAS float*)ldq(lds, 22))
#define WSP ((unsigned char*)(GAS unsigned char*)ldq(lds, 23))

DI void prep_weights(int l, LAS unsigned char* lds, int gw, int NGW, int wave, int lane, int part = 0) {
    LAS float* scr = (LAS float*)(lds + wave * 16384);
    unsigned char* ws = WSP;
    constexpr int I_IN = 16 * 224, I_BR = 8 * 32, I_SQ = 16 * 32, I_GU = 16 * 88, I_DN = 44 * 32;
    constexpr int NSQ = 7; constexpr int NITEMS = I_IN + 3 * I_BR + NSQ * I_SQ + 2 * I_GU + I_DN;
    const int it_lo = part == 2 ? NITEMS - I_DN : 0, it_hi = part == 1 ? NITEMS - I_DN : NITEMS;
    for (int it = it_lo + gw; it < it_hi; it += NGW) {
        int r = it;
        if (r < I_IN) { const int kb = r / 224, nb = r % 224, n0 = nb * 32, seg = n0 >> 9;
            int base;
            switch (seg) { case 0: base = 0; break; case 1: base = 512; break; case 2: base = 3072; break; case 3: base = 1024; break; case 4: base = 3584; break;
                           case 5: base = 1536; break; case 6: base = 2048; break; case 7: base = 2560; break; default: base = seg * 512; break; }
            transpose_item(INP(3) + (size_t)l * D * INC, D, INC, INP(2) + l * D, (bf16_t*)(ws + WS_WIN), base + (n0 & 511), kb * 64, n0, scr, lane); continue; }
        r -= I_IN;
        if (r < 3 * I_BR) { const int n = r / I_BR, q = r % I_BR, kb = q / 32, nb = q % 32;
            transpose_item(INP(9) + ((size_t)l * 3 + n) * 512 * D, 512, D, nullptr, (bf16_t*)(ws + WS_WB) + (size_t)n * D * 512, nb * 32, kb * 64, nb * 32, scr, lane); continue; }
        r -= 3 * I_BR;
        if (r < NSQ * I_SQ) { const int w = r / I_SQ, q = r % I_SQ, kb = q / 32, nb = q % 32;
            const float* src; const float* gk = nullptr; size_t dst;
            if (l == 0 && w >= 5) {
                transpose_item(INP(w == 5 ? 14 : 15) + (size_t)D * D, D, D, nullptr, (bf16_t*)(ws + (w == 5 ? WS_WK1 : WS_WV1)), nb * 32, kb * 64, nb * 32, scr, lane); continue; }
            if (w >= 5 || (l == 1 && (w == 2 || w == 3))) continue;
            switch (w) { case 0: src = INP(10); dst = WS_WOUT; break; case 1: src = INP(13); dst = WS_WQ; gk = INP(11) + l * D; break; case 2: src = INP(14); dst = WS_WK; break;
                         case 3: src = INP(15); dst = WS_WV; break; default: src = INP(16); dst = WS_WOX; break; }
            transpose_item(src + (size_t)l * D * D, D, D, gk, (bf16_t*)(ws + dst), nb * 32, kb * 64, nb * 32, scr, lane); continue; }
        r -= NSQ * I_SQ;
        if (r < 2 * I_GU) { const int w = r / I_GU, q = r % I_GU, kb = q / 88, nb = q % 88, n0 = nb * 32;
            transpose_item(INP(18 + w) + (size_t)l * D * FF, D, FF, INP(17) + l * D, (bf16_t*)(ws + WS_WGU), (n0 >> 7) * 256 + w * 128 + (n0 & 127), kb * 64, n0, scr, lane); continue; }
        r -= 2 * I_GU;
        { const int kb = r / 32, nb = r % 32;
          transpose_item(INP(20) + (size_t)l * FF * D, FF, D, nullptr, (bf16_t*)(ws + WS_WD), nb * 32, kb * 64, nb * 32, scr, lane); }
    }
    if (l == 0) {
        for (int row2 = gw; row2 < 2 * NBATCH * 256; row2 += NGW) {
            const int lay = row2 >> 10, row = row2 & 1023; const float* mg = INP(12) + lay * D;
            const f32x4* xr = (const f32x4*)(INP(1) + (size_t)row * D) + lane; f32x4 v[4]; float s = 0.f;
#pragma unroll
            for (int j = 0; j < 4; ++j) { v[j] = xr[64 * j]; s += (v[j][0] * v[j][0] + v[j][1] * v[j][1]) + (v[j][2] * v[j][2] + v[j][3] * v[j][3]); }
            const float rs = 1.0f / sqrtf(wave_sum(s) * (1.0f / D) + RMS_EPS);
            u32x2* o = (u32x2*)((bf16_t*)(ws + (lay ? WS_MB1 : WS_MB)) + (size_t)row * D) + lane;
#pragma unroll
            for (int j = 0; j < 4; ++j) { const f32x4 gv = *((const f32x4*)mg + lane + 64 * j); u32x2 w; w.x = pkbf(v[j][0] * rs * gv[0], v[j][1] * rs * gv[1]); w.y = pkbf(v[j][2] * rs * gv[2], v[j][3] * rs * gv[3]); o[64 * j] = w; }
        }
    }
}

DI void prep_x(LAS unsigned char* lds, int gw, int NGW, int lane) {
    unsigned char* ws = WSP; const float* xin = INP(0);
    float* ssp = (float*)(ws + WS_SSP);
    constexpr int NR = 4;
    for (int row0 = gw; row0 < M; row0 += NR * NGW) {
        f32x4 v[NR][4];
#pragma unroll
        for (int r = 0; r < NR; ++r) { const int row = row0 + r * NGW < M ? row0 + r * NGW : row0; const f32x4* xr = (const f32x4*)(xin + (size_t)row * D) + lane;
#pragma unroll
            for (int j = 0; j < 4; ++j) v[r][j] = xr[64 * j]; }
        asm volatile("" ::: "memory");
#pragma unroll
        for (int r = 0; r < NR; ++r) { const int row = row0 + r * NGW; if (row < M) { float s = 0.f;
#pragma unroll
            for (int j = 0; j < 4; ++j) s += (v[r][j][0] * v[r][j][0] + v[r][j][1] * v[r][j][1]) + (v[r][j][2] * v[r][j][2] + v[r][j][3] * v[r][j][3]);
            s = wave_sum(s);
            u32x2* o = (u32x2*)((bf16_t*)(ws + WS_XB) + (size_t)row * D) + lane;
#pragma unroll
            for (int j = 0; j < 4; ++j) { u32x2 w; w.x = pkbf(v[r][j][0], v[r][j][1]); w.y = pkbf(v[r][j][2], v[r][j][3]); o[64 * j] = w; }
            if (lane < 16) ssp[(size_t)row * 16 + lane] = lane == 0 ? s : 0.f; } }
    }
}

DI void final_norm(LAS unsigned char* lds, int gw, int NGW, int lane) {
    const float* fg = INP(21); float* outp = OUTP; const float* ssp = (const float*)(WSP + WS_SSP); const bf16_t* xb = (const bf16_t*)(WSP + WS_XB);
    f32x4 gv[4];
#pragma unroll
    for (int j = 0; j < 4; ++j) gv[j] = *((const f32x4*)fg + lane + 64 * j);
    constexpr int NR = 4;
    for (int row0 = gw; row0 < M; row0 += NR * NGW) {
        u32x2 w[NR][4]; float sp[NR];
#pragma unroll
        for (int r = 0; r < NR; ++r) { const int row = row0 + r * NGW < M ? row0 + r * NGW : row0; const u32x2* xbr = (const u32x2*)(xb + (size_t)row * D) + lane;
            sp[r] = lane < 16 ? ssp[(size_t)row * 16 + lane] : 0.f;
#pragma unroll
            for (int j = 0; j < 4; ++j) w[r][j] = xbr[64 * j]; }
        asm volatile("" ::: "memory");
#pragma unroll
        for (int r = 0; r < NR; ++r) { const int row = row0 + r * NGW; if (row < M) {
            const float rs = 1.0f / sqrtf(wave_sum(sp[r]) * (1.0f / D) + RMS_EPS);
            f32x4* xr = (f32x4*)(outp + (size_t)row * D) + lane;
#pragma unroll
            for (int j = 0; j < 4; ++j) xr[64 * j] = (f32x4){bflo(w[r][j].x), bfhi(w[r][j].x), bflo(w[r][j].y), bfhi(w[r][j].y)} * rs * gv[j]; } }
    }
}

DI void sb_attn_item(bf16_t* p, const bf16_t* T, int item, int lane) {
    const int b = item >> 10, h = (item >> 7) & 7, qb = item & 127;
    const int hl = lane >> 5, li = lane & 31;
    const size_t rowbase = (size_t)b * SEQ;
    const int kperm = (li & 16) | ((li & 4) << 1) | ((li & 8) >> 1) | (li & 3);
    const bf16_t* qrow = p + (rowbase + qb * 32 + li) * PC + h * 64 + 8 * hl;
    bf16x8 qf[4];
#pragma unroll
    for (int kk = 0; kk < 4; ++kk) qf[kk] = *(const bf16x8*)(qrow + 16 * kk);
    bf16x8 U[2];
#pragma unroll
    for (int c = 0; c < 2; ++c)
#pragma unroll
        for (int e = 0; e < 8; ++e) U[c][e] = (16 * c + 8 * hl + e >= kperm) ? (short)0x3f80 : (short)0;
    f32x16 o0, o1;
#pragma unroll
    for (int r = 0; r < 16; ++r) { o0[r] = 0.f; o1[r] = 0.f; }
    float carry = 0.f;
    const bf16_t* vt0 = T + (size_t)(h * 64 + li) * M + rowbase + 8 * hl;
    for (int kb = qb; kb >= 0; --kb) {
        const int s0 = kb * 32;
        const bf16_t* krow = p + (rowbase + s0 + kperm) * PC + 512 + h * 64 + 8 * hl;
        bf16x8 kf[4], vf[4];
#pragma unroll
        for (int kk = 0; kk < 4; ++kk) kf[kk] = *(const bf16x8*)(krow + 16 * kk);
#pragma unroll
        for (int c = 0; c < 2; ++c) { vf[c] = *(const bf16x8*)(vt0 + s0 + 16 * c); vf[2 + c] = *(const bf16x8*)(vt0 + (size_t)32 * M + s0 + 16 * c); }
        f32x16 z;
#pragma unroll
        for (int r = 0; r < 16; ++r) z[r] = 0.f;
#pragma unroll
        for (int kk = 0; kk < 4; ++kk) z = MFMA32(kf[kk], qf[kk], z);
        const bool diag = (kb == qb);
        float Lv[16];
#pragma unroll
        for (int r = 0; r < 16; ++r) {
            const float zz = z[r];
            float L = fmaxf(zz, 0.f) + LN2 * __builtin_amdgcn_logf(1.0f + __builtin_amdgcn_exp2f(-fabsf(zz) * LOG2E));
            if (diag && !(16 * (r >> 3) + 8 * hl + (r & 7) < li)) L = 0.f;
            Lv[r] = L;
        }
        bf16x8 Lh[2], Ll[2];
#pragma unroll
        for (int c = 0; c < 2; ++c) { u32x4 wh, wl;
#pragma unroll
            for (int e = 0; e < 4; ++e) { const float a0 = Lv[8 * c + 2 * e], a1 = Lv[8 * c + 2 * e + 1]; const unsigned hp = pkbf(a0, a1); wh[e] = hp; wl[e] = pkbf(a0 - bflo(hp), a1 - bfhi(hp)); }
            Lh[c] = __builtin_bit_cast(bf16x8, wh); Ll[c] = __builtin_bit_cast(bf16x8, wl); }
        f32x16 C;
#pragma unroll
        for (int r = 0; r < 16; ++r) C[r] = carry;
        C = MFMA32(U[0], Lh[0], C); C = MFMA32(U[1], Lh[1], C); C = MFMA32(U[0], Ll[0], C); C = MFMA32(U[1], Ll[1], C);
        bf16x8 pf[2];
#pragma unroll
        for (int c = 0; c < 2; ++c) { u32x4 w;
#pragma unroll
            for (int e = 0; e < 4; ++e) { float a0, a1; { const int r = 8 * c + 2 * e; a0 = __builtin_amdgcn_exp2f((z[r] - C[r]) * LOG2E); a1 = __builtin_amdgcn_exp2f((z[r + 1] - C[r + 1]) * LOG2E);
                    if (diag) { if (!(16 * c + 8 * hl + 2 * e < li)) a0 = 0.f; if (!(16 * c + 8 * hl + 2 * e + 1 < li)) a1 = 0.f; } }
                w[e] = pkbf(a0, a1); }
            pf[c] = __builtin_bit_cast(bf16x8, w); }
        carry = __shfl(C[0], li);
        o0 = MFMA32(vf[0], pf[0], o0); o0 = MFMA32(vf[1], pf[1], o0);
        o1 = MFMA32(vf[2], pf[0], o1); o1 = MFMA32(vf[3], pf[1], o1);
        if (__all(carry > SB_EXIT)) break;
    }
    bf16_t* orow = p + (rowbase + qb * 32 + li) * PC + h * 64 + 4 * hl;
#pragma unroll
    for (int g = 0; g < 4; ++g) {
        u32x2 w0, w1; w0.x = pkbf(o0[4 * g], o0[4 * g + 1]); w0.y = pkbf(o0[4 * g + 2], o0[4 * g + 3]); w1.x = pkbf(o1[4 * g], o1[4 * g + 1]); w1.y = pkbf(o1[4 * g + 2], o1[4 * g + 3]);
        *(u32x2*)(orow + 8 * g) = w0; *(u32x2*)(orow + 32 + 8 * g) = w1; }
}

DI void sgu_item(int l, bf16_t* p, const bf16_t* T, int item, LAS unsigned char* lds, int tid, int wave, int lane) {
    const int g = item & 3, n = (item >> 2) & 31, b = item >> 7;
    const size_t tok0 = (size_t)b * SEQ + n * 128;
    const bf16_t* zv = T + (size_t)512 * M;
    LAS float* red = (LAS float*)lds;
    LAS float* mean = (LAS float*)(lds + 8192);
    LAS float* rstd = (LAS float*)(lds + 8192 + 512);
    {
        float s0 = 0.f, s1 = 0.f, q0 = 0.f, q1 = 0.f;
        const bf16_t* src = zv + (size_t)(wave * 64) * M + tok0 + 2 * lane;
#pragma unroll 1
        for (int jb = 0; jb < 64; jb += 16) {
            unsigned wv[16];
#pragma unroll
            for (int j = 0; j < 16; ++j) wv[j] = *(const unsigned*)(src + (size_t)(jb + j) * M);
            asm volatile("" ::: "memory");
#pragma unroll
            for (int j = 0; j < 16; ++j) { const float a0 = bflo(wv[j]), a1 = bfhi(wv[j]); s0 += a0; s1 += a1; q0 += a0 * a0; q1 += a1 * a1; }
        }
        *(LAS f32x4*)(red + (wave * 64 + lane) * 4) = (f32x4){s0, q0, s1, q1};
    }
    __syncthreads();
    if (tid < 128) { float s = 0.f, q = 0.f;
#pragma unroll
        for (int w = 0; w < 8; ++w) { const f32x2 v = *(LAS f32x2*)(red + (w * 64 + (tid >> 1)) * 4 + (tid & 1) * 2); s += v.x; q += v.y; }
        const float mu = s * (1.0f / 512.0f), var = fmaxf(q * (1.0f / 512.0f) - mu * mu, 0.f);
        mean[tid] = mu; rstd[tid] = 1.0f / sqrtf(var + LN_EPS); }
    __syncthreads();
    const int cblk = wave & 3, th = wave >> 2, hl = lane >> 5, li = lane & 31;
    const int cch = g * 128 + cblk * 32 + li;
    const float lg = INP(4)[l * 512 + cch], lb = INP(5)[l * 512 + cch];
    const bf16_t* arow = zv + (size_t)cch * M + tok0 + 8 * hl;
    const float* wsp = INP(6) + ((size_t)(l * 4 + g) * 128) * 128;
    f32x16 acc0, acc1;
#pragma unroll
    for (int r = 0; r < 16; ++r) { acc0[r] = 0.f; acc1[r] = 0.f; }
#pragma unroll
    for (int hf = 0; hf < 2; ++hf) if (hf == 0 || th) {
        u32x4 raw[4]; f32x4 wv[4][2][2];
#pragma unroll
        for (int k4 = 0; k4 < 4; ++k4) { const int kk = 4 * hf + k4, sb = 16 * kk + 8 * hl;
            raw[k4] = *(const u32x4*)(arow + 16 * kk);
#pragma unroll
            for (int tb = 0; tb < 2; ++tb) { const int t = th * 64 + tb * 32 + li; wv[k4][tb][0] = *(const f32x4*)(wsp + (size_t)t * 128 + sb); wv[k4][tb][1] = *(const f32x4*)(wsp + (size_t)t * 128 + sb + 4); } }
        asm volatile("" ::: "memory");
#pragma unroll
        for (int k4 = 0; k4 < 4; ++k4) { const int kk = 4 * hf + k4, sb = 16 * kk + 8 * hl;
            const f32x4 m0 = *(LAS f32x4*)(mean + sb), m1 = *(LAS f32x4*)(mean + sb + 4), r0 = *(LAS f32x4*)(rstd + sb), r1 = *(LAS f32x4*)(rstd + sb + 4);
            const u32x4 rw = raw[k4]; u32x4 aw;
            aw.x = pkbf((bflo(rw.x) - m0[0]) * r0[0] * lg + lb, (bfhi(rw.x) - m0[1]) * r0[1] * lg + lb);
            aw.y = pkbf((bflo(rw.y) - m0[2]) * r0[2] * lg + lb, (bfhi(rw.y) - m0[3]) * r0[3] * lg + lb);
            aw.z = pkbf((bflo(rw.z) - m1[0]) * r1[0] * lg + lb, (bfhi(rw.z) - m1[1]) * r1[1] * lg + lb);
            aw.w = pkbf((bflo(rw.w) - m1[2]) * r1[2] * lg + lb, (bfhi(rw.w) - m1[3]) * r1[3] * lg + lb);
            const bf16x8 af = __builtin_bit_cast(bf16x8, aw);
#pragma unroll
            for (int tb = 0; tb < 2; ++tb) { const f32x4 w0 = wv[k4][tb][0], w1 = wv[k4][tb][1];
                u32x4 bw; bw.x = pkbf(w0[0], w0[1]); bw.y = pkbf(w0[2], w0[3]); bw.z = pkbf(w1[0], w1[1]); bw.w = pkbf(w1[2], w1[3]);
                const bf16x8 bfr = __builtin_bit_cast(bf16x8, bw);
                if (tb == 0) acc0 = MFMA32(af, bfr, acc0); else acc1 = MFMA32(af, bfr, acc1); } }
    }
#pragma unroll
    for (int tb = 0; tb < 2; ++tb) {
        const int t = th * 64 + tb * 32 + li; const float bs = INP(7)[(l * 4 + g) * 128 + t];
        bf16_t* urow = p + (tok0 + t) * PC + 1024 + g * 128 + cblk * 32 + 4 * hl;
        u32x2 uws[4];
#pragma unroll
        for (int q = 0; q < 4; ++q) uws[q] = *(const u32x2*)(urow + 8 * q);
#pragma unroll
        for (int q = 0; q < 4; ++q) { const u32x2 uw = uws[q];
            float v0, v1, v2, v3;
            if (tb == 0) { v0 = acc0[4 * q]; v1 = acc0[4 * q + 1]; v2 = acc0[4 * q + 2]; v3 = acc0[4 * q + 3]; } else { v0 = acc1[4 * q]; v1 = acc1[4 * q + 1]; v2 = acc1[4 * q + 2]; v3 = acc1[4 * q + 3]; }
            u32x2 ow; ow.x = pkbf(bflo(uw.x) * (v0 + bs), bfhi(uw.x) * (v1 + bs)); ow.y = pkbf(bflo(uw.y) * (v2 + bs), bfhi(uw.y) * (v3 + bs));
            *(u32x2*)(urow + 8 * q) = ow; }
    }
    __syncthreads();
}

DI void conv_phase(int l, bf16_t* p, LAS unsigned char* lds, int gtid, int NGT) {
    const float* cw = INP(8) + (size_t)l * 3 * 512;
    for (int it = gtid; it < M * 64; it += NGT) {
        const int row = it >> 6, c8 = (it & 63) * 8, t = row & (SEQ - 1);
        bf16_t* pr = p + (size_t)row * PC;
        float accv[8];
#pragma unroll
        for (int e = 0; e < 8; ++e) accv[e] = 0.f;
        u32x4 ccv[3], cxv[3];
#pragma unroll
        for (int j = 0; j < 3; ++j) { const int dt = (t - (2 - j) >= 0) ? 2 - j : 0;
            ccv[j] = *(const u32x4*)(pr - (size_t)dt * PC + 2048 + c8); cxv[j] = *(const u32x4*)(pr - (size_t)dt * PC + 2560 + c8); }
        const u32x4 cb = *(const u32x4*)(pr + 1536 + c8);
        asm volatile("" ::: "memory");
#pragma unroll
        for (int j = 0; j < 3; ++j) { const int dt = 2 - j;
            if (t - dt >= 0) {
                const u32x4 cc = ccv[j], cx = cxv[j];
                const f32x4 w0 = *(const f32x4*)(cw + j * 512 + c8), w1 = *(const f32x4*)(cw + j * 512 + c8 + 4);
                accv[0] += w0[0] * bflo(cc.x) * bflo(cx.x); accv[1] += w0[1] * bfhi(cc.x) * bfhi(cx.x); accv[2] += w0[2] * bflo(cc.y) * bflo(cx.y); accv[3] += w0[3] * bfhi(cc.y) * bfhi(cx.y);
                accv[4] += w1[0] * bflo(cc.z) * bflo(cx.z); accv[5] += w1[1] * bfhi(cc.z) * bfhi(cx.z); accv[6] += w1[2] * bflo(cc.w) * bflo(cx.w); accv[7] += w1[3] * bfhi(cc.w) * bfhi(cx.w); } }
        u32x4 o; o.x = pkbf(bflo(cb.x) * accv[0], bfhi(cb.x) * accv[1]); o.y = pkbf(bflo(cb.y) * accv[2], bfhi(cb.y) * accv[3]); o.z = pkbf(bflo(cb.z) * accv[4], bfhi(cb.z) * accv[5]); o.w = pkbf(bflo(cb.w) * accv[6], bfhi(cb.w) * accv[7]);
        *(u32x4*)(pr + 1536 + c8) = o;
    }
}

DI void xattn_wg(const bf16_t* qx, const bf16_t* memK, const bf16_t* memVT, bf16_t* ox, int item, int tid, int wave, int lane, LAS unsigned char* lds) {
    const int b = item >> 6, h = (item >> 4) & 3, qb = (item & 15) * 8 + wave;
    const int hl = lane >> 5, li = lane & 31;
    const size_t qrow = (size_t)b * SEQ + qb * 32 + li;
    bf16x8 qf[16];
#pragma unroll
    for (int kk = 0; kk < 16; ++kk) qf[kk] = *(const bf16x8*)(qx + qrow * D + h * 256 + 16 * kk + 8 * hl);
    const int sr = tid >> 4, sp0 = (tid & 15) * 2;
    const int kperm_sr = (sr & 16) | ((sr & 4) << 1) | ((sr & 8) >> 1) | (sr & 3);
    const bf16_t* kbase = memK + (size_t)(b * 256) * D + h * 256;
    const bf16_t* vbase = memVT + (size_t)(h * 256) * D + b * 256;
    u32x4 st[2], sn[2];
#define XA_LOAD(R, c) do { if ((c) < 8) { _Pragma("unroll") for (int e = 0; e < 2; ++e) R[e] = *(const u32x4*)(kbase + (size_t)((c) * 32 + sr) * D + (sp0 + e) * 8); } \
                           else { _Pragma("unroll") for (int e = 0; e < 2; ++e) R[e] = *(const u32x4*)(vbase + (size_t)(((c) - 8) * 32 + sr) * D + (sp0 + e) * 8); } } while (0)
#define XA_STORE(R, c) do { const int rl = (c) < 8 ? kperm_sr : sr; _Pragma("unroll") for (int e = 0; e < 2; ++e) { const int p = sp0 + e; \
                           *(LAS u32x4*)(lds + ((c) & 1) * 16384 + (((p >> 1) * 64) + (p & 1) * 32 + rl) * 16) = R[e]; } } while (0)
    XA_LOAD(st, 0); XA_STORE(st, 0); XA_LOAD(st, 1);
    __syncthreads();
    f32x16 S[8];
#pragma unroll
    for (int c = 0; c < 8; ++c) {
        XA_LOAD(sn, c + 2);
        f32x16 z;
#pragma unroll
        for (int r = 0; r < 16; ++r) z[r] = 0.f;
        const LAS unsigned char* buf = lds + (c & 1) * 16384 + lane * 16;
#pragma unroll
        for (int kk = 0; kk < 16; ++kk) { const bf16x8 kf = *(const LAS bf16x8*)(buf + kk * 1024); z = MFMA32(kf, qf[kk], z); }
        S[c] = z;
        XA_STORE(st, c + 1);
        __syncthreads();
        st[0] = sn[0]; st[1] = sn[1];
    }
    float mx = -3.0e38f;
#pragma unroll
    for (int kb = 0; kb < 8; ++kb)
#pragma unroll
        for (int r = 0; r < 16; ++r) mx = fmaxf(mx, S[kb][r]);
    mx = fmaxf(mx, __shfl_xor(mx, 32));
    float sum = 0.f;
    bf16x8 pf[16];
#pragma unroll
    for (int kb = 0; kb < 8; ++kb)
#pragma unroll
        for (int c = 0; c < 2; ++c) { u32x4 w;
#pragma unroll
            for (int e = 0; e < 4; ++e) { const float a0 = __builtin_amdgcn_exp2f((S[kb][8 * c + 2 * e] - mx) * LOG2E), a1 = __builtin_amdgcn_exp2f((S[kb][8 * c + 2 * e + 1] - mx) * LOG2E); sum += a0 + a1; w[e] = pkbf(a0, a1); }
            pf[2 * kb + c] = __builtin_bit_cast(bf16x8, w); }
    sum += __shfl_xor(sum, 32);
    const float inv = 1.0f / sum;
    bf16_t* orow = ox + qrow * D + h * 256 + 4 * hl;
#pragma unroll 1
    for (int c = 8; c < 16; ++c) {
        if (c + 2 < 16) XA_LOAD(sn, c + 2);
        f32x16 o;
#pragma unroll
        for (int r = 0; r < 16; ++r) o[r] = 0.f;
        const LAS unsigned char* buf = lds + (c & 1) * 16384 + lane * 16;
#pragma unroll
        for (int s = 0; s < 16; ++s) { const bf16x8 vf = *(const LAS bf16x8*)(buf + s * 1024); o = MFMA32(vf, pf[s], o); }
        const int db = c - 8;
#pragma unroll
        for (int g = 0; g < 4; ++g) { u32x2 w; w.x = pkbf(o[4 * g] * inv, o[4 * g + 1] * inv); w.y = pkbf(o[4 * g + 2] * inv, o[4 * g + 3] * inv); *(u32x2*)(orow + db * 32 + 8 * g) = w; }
        if (c + 1 < 16) XA_STORE(st, c + 1);
        __syncthreads();
        st[0] = sn[0]; st[1] = sn[1];
    }
#undef XA_LOAD
#undef XA_STORE
}

constexpr int RSD_OFF = 131072 + 768, RS_OFF = 131072 + 1024, RS_MAXU = 15;
template <class Prog>
DI void fill_rs(LAS unsigned char* lds, Prog P2, const float* ssp, int tid) {
    LAS int* desc = (LAS int*)(lds + RSD_OFF);
    if (tid == 0) { pg8::UnitX x; int n = 0; while (n < RS_MAXU && P2.next(x)) { desc[n] = P2.rs_base(x); ++n; } desc[RS_MAXU] = n; }
    __syncthreads();
    const int n = desc[RS_MAXU];
    for (int kb = 0; kb < n; kb += 8) {
        f32x4 sv[4][4]; int ok[4];
#pragma unroll
        for (int j = 0; j < 4; ++j) { const int k = kb + 2 * j + (tid >> 8); const int base = k < n ? desc[k] : -1; ok[j] = base >= 0;
            const f32x4* sp = (const f32x4*)(ssp + (size_t)((ok[j] ? base : 0) + (tid & 255)) * 16);
#pragma unroll
            for (int q = 0; q < 4; ++q) sv[j][q] = ok[j] ? sp[q] : (f32x4){0.f, 0.f, 0.f, 0.f}; }
        asm volatile("" ::: "memory");
#pragma unroll
        for (int j = 0; j < 4; ++j) if (ok[j]) { const int k = kb + 2 * j + (tid >> 8); float s = 0.f;
#pragma unroll
            for (int q = 0; q < 4; ++q) s += (sv[j][q][0] + sv[j][q][1]) + (sv[j][q][2] + sv[j][q][3]);
            ((LAS float*)(lds + RS_OFF))[k * 256 + (tid & 255)] = 1.0f / sqrtf(s * (1.0f / D) + RMS_EPS); }
    }
    __syncthreads();
}
struct ProgC {
    unsigned char* ws; LAS unsigned char* lds; int G, c; int j, i, kk; pg8::Unit u; bool have;
    DI int rs_base(const pg8::UnitX& x) const { return (x.job & 1) ? -1 : x.pm * 256; }
    DI void init(unsigned char* ws_, int G_, int c_, LAS unsigned char* lds_) { lds = lds_; kk = 0; ws = ws_; G = G_; c = c_; j = 0; i = 0; pg8::StaticOrder S; S.init(M, D, G, c); have = S.next(0, u); }
    DI bool next(pg8::UnitX& x) {
        if (have && j >= 6) { pg8::StaticOrder S; S.init(M, D, G, c); ++i; j = 0; have = S.next(i, u); }
        if (!have) return false;
        x.pm = u.pm; x.pn = u.pn; x.job = j; x.k = kk; ++kk; ++j; return true; }
    DI pg8::JobP job(int jj) const { const int n = jj >> 1; pg8::JobP p;
        if ((jj & 1) == 0) { p.A = (const bf16_t*)(ws + WS_XB); p.Bt = (const bf16_t*)(ws + WS_WIN) + (size_t)(4096 + n * 1024) * D; p.lda = D; p.ldb = D; p.nt = D / 64; }
        else { const int acol = n == 0 ? 0 : (n == 1 ? 1024 : 1536); p.A = (const bf16_t*)(ws + WS_P) + acol; p.Bt = (const bf16_t*)(ws + WS_WB) + (size_t)n * D * 512; p.lda = PC; p.ldb = 512; p.nt = 512 / 64; }
        return p; }
    DI void epilogue(const f32x4 (&acc)[2][2][4][2], const pg8::UnitX& x, int wr, int wc, int fr, int fq) const {
        pg8::EpiArgs ea{}; const pg8::Unit uu{x.pm, x.pn};
        if ((x.job & 1) == 0) { ea.O = (bf16_t*)(ws + WS_T); ea.ldc = D; ea.ssp = (const float*)(ws + WS_SSP); ea.rstab = x.k < RS_MAXU ? (const LAS float*)(lds + RS_OFF) + x.k * 256 : nullptr; ea.cscale = 1.f; pg8::Epi<pg8::E_GATE> E{ea}; E(acc, uu, wr, wc, fr, fq); }
        else { ea.O = (bf16_t*)(ws + WS_X2); ea.ldc = D; ea.G = (const bf16_t*)(ws + WS_T);
            if (x.job == 1) { pg8::Epi<pg8::E_BR0> E{ea}; E(acc, uu, wr, wc, fr, fq); } else { pg8::Epi<pg8::E_BRN> E{ea}; E(acc, uu, wr, wc, fr, fq); } }
    }
};
struct ProgA {
    unsigned char* ws; LAS unsigned char* lds; int G, c; int jb, i, njobs, kk;
    DI int rs_base(const pg8::UnitX& x) const { return x.job == 0 ? x.pm * 256 : (x.job == 1 ? x.pn * 256 : -1); }
    DI void init(unsigned char* ws_, int G_, int c_, int l, LAS unsigned char* lds_) { lds = lds_; kk = 0; ws = ws_; G = G_; c = c_; jb = 0; i = 0; njobs = l == 0 ? 4 : 2; }
    DI bool next(pg8::UnitX& x) {
        for (; jb < njobs; ++jb, i = 0) {
            pg8::StaticOrder S; pg8::Unit u;
            if (jb == 0) S.init(M, 3072, G, c); else if (jb == 1) S.init(1024, M, G, c); else if (jb == 2) S.init(1024, D, G, (c + 64) % G); else S.init(D, 1024, G, (c + 192) % G);
            if (S.next(i, u)) { x.pm = u.pm; x.pn = u.pn; x.job = jb; x.k = kk; ++kk; ++i; return true; }
        }
        return false;
    }
    DI pg8::JobP job(int jj) const { pg8::JobP p; p.lda = D; p.ldb = D; p.nt = D / 64;
        if (jj == 0) { p.A = (const bf16_t*)(ws + WS_XB); p.Bt = (const bf16_t*)(ws + WS_WIN); }
        else if (jj == 1) { p.A = (const bf16_t*)(ws + WS_WIN) + (size_t)3072 * D; p.Bt = (const bf16_t*)(ws + WS_XB); }
        else if (jj == 2) { p.A = (const bf16_t*)(ws + WS_MB); p.Bt = (const bf16_t*)(ws + WS_WK); }
        else { p.A = (const bf16_t*)(ws + WS_WV); p.Bt = (const bf16_t*)(ws + WS_MB); }
        return p; }
    DI void epilogue(const f32x4 (&acc)[2][2][4][2], const pg8::UnitX& x, int wr, int wc, int fr, int fq) const {
        pg8::EpiArgs ea{}; const pg8::Unit uu{x.pm, x.pn};
        const LAS float* rst = x.k < RS_MAXU ? (const LAS float*)(lds + RS_OFF) + x.k * 256 : nullptr;
        if (x.job == 0) { ea.O = (bf16_t*)(ws + WS_P); ea.ldc = PC; ea.ssp = (const float*)(ws + WS_SSP); ea.rstab = rst; ea.cscale = 1.f; pg8::Epi<pg8::E_INPROJ> E{ea}; E(acc, uu, wr, wc, fr, fq); }
        else if (x.job == 2) { ea.O = (bf16_t*)(ws + WS_MEMK); ea.ldc = D; ea.ssp = nullptr; ea.cscale = 1.f; pg8::Epi<pg8::E_ROWSCALE> E{ea}; E(acc, uu, wr, wc, fr, fq); }
        else { if (x.job == 1) { ea.O = (bf16_t*)(ws + WS_T); ea.ldc = M; ea.ssp = (const float*)(ws + WS_SSP); ea.rstab = rst; } else { ea.O = (bf16_t*)(ws + WS_MEMVT); ea.ldc = 1024; ea.ssp = nullptr; }
            pg8::Epi<pg8::E_TRANS> E{ea}; E(acc, uu, wr, wc, fr, fq); }
    }
};
struct ProgJ {
    unsigned char* ws; LAS unsigned char* lds; int G, c; int jb, i, njobs, kk;
    DI int rs_base(const pg8::UnitX& x) const { return x.job == 0 ? x.pm * 256 : -1; }
    DI void init(unsigned char* ws_, int G_, int c_, int l, LAS unsigned char* lds_) { lds = lds_; kk = 0; ws = ws_; G = G_; c = c_; jb = 0; i = 0; njobs = l == 0 ? 3 : 1; }
    DI bool next(pg8::UnitX& x) {
        for (; jb < njobs; ++jb, i = 0) {
            pg8::StaticOrder S; pg8::Unit u;
            if (jb == 0) S.init(M, 2 * FF, G, c); else if (jb == 1) S.init(1024, D, G, (c + 128) % G); else S.init(D, 1024, G, (c + 96) % G);
            if (S.next(i, u)) { x.pm = u.pm; x.pn = u.pn; x.job = jb; x.k = kk; ++kk; ++i; return true; }
        }
        return false;
    }
    DI pg8::JobP job(int jj) const { pg8::JobP p; p.lda = D; p.ldb = D; p.nt = D / 64;
        if (jj == 0) { p.A = (const bf16_t*)(ws + WS_XB); p.Bt = (const bf16_t*)(ws + WS_WGU); }
        else if (jj == 1) { p.A = (const bf16_t*)(ws + WS_MB1); p.Bt = (const bf16_t*)(ws + WS_WK1); }
        else { p.A = (const bf16_t*)(ws + WS_WV1); p.Bt = (const bf16_t*)(ws + WS_MB1); }
        return p; }
    DI void epilogue(const f32x4 (&acc)[2][2][4][2], const pg8::UnitX& x, int wr, int wc, int fr, int fq) const {
        pg8::EpiArgs ea{}; const pg8::Unit uu{x.pm, x.pn};
        if (x.job == 0) { ea.O = (bf16_t*)(ws + WS_P); ea.ldc = FF; ea.ssp = (const float*)(ws + WS_SSP) + (size_t)2 * M * 16; ea.rstab = x.k < RS_MAXU ? (const LAS float*)(lds + RS_OFF) + x.k * 256 : nullptr; pg8::Epi<pg8::E_SWIGLU> E{ea}; E(acc, uu, wr, wc, fr, fq); }
        else if (x.job == 1) { ea.O = (bf16_t*)(ws + WS_MEMK1); ea.ldc = D; ea.ssp = nullptr; ea.cscale = 1.f; pg8::Epi<pg8::E_ROWSCALE> E{ea}; E(acc, uu, wr, wc, fr, fq); }
        else { ea.O = (bf16_t*)(ws + WS_MEMVT1); ea.ldc = 1024; ea.ssp = nullptr; pg8::Epi<pg8::E_TRANS> E{ea}; E(acc, uu, wr, wc, fr, fq); }
    }
};
#define XB_TMO      128
#define XB_XCNT(j)  (256  + 64 * (j))
#define XB_XSUB(j)  (1280 + 64 * (j))
#define XB_XGEN(j)  (2304 + 64 * (j))
#define XB_TOP      3328
#define XB_TOPGEN   3392
#define XCD_BAR_WORDS 3456
#define XB_SPIN_CAP (1u << 18)

__device__ __forceinline__ unsigned xb_ld(unsigned* p)              { return __hip_atomic_load(p, __ATOMIC_RELAXED, __HIP_MEMORY_SCOPE_AGENT); }
__device__ __forceinline__ unsigned xb_add(unsigned* p, unsigned v) { return __hip_atomic_fetch_add(p, v, __ATOMIC_RELAXED, __HIP_MEMORY_SCOPE_AGENT); }
__device__ __forceinline__ unsigned xb_xcc_id() { return (unsigned)__builtin_amdgcn_s_getreg((3 << 11) | 20) & 0xFu; }
#define XB_SPIN(cond, bar) do { unsigned _sp = 0; while (cond) { __builtin_amdgcn_s_sleep(1); \
    if ((++_sp & 255u) == 0u) { if (xb_ld(&(bar)[XB_TMO])) break; if (_sp > XB_SPIN_CAP) { atomicAdd(&(bar)[XB_TMO], 1u); break; } } } } while (0)

struct XcdBarrier {
    unsigned* bar; unsigned x;
    volatile LAS unsigned* st;
};

__device__ __forceinline__ XcdBarrier xcd_barrier_post(unsigned* bar, volatile LAS unsigned* st) {
    XcdBarrier b; b.bar = bar; b.x = xb_xcc_id(); b.st = st;
    if (threadIdx.x == 0) (void)xb_add(&bar[XB_XCNT(b.x)], 1u);
    return b;
}
__device__ __forceinline__ void xcd_barrier_complete(unsigned* bar, unsigned x, unsigned& nloc, unsigned& nx) {
    const unsigned G = gridDim.x * gridDim.y * gridDim.z;
    unsigned sum, cnt, mine, sp = 0u;
    for (;;) {
        sum = 0u; cnt = 0u; mine = 0u;
#pragma unroll
        for (unsigned j = 0; j < 16; ++j) { const unsigned c = xb_ld(&bar[XB_XCNT(j)]); sum += c; cnt += (c > 0u) ? 1u : 0u; mine = (j == x) ? c : mine; }
        if (sum == G) break;
        __builtin_amdgcn_s_sleep(1);
        if ((++sp & 255u) == 0u) { if (xb_ld(&bar[XB_TMO])) break; if (sp > XB_SPIN_CAP) { atomicAdd(&bar[XB_TMO], 1u); break; } }
    }
    nloc = mine > 0u ? mine : 1u; nx = cnt > 0u ? cnt : 1u;
}

__device__ __forceinline__ void xcd_barrier(const XcdBarrier& b) {
    asm volatile("s_waitcnt vmcnt(0)" ::: "memory");
    __syncthreads();
    if (threadIdx.x == 0) {
        unsigned* bar = b.bar;
        __builtin_amdgcn_s_waitcnt(0);
        unsigned nloc = b.st[0], nx = b.st[1];
        if (nloc == 0u) { xcd_barrier_complete(bar, b.x, nloc, nx); b.st[0] = nloc; b.st[1] = nx; }
        const unsigned old = xb_add(&bar[XB_XSUB(b.x)], 1u);
        const unsigned gen = old / nloc;
        if (old + 1u == (gen + 1u) * nloc) {
            __builtin_amdgcn_fence(__ATOMIC_RELEASE, "agent");
            asm volatile("s_waitcnt vmcnt(0)" ::: "memory");
            const unsigned og = xb_add(&bar[XB_TOP], 1u);
            const unsigned tg = og / nx;
            if (og + 1u == (tg + 1u) * nx) xb_add(&bar[XB_TOPGEN], 1u);
            else XB_SPIN(xb_ld(&bar[XB_TOPGEN]) == tg, bar);
            __builtin_amdgcn_fence(__ATOMIC_ACQUIRE, "agent");
            xb_add(&bar[XB_XGEN(b.x)], 1u);
            asm volatile("s_waitcnt vmcnt(0)" ::: "memory");
        } else {
            XB_SPIN(xb_ld(&bar[XB_XGEN(b.x)]) == gen, bar);
            __builtin_amdgcn_fence(__ATOMIC_ACQUIRE, "agent");
            asm volatile("s_waitcnt vmcnt(0)" ::: "memory");
        }
    }
    __syncthreads();
}

#define WSB(off) ((bf16_t*)(WSP + (off)))
#define WSF(off) ((float*)(WSP + (off)))
__global__ void __launch_bounds__(NTHREADS, 2) fwd_megakernel(Args A_unused) {
    extern __shared__ __attribute__((aligned(16))) unsigned char lds_raw[];
    LAS unsigned char* lds = (LAS unsigned char*)lds_raw;
    cg::grid_group grid = cg::this_grid();
    { const int tid = threadIdx.x;
    if (tid < 24) { const unsigned long long* ka = (const unsigned long long*)__builtin_amdgcn_kernarg_segment_ptr(); *(LAS unsigned long long*)(lds + PTR_OFF + 8 * tid) = ka[tid]; } }
    if (threadIdx.x < 8) ((LAS unsigned*)(lds + PTR_OFF + 256))[threadIdx.x] = 0u;
    __syncthreads();
    if (blockIdx.x == 0) { unsigned* bw = (unsigned*)ldq(lds, 23); for (int w = threadIdx.x; w < XCD_BAR_WORDS; w += NTHREADS) __hip_atomic_store(bw + w, 0u, __ATOMIC_RELAXED, __HIP_MEMORY_SCOPE_AGENT); }
    asm volatile("s_waitcnt vmcnt(0)" ::: "memory");
    __syncthreads();
    grid.sync();
    const XcdBarrier bar = xcd_barrier_post((unsigned*)ldq(lds, 23), (volatile LAS unsigned*)(lds + PTR_OFF + 256));
#define XBAR() do { XcdBarrier b2_ = bar; asm volatile("" : "+s"(b2_.x)); xcd_barrier(b2_); } while (0)
#define FRESH_IDS const int tid = fresh_tid(), lane = tid & 63, wave = __builtin_amdgcn_readfirstlane(tid >> 6); (void)lane; (void)wave
#define GRID_ ((int)gridDim.x)
#define BID_ ((int)blockIdx.x)
#define GW_ (BID_ * NWAVES + wave)
#define NGW_ (GRID_ * NWAVES)
    constexpr size_t SSPB = (size_t)M * 16 * 4;
    using namespace pg8;

    { FRESH_IDS; prep_x(lds, GW_, NGW_, lane); }
    { FRESH_IDS; prep_weights(0, lds, GW_, NGW_, wave, lane); }
    XBAR();
    for (int l = 0; l < DEPTH; ++l) {
        { ProgA PA; PA.init(WSP, GRID_, BID_, l, lds); { FRESH_IDS; fill_rs(lds, PA, WSF(WS_SSP), tid); } gemm_stream(lds, PA); }
        XBAR();
        if (l > 0) { FRESH_IDS; prep_weights(l, lds, GW_, NGW_, wave, lane, 2); __syncthreads(); }
        { FRESH_IDS;
          for (int it0 = BID_; it0 < NBATCH * 32 * 4; it0 += GRID_) { int it = it0;
              if (GRID_ == 256) { const int r = it0 >> 8, bx = it0 & 255, xcd = bx & 7, slot = bx >> 3; it = (r * 64 + xcd * 8 + (slot >> 2)) * 4 + (slot & 3); }
              sgu_item(l, WSB(WS_P), WSB(WS_T), it, lds, tid, wave, lane); } }
        { FRESH_IDS; for (int it = GW_; it < NBATCH * 8 * 128; it += NGW_) sb_attn_item(WSB(WS_P), WSB(WS_T), it, lane); }
        { FRESH_IDS; conv_phase(l, WSB(WS_P), lds, BID_ * NTHREADS + tid, GRID_ * NTHREADS); }
        XBAR();
        { ProgC PCg; PCg.init(WSP, GRID_, BID_, lds); { FRESH_IDS; fill_rs(lds, PCg, WSF(WS_SSP), tid); } gemm_stream(lds, PCg); }
        XBAR();
        {
            StaticOrder S; S.init(M, D, GRID_, BID_);
            EpiArgs ea{}; Gemm g{WSB(WS_X2), WSB(WS_WOUT), M, D, D, D, D}; ea.xb = WSB(WS_XB); ea.sspo = WSF(WS_SSP + SSPB); Epi<E_RESID> E{ea}; gemm_phase(lds, g, S, E);
        }
        XBAR();
        {
            StaticOrder S; S.init(M, D, GRID_, BID_);
            EpiArgs ea{}; Gemm g{WSB(WS_XB), WSB(WS_WQ), M, D, D, D, D}; ea.O = WSB(WS_T); ea.ldc = D; ea.ssp = WSF(WS_SSP + SSPB); ea.cscale = 0.0625f; Epi<E_ROWSCALE> E{ea}; gemm_phase(lds, g, S, E);
            Unit u;
            for (int i = 0; S.next(i, u); ++i) { FRESH_IDS; xattn_wg(WSB(WS_T), WSB(l ? WS_MEMK1 : WS_MEMK), WSB(l ? WS_MEMVT1 : WS_MEMVT), WSB(WS_X2), (u.pm >> 4) * 64 + u.pn * 16 + (u.pm & 15), tid, wave, lane, lds); }
        }
        XBAR();
        {
            StaticOrder S; S.init(M, D, GRID_, BID_);
            EpiArgs ea{}; Gemm g{WSB(WS_X2), WSB(WS_WOX), M, D, D, D, D}; ea.xb = WSB(WS_XB); ea.sspo = WSF(WS_SSP + 2 * SSPB); Epi<E_RESID> E{ea}; gemm_phase(lds, g, S, E);
        }
        XBAR();
        { ProgJ PJ; PJ.init(WSP, GRID_, BID_, l, lds); { FRESH_IDS; fill_rs(lds, PJ, WSF(WS_SSP + 2 * SSPB), tid); } gemm_stream(lds, PJ); }
        XBAR();
        {
            StaticOrder S; S.init(M, D, GRID_, BID_);
            EpiArgs ea{}; Gemm g{WSB(WS_P), WSB(WS_WD), M, D, FF, FF, FF}; ea.xb = WSB(WS_XB); ea.sspo = WSF(WS_SSP); Epi<E_RESID> E{ea}; gemm_phase(lds, g, S, E);
        }
        if (l + 1 < DEPTH) { FRESH_IDS; prep_weights(l + 1, lds, GW_, NGW_, wave, lane, 1); }
        XBAR();
    }
    { FRESH_IDS; final_norm(lds, GW_, NGW_, lane); }
}

extern "C" void kernel_launch(void* const* d_in, const int* in_sizes, int n_in, void* d_out, int out_size, void* d_ws, size_t ws_size, hipStream_t stream) {
    static int grid = 0;
    if (grid == 0) {
        if (n_in != 22 || in_sizes[0] != M * D || out_size != M * D || ws_size < WS_END) { fprintf(stderr, "kernel_launch: unexpected shapes (n_in %d, in0 %d, out %d, ws %zu)\n", n_in, n_in > 0 ? in_sizes[0] : -1, out_size, ws_size); grid = -1; return; }
        int dev = 0, cus = 0, per_cu = 0;
        hipGetDevice(&dev); hipDeviceGetAttribute(&cus, hipDeviceAttributeMultiprocessorCount, dev);
        hipFuncSetAttribute((const void*)fwd_megakernel, hipFuncAttributeMaxDynamicSharedMemorySize, LDS_BYTES);
        hipOccupancyMaxActiveBlocksPerMultiprocessor(&per_cu, (const void*)fwd_megakernel, NTHREADS, LDS_BYTES);
        if (per_cu < 1) { fprintf(stderr, "kernel_launch: occupancy query says %d blocks per CU\n", per_cu); per_cu = 1; }
        (void)hipGetLastError();
        grid = cus;
    }
    if (grid < 0) return;
    Args a{};
    for (int i = 0; i < 22; ++i) a.in[i] = (const float*)d_in[i];
    a.out = (float*)d_out; a.ws = (unsigned char*)d_ws;
    void* args[] = {&a};
    hipError_t e = hipLaunchCooperativeKernel((const void*)fwd_megakernel, dim3(grid), dim3(NTHREADS), args, LDS_BYTES, stream);
    if (e != hipSuccess) fprintf(stderr, "cooperative launch failed: %s (grid %d)\n", hipGetErrorString(e), grid);
}
```

```cpp
#include <hip/hip_runtime.h>
#include <hip/hip_cooperative_groups.h>
#include <cstdio>
#include <cstdint>
namespace cg = cooperative_groups;

#define LAS __attribute__((address_space(3)))
typedef unsigned short bf16_t;
typedef short bf16x8 __attribute__((ext_vector_type(8)));
typedef float f32x4 __attribute__((ext_vector_type(4)));
typedef float f32x2 __attribute__((ext_vector_type(2)));
typedef float f32x16 __attribute__((ext_vector_type(16)));
typedef unsigned u32x4 __attribute__((ext_vector_type(4)));
typedef unsigned u32x2 __attribute__((ext_vector_type(2)));
typedef __bf16 bf16x2n __attribute__((ext_vector_type(2)));

#define DI __device__ __forceinline__
DI unsigned pkbf(float lo, float hi) { f32x2 v = {lo, hi}; bf16x2n b = __builtin_convertvector(v, bf16x2n); return __builtin_bit_cast(unsigned, b); }
DI float bflo(unsigned u) { return __uint_as_float(u << 16); }
DI float bfhi(unsigned u) { return __uint_as_float(u & 0xffff0000u); }
DI int fresh_tid() { int t = threadIdx.x; asm volatile("" : "+v"(t)); return t; }
#define MFMA32(a, b, c) __builtin_amdgcn_mfma_f32_32x32x16_bf16((a), (b), (c), 0, 0, 0)

constexpr int M = 16384, D = 1024, SEQ = 4096, NBATCH = 4, DEPTH = 2;
constexpr int PC = 3072;
constexpr int FF = 2816;
constexpr int INC = 7168;
constexpr float RMS_EPS = 1e-6f, LN_EPS = 1e-5f;
constexpr float LOG2E = 1.4426950408889634f, LN2 = 0.6931471805599453f;
constexpr float SB_EXIT = 110.0f;

constexpr size_t MiB = (size_t)1 << 20;
constexpr size_t WS_WIN = 1 * MiB;
constexpr size_t WS_WB = 15 * MiB;
constexpr size_t WS_WOUT = 18 * MiB, WS_WQ = 20 * MiB, WS_WK = 22 * MiB, WS_WV = 24 * MiB, WS_WOX = 26 * MiB;
constexpr size_t WS_WGU = 28 * MiB;
constexpr size_t WS_WD = 39 * MiB;
constexpr size_t WS_MB = 45 * MiB, WS_MEMK = 47 * MiB, WS_MEMVT = 49 * MiB;
constexpr size_t WS_XB = 51 * MiB;
constexpr size_t WS_P = 83 * MiB;
constexpr size_t WS_T = 179 * MiB;
constexpr size_t WS_X2 = 211 * MiB;
constexpr size_t WS_SSP = 243 * MiB;
constexpr size_t WS_WK1 = 246 * MiB, WS_WV1 = 248 * MiB, WS_MB1 = 250 * MiB, WS_MEMK1 = 252 * MiB, WS_MEMVT1 = 254 * MiB;
constexpr size_t WS_END = 256 * MiB;

namespace pg8 {
constexpr int BM = 256, BK = 64, HALF = 128, HTB = HALF * BK * 2, STAGE_BYTES = 8 * HTB, NXCD = 8, WGM = 8;
DI int lds_byte(int r, int c) { const int st = (r >> 4) * 2 + (c >> 5), rr = r & 15, cc = c & 31, ob = rr * 64 + cc * 2; return st * 1024 + (ob ^ (((ob >> 9) & 1) << 5)); }
DI void stage_rc(int b, int& R, int& C) { const int st = b / 1024, sb = b % 1024, swz = sb ^ (((sb >> 9) & 1) << 5); R = (st >> 1) * 16 + swz / 64; C = (st & 1) * 32 + (swz % 64) / 2; }
DI int perm32(int rho) { const int n = rho >> 4, i = rho & 15; return 8 * (i >> 2) + 4 * n + (i & 3); }

struct Unit { int pm, pn; };
struct Gemm { const bf16_t* A; const bf16_t* Bt; int M, N, K, lda, ldb; };

struct StaticOrder {
    int nM, nN, nwg, G, c;
    DI void init(int M_, int N_, int G_, int c_) { nM = M_ / BM; nN = N_ / BM; nwg = nM * nN; G = G_; c = c_; }
    DI bool next(int i, Unit& u) const {
        const long L = (long)i * G + c; if (L >= nwg) return false;
        int wgid = (int)L; { const int q = nwg / NXCD, r = nwg % NXCD, xcd = wgid % NXCD, off = wgid / NXCD; wgid = (xcd < r ? xcd * (q + 1) : r * (q + 1) + (xcd - r) * q) + off; }
        const int nig = WGM * nN, gid = wgid / nig, fm = gid * WGM, gsz = (nM - fm) < WGM ? (nM - fm) : WGM;
        u.pm = fm + ((wgid % nig) % gsz); u.pn = (wgid % nig) / gsz; return true;
    }
};

DI f32x2 gelu_pk(f32x2 v) {
    const f32x2 av = __builtin_elementwise_abs(v), d = av * 0.2316418882f + 1.0f;
    f32x2 t; t.x = __builtin_amdgcn_rcpf(d.x); t.y = __builtin_amdgcn_rcpf(d.y);
    f32x2 q = t * 0.5307027145f + (-0.7265760135f); q = q * t + 0.7107068705f; q = q * t + (-0.142248368f); q = q * t + 0.127414796f; q = q * t;
    const f32x2 s = (v * v) * (-0.72134752044f);
    f32x2 e; e.x = __builtin_amdgcn_exp2f(s.x); e.y = __builtin_amdgcn_exp2f(s.y);
    const f32x2 m = v * (q * e), r = v - m;
    f32x2 o; o.x = v.x < 0.f ? m.x : r.x; o.y = v.y < 0.f ? m.y : r.y; return o;
}
DI f32x4 gelu4(f32x4 v) { f32x2 a = gelu_pk((f32x2){v[0], v[1]}), b = gelu_pk((f32x2){v[2], v[3]}); return (f32x4){a.x, a.y, b.x, b.y}; }
DI float sigmoidf_(float x) { return __builtin_amdgcn_rcpf(1.0f + __builtin_amdgcn_exp2f(-x * LOG2E)); }
DI f32x4 sigmoid4(f32x4 v) { return (f32x4){sigmoidf_(v[0]), sigmoidf_(v[1]), sigmoidf_(v[2]), sigmoidf_(v[3])}; }

DI float row_rs(const float* ssp, int row, int fq) {
    const f32x4 v = *(const f32x4*)(ssp + (size_t)row * 16 + fq * 4);
    float s = (v[0] + v[1]) + (v[2] + v[3]);
    s += __shfl_xor(s, 16); s += __shfl_xor(s, 32);
    return 1.0f / sqrtf(s * (1.0f / D) + RMS_EPS);
}

DI void row_rs8(const float* ssp, int row0, int fq, float (&rs)[2][4]) {
    f32x4 v[2][4];
#pragma unroll
    for (int ai = 0; ai < 2; ++ai)
#pragma unroll
        for (int m = 0; m < 4; ++m) v[ai][m] = *(const f32x4*)(ssp + (size_t)(row0 + ai * HALF + m * 16) * 16 + fq * 4);
    asm volatile("" ::: "memory");
#pragma unroll
    for (int ai = 0; ai < 2; ++ai)
#pragma unroll
        for (int m = 0; m < 4; ++m) { float s = (v[ai][m][0] + v[ai][m][1]) + (v[ai][m][2] + v[ai][m][3]); s += __shfl_xor(s, 16); s += __shfl_xor(s, 32); rs[ai][m] = 1.0f / sqrtf(s * (1.0f / D) + RMS_EPS); }
}

DI void row_rs8_lds(const LAS float* tab, int wr, int fr, float (&rs)[2][4]) {
#pragma unroll
    for (int ai = 0; ai < 2; ++ai)
#pragma unroll
        for (int m = 0; m < 4; ++m) rs[ai][m] = tab[ai * HALF + wr * 64 + m * 16 + fr];
}

enum { E_INPROJ = 0, E_TRANS = 1, E_GATE = 2, E_BR0 = 3, E_BRN = 4, E_RESID = 5, E_ROWSCALE = 6, E_SWIGLU = 7 };
struct EpiArgs {
    bf16_t* O; int ldc;
    const float* ssp;
    float cscale;
    const float* xsrc; float* xdst; bf16_t* xb; float* sspo;
    const bf16_t* G;
    const LAS float* rstab;
};
template <int MODE> struct Epi {
    static constexpr bool PERM = true;
    EpiArgs a;
    DI void store8(bf16_t* p, f32x4 v0, f32x4 v1) const { u32x4 w; w.x = pkbf(v0[0], v0[1]); w.y = pkbf(v0[2], v0[3]); w.z = pkbf(v1[0], v1[1]); w.w = pkbf(v1[2], v1[3]); *(u32x4*)p = w; }
    DI void operator()(const f32x4 (&acc)[2][2][4][2], const Unit& u, int wr, int wc, int fr, int fq) const {
        const int row0 = u.pm * BM + wr * 64 + fr, col0 = u.pn * BM + wc * 32 + 8 * fq;
        if constexpr (MODE == E_TRANS) {
            float rsc[2][8];
            if (a.rstab) {
#pragma unroll
                for (int bj = 0; bj < 2; ++bj) { const f32x4 t0 = *(const LAS f32x4*)(a.rstab + bj * HALF + wc * 32 + 8 * fq), t1 = *(const LAS f32x4*)(a.rstab + bj * HALF + wc * 32 + 8 * fq + 4);
                    rsc[bj][0] = t0[0]; rsc[bj][1] = t0[1]; rsc[bj][2] = t0[2]; rsc[bj][3] = t0[3]; rsc[bj][4] = t1[0]; rsc[bj][5] = t1[1]; rsc[bj][6] = t1[2]; rsc[bj][7] = t1[3]; }
            } else if (a.ssp) {
                const int lane = fq * 16 + fr, tok = u.pn * BM + (lane >> 5) * HALF + wc * 32 + (lane & 31);
                const f32x4* sp = (const f32x4*)(a.ssp + (size_t)tok * 16);
                const f32x4 s0 = sp[0], s1 = sp[1], s2 = sp[2], s3 = sp[3];
                const float s = ((s0[0] + s0[1]) + (s0[2] + s0[3])) + ((s1[0] + s1[1]) + (s1[2] + s1[3])) + ((s2[0] + s2[1]) + (s2[2] + s2[3])) + ((s3[0] + s3[1]) + (s3[2] + s3[3]));
                const float rs = 1.0f / sqrtf(s * (1.0f / D) + RMS_EPS);
#pragma unroll
                for (int bj = 0; bj < 2; ++bj)
#pragma unroll
                    for (int e = 0; e < 8; ++e) rsc[bj][e] = __shfl(rs, bj * 32 + 8 * fq + e);
            } else {
#pragma unroll
                for (int bj = 0; bj < 2; ++bj)
#pragma unroll
                    for (int e = 0; e < 8; ++e) rsc[bj][e] = 1.0f;
            }
            const bool act = a.ssp != nullptr && u.pm >= 2;
#pragma unroll
            for (int ai = 0; ai < 2; ++ai)
#pragma unroll
                for (int m = 0; m < 4; ++m) { bf16_t* rowp = a.O + (size_t)(row0 + ai * HALF + m * 16) * a.ldc + col0;
#pragma unroll
                    for (int bj = 0; bj < 2; ++bj) {
                        f32x4 v0 = acc[ai][bj][m][0], v1 = acc[ai][bj][m][1];
                        v0 = v0 * (f32x4){rsc[bj][0], rsc[bj][1], rsc[bj][2], rsc[bj][3]}; v1 = v1 * (f32x4){rsc[bj][4], rsc[bj][5], rsc[bj][6], rsc[bj][7]};
                        if (act) { v0 = gelu4(v0); v1 = gelu4(v1); }
                        store8(rowp + bj * HALF, v0, v1); } }
        } else if constexpr (MODE == E_RESID) {
#pragma unroll
            for (int ai = 0; ai < 2; ++ai) {
                u32x4 xw[4][2];
#pragma unroll
                for (int m = 0; m < 4; ++m)
#pragma unroll
                    for (int bj = 0; bj < 2; ++bj) xw[m][bj] = *(const u32x4*)(a.xb + (size_t)(row0 + ai * HALF + m * 16) * D + col0 + bj * HALF);
                asm volatile("" ::: "memory");
#pragma unroll
                for (int m = 0; m < 4; ++m) { const int row = row0 + ai * HALF + m * 16; const size_t off = (size_t)row * D + col0; float ss = 0.f;
#pragma unroll
                    for (int bj = 0; bj < 2; ++bj) { const u32x4 w = xw[m][bj];
                        const f32x4 v0 = (f32x4){bflo(w.x), bfhi(w.x), bflo(w.y), bfhi(w.y)} + acc[ai][bj][m][0], v1 = (f32x4){bflo(w.z), bfhi(w.z), bflo(w.w), bfhi(w.w)} + acc[ai][bj][m][1];
                        store8(a.xb + off + bj * HALF, v0, v1);
                        ss += (v0[0] * v0[0] + v0[1] * v0[1]) + (v0[2] * v0[2] + v0[3] * v0[3]) + (v1[0] * v1[0] + v1[1] * v1[1]) + (v1[2] * v1[2] + v1[3] * v1[3]); }
                    ss += __shfl_xor(ss, 16); ss += __shfl_xor(ss, 32);
                    if (fq == 0) a.sspo[(size_t)row * 16 + u.pn * 4 + wc] = ss; }
            }
        } else if constexpr (MODE == E_SWIGLU) {
            const int ocol = u.pn * HALF + wc * 32 + 8 * fq;
            float rs8[2][4]; if (a.rstab) row_rs8_lds(a.rstab, wr, fr, rs8); else row_rs8(a.ssp, row0, fq, rs8);
#pragma unroll
            for (int ai = 0; ai < 2; ++ai)
#pragma unroll
                for (int m = 0; m < 4; ++m) { const int row = row0 + ai * HALF + m * 16; const float rs = rs8[ai][m];
                    const f32x4 g0 = acc[ai][0][m][0] * rs, g1 = acc[ai][0][m][1] * rs, u0 = acc[ai][1][m][0] * rs, u1 = acc[ai][1][m][1] * rs;
                    store8(a.O + (size_t)row * a.ldc + ocol, g0 * sigmoid4(g0) * u0, g1 * sigmoid4(g1) * u1); }
        } else {
            float sc = a.cscale; bool gelu = false;
            if constexpr (MODE == E_INPROJ) { sc = (u.pn < 2) ? 0.125f : 1.0f; gelu = (u.pn == 4 || u.pn == 5); }
            if constexpr (MODE == E_INPROJ || MODE == E_GATE || MODE == E_ROWSCALE) {
                float rs8[2][4];
                if (a.rstab) row_rs8_lds(a.rstab, wr, fr, rs8); else if (a.ssp) row_rs8(a.ssp, row0, fq, rs8); else {
#pragma unroll
                    for (int ai = 0; ai < 2; ++ai)
#pragma unroll
                        for (int m = 0; m < 4; ++m) rs8[ai][m] = 1.0f; }
#pragma unroll
                for (int ai = 0; ai < 2; ++ai)
#pragma unroll
                    for (int m = 0; m < 4; ++m) { const int row = row0 + ai * HALF + m * 16; const float rs = sc * rs8[ai][m];
#pragma unroll
                        for (int bj = 0; bj < 2; ++bj) { const size_t off = (size_t)row * a.ldc + col0 + bj * HALF;
                            f32x4 v0 = acc[ai][bj][m][0] * rs, v1 = acc[ai][bj][m][1] * rs;
                            if constexpr (MODE == E_INPROJ) { if (gelu) { v0 = gelu4(v0); v1 = gelu4(v1); } }
                            else if constexpr (MODE == E_GATE) { v0 = sigmoid4(v0); v1 = sigmoid4(v1); }
                            store8(a.O + off, v0, v1); } }
            } else {
#pragma unroll
                for (int ai = 0; ai < 2; ++ai) {
                    u32x4 gw[4][2], pw[4][2];
#pragma unroll
                    for (int m = 0; m < 4; ++m)
#pragma unroll
                        for (int bj = 0; bj < 2; ++bj) { const size_t off = (size_t)(row0 + ai * HALF + m * 16) * a.ldc + col0 + bj * HALF;
                            gw[m][bj] = *(const u32x4*)(a.G + off); if constexpr (MODE == E_BRN) pw[m][bj] = *(const u32x4*)(a.O + off); }
                    asm volatile("" ::: "memory");
#pragma unroll
                    for (int m = 0; m < 4; ++m)
#pragma unroll
                        for (int bj = 0; bj < 2; ++bj) { const size_t off = (size_t)(row0 + ai * HALF + m * 16) * a.ldc + col0 + bj * HALF; const u32x4 g = gw[m][bj];
                            f32x4 v0 = acc[ai][bj][m][0] * (f32x4){bflo(g.x), bfhi(g.x), bflo(g.y), bfhi(g.y)}, v1 = acc[ai][bj][m][1] * (f32x4){bflo(g.z), bfhi(g.z), bflo(g.w), bfhi(g.w)};
                            if constexpr (MODE == E_BRN) { const u32x4 q = pw[m][bj];
                                v0 = v0 + (f32x4){bflo(q.x), bfhi(q.x), bflo(q.y), bfhi(q.y)}; v1 = v1 + (f32x4){bflo(q.z), bfhi(q.z), bflo(q.w), bfhi(q.w)}; }
                            store8(a.O + off, v0, v1); }
                }
            }
        }
    }
};

template <class EpiT>
DI void gemm_phase(LAS unsigned char* lds, const Gemm g, const StaticOrder& S, const EpiT& E) {
    const int tid = fresh_tid(), wid = __builtin_amdgcn_readfirstlane(tid >> 6), lane = tid & 63, wr = wid >> 2, wc = wid & 3, fr = lane & 15, fq = lane >> 4;
    const int nt = g.K / BK;
    unsigned voffA[2], voffB[2];
#pragma unroll
    for (int i = 0; i < 2; ++i) { int R, C; stage_rc(tid * 16 + i * 8192, R, C); const int Rb = EpiT::PERM ? ((R & ~31) + perm32(R & 31)) : R;
        voffA[i] = (unsigned)(R * g.lda + C) * 2u; voffB[i] = (unsigned)(Rb * g.ldb + C) * 2u; }
    const size_t kstep = (size_t)(BK * 2);
    const size_t hstepA = (size_t)HALF * g.lda * 2, hstepB = (size_t)HALF * g.ldb * 2;
    const size_t tstepA = 2 * hstepA, tstepB = 2 * hstepB;
    const unsigned ldsw = (unsigned)wid * 1024u;
    const int aoff = lds_byte(wr * 64 + fr, fq * 8), boff = lds_byte(wc * 32 + fr, fq * 8);
#define PG8_SA(b, h) (((b) * 2 + (h)) * HTB)
#define PG8_SB(b, h) ((4 + (b) * 2 + (h)) * HTB)
#define PG8_STAGE(bufoff, gbase, voff) do { _Pragma("unroll") for (int _i = 0; _i < 2; ++_i) \
        __builtin_amdgcn_global_load_lds((const unsigned*)((const char*)(gbase) + (voff)[_i]), (LAS unsigned*)(lds + (bufoff) + ldsw + _i * 8192), 16, 0, 0); } while (0)
#define PG8_LDA(dst, b, h) do { _Pragma("unroll") for (int m = 0; m < 4; ++m) _Pragma("unroll") for (int k = 0; k < 2; ++k) dst[m][k] = *(const LAS bf16x8*)(lds + PG8_SA(b, h) + aoff + m * 2048 + k * 1024); } while (0)
#define PG8_LDB(dst, b, h) do { _Pragma("unroll") for (int n = 0; n < 2; ++n) _Pragma("unroll") for (int k = 0; k < 2; ++k) dst[n][k] = *(const LAS bf16x8*)(lds + PG8_SB(b, h) + boff + n * 2048 + k * 1024); } while (0)
#define PG8_MMA(ai, bj, At, Bt) do { __builtin_amdgcn_s_setprio(1); _Pragma("unroll") for (int m = 0; m < 4; ++m) _Pragma("unroll") for (int n = 0; n < 2; ++n) _Pragma("unroll") for (int k = 0; k < 2; ++k) \
        acc[ai][bj][m][n] = __builtin_amdgcn_mfma_f32_16x16x32_bf16(Bt[n][k], At[m][k], acc[ai][bj][m][n], 0, 0, 0); __builtin_amdgcn_s_setprio(0); } while (0)
#define PG8_WAIT_V(n) asm volatile("s_waitcnt vmcnt(" #n ")" ::: "memory")
#define PG8_WAIT_L(n) asm volatile("s_waitcnt lgkmcnt(" #n ")" ::: "memory")
#define PG8_BAR __builtin_amdgcn_s_barrier()
#define PG8_SCHED __builtin_amdgcn_sched_barrier(0)
    Unit cur, nxt; int ui = 0;
    if (!S.next(0, cur)) return;
    f32x4 acc[2][2][4][2];
#pragma unroll
    for (int a = 0; a < 2; ++a)
#pragma unroll
        for (int b = 0; b < 2; ++b)
#pragma unroll
            for (int m = 0; m < 4; ++m)
#pragma unroll
                for (int n = 0; n < 2; ++n) acc[a][b][m][n] = (f32x4){0.f, 0.f, 0.f, 0.f};
    bf16x8 At[4][2], B0[2][2], B1[2][2];
    const char* cA = (const char*)g.A + (size_t)cur.pm * tstepA; const char* cB = (const char*)g.Bt + (size_t)cur.pn * tstepB;
    PG8_STAGE(PG8_SB(0, 0), cB, voffB); PG8_STAGE(PG8_SB(0, 1), cB + hstepB, voffB); PG8_STAGE(PG8_SA(0, 0), cA, voffA); PG8_STAGE(PG8_SA(0, 1), cA + hstepA, voffA);
    if (wr == 1) PG8_BAR;
    PG8_WAIT_V(2); PG8_BAR;
    PG8_STAGE(PG8_SB(1, 0), cB + kstep, voffB); PG8_STAGE(PG8_SA(1, 0), cA + kstep, voffA); PG8_STAGE(PG8_SB(1, 1), cB + hstepB + kstep, voffB);
    PG8_WAIT_V(6); PG8_BAR;
    for (;;) {
        const bool has_next = S.next(ui + 1, nxt);
        const char* nA = has_next ? (const char*)g.A + (size_t)nxt.pm * tstepA : cA; const char* nB = has_next ? (const char*)g.Bt + (size_t)nxt.pn * tstepB : cB;
        for (int t = 0; t < nt; t += 2) {
            const bool last = (t == nt - 2);
            const char* a1 = cA + (size_t)(t + 1) * kstep;
            const char* a2 = last ? nA : cA + (size_t)(t + 2) * kstep; const char* b2 = last ? nB : cB + (size_t)(t + 2) * kstep;
            const char* a3 = a2 + kstep; const char* b3 = b2 + kstep;
            PG8_LDB(B0, 0, 0); PG8_LDB(B1, 0, 1); PG8_SCHED; PG8_LDA(At, 0, 0); PG8_STAGE(PG8_SA(1, 1), a1 + hstepA, voffA);
            PG8_WAIT_V(8); PG8_WAIT_L(0); PG8_BAR; PG8_MMA(0, 0, At, B0); PG8_MMA(0, 1, At, B1); PG8_BAR; PG8_SCHED;
            PG8_LDA(At, 0, 1); PG8_STAGE(PG8_SB(0, 0), b2, voffB); PG8_STAGE(PG8_SB(0, 1), b2 + hstepB, voffB); PG8_STAGE(PG8_SA(0, 0), a2, voffA);
            PG8_WAIT_V(8); PG8_WAIT_L(0); PG8_BAR; PG8_MMA(1, 0, At, B0); PG8_MMA(1, 1, At, B1); PG8_BAR; PG8_SCHED;
            PG8_LDB(B0, 1, 0); PG8_LDB(B1, 1, 1); PG8_SCHED; PG8_LDA(At, 1, 0); PG8_STAGE(PG8_SA(0, 1), a2 + hstepA, voffA);
            PG8_WAIT_V(8); PG8_WAIT_L(0); PG8_BAR; PG8_MMA(0, 0, At, B0); PG8_MMA(0, 1, At, B1); PG8_BAR; PG8_SCHED;
            PG8_LDA(At, 1, 1); PG8_STAGE(PG8_SB(1, 0), b3, voffB); PG8_STAGE(PG8_SB(1, 1), b3 + hstepB, voffB); PG8_STAGE(PG8_SA(1, 0), a3, voffA);
            PG8_WAIT_V(8); PG8_WAIT_L(0); PG8_BAR; PG8_MMA(1, 0, At, B0); PG8_MMA(1, 1, At, B1); PG8_BAR; PG8_SCHED;
        }
        if (wr == 0) PG8_BAR;
        E(acc, cur, wr, wc, fr, fq);
        if (!has_next) break;
#pragma unroll
        for (int a = 0; a < 2; ++a)
#pragma unroll
            for (int b = 0; b < 2; ++b)
#pragma unroll
                for (int m = 0; m < 4; ++m)
#pragma unroll
                    for (int n = 0; n < 2; ++n) acc[a][b][m][n] = (f32x4){0.f, 0.f, 0.f, 0.f};
        cur = nxt; cA = nA; cB = nB; ++ui;
        if (wr == 1) PG8_BAR;
    }
    PG8_WAIT_V(0);
    PG8_BAR;

}

struct UnitX { int pm, pn, job, k; };
struct JobP { const bf16_t* A; const bf16_t* Bt; int lda, ldb, nt; };
template <class Prog>
DI void gemm_stream(LAS unsigned char* lds, Prog& P) {
    const int tid = fresh_tid(), wid = __builtin_amdgcn_readfirstlane(tid >> 6), lane = tid & 63, wr = wid >> 2, wc = wid & 3, fr = lane & 15, fq = lane >> 4;
    const size_t kstep = (size_t)(BK * 2);
    const unsigned ldsw = (unsigned)wid * 1024u;
    const int aoff = lds_byte(wr * 64 + fr, fq * 8), boff = lds_byte(wc * 32 + fr, fq * 8);
#define PG8_VOFF(vA, vB, j) do { _Pragma("unroll") for (int _i = 0; _i < 2; ++_i) { int sR_, sC_; stage_rc(tid * 16 + _i * 8192, sR_, sC_); const int sRb_ = (sR_ & ~31) + perm32(sR_ & 31); \
        vA[_i] = (unsigned)(sR_ * (j).lda + sC_) * 2u; vB[_i] = (unsigned)(sRb_ * (j).ldb + sC_) * 2u; } } while (0)
    UnitX cur, nxt;
    if (!P.next(cur)) return;
    JobP jc = P.job(cur.job);
    unsigned voffA[2], voffB[2], voffAn[2], voffBn[2];
    PG8_VOFF(voffA, voffB, jc);
    unsigned hstepA = (unsigned)(HALF * jc.lda * 2), hstepB = (unsigned)(HALF * jc.ldb * 2), hstepAn, hstepBn;
    int nt = jc.nt;
    f32x4 acc[2][2][4][2];
#pragma unroll
    for (int a = 0; a < 2; ++a)
#pragma unroll
        for (int b = 0; b < 2; ++b)
#pragma unroll
            for (int m = 0; m < 4; ++m)
#pragma unroll
                for (int n = 0; n < 2; ++n) acc[a][b][m][n] = (f32x4){0.f, 0.f, 0.f, 0.f};
    bf16x8 At[4][2], B0[2][2], B1[2][2];
    const char* cA = (const char*)jc.A + (size_t)cur.pm * 2 * hstepA; const char* cB = (const char*)jc.Bt + (size_t)cur.pn * 2 * hstepB;
    PG8_STAGE(PG8_SB(0, 0), cB, voffB); PG8_STAGE(PG8_SB(0, 1), cB + hstepB, voffB); PG8_STAGE(PG8_SA(0, 0), cA, voffA); PG8_STAGE(PG8_SA(0, 1), cA + hstepA, voffA);
    if (wr == 1) PG8_BAR;
    PG8_WAIT_V(2); PG8_BAR;
    PG8_STAGE(PG8_SB(1, 0), cB + kstep, voffB); PG8_STAGE(PG8_SA(1, 0), cA + kstep, voffA); PG8_STAGE(PG8_SB(1, 1), cB + hstepB + kstep, voffB);
    PG8_WAIT_V(6); PG8_BAR;
    for (;;) {
        const bool has_next = P.next(nxt);
        const char* nA = cA; const char* nB = cB; int ntn = nt;
        hstepAn = hstepA; hstepBn = hstepB; voffAn[0] = voffA[0]; voffAn[1] = voffA[1]; voffBn[0] = voffB[0]; voffBn[1] = voffB[1];
        if (has_next) { const JobP jn = P.job(nxt.job); PG8_VOFF(voffAn, voffBn, jn); hstepAn = (unsigned)(HALF * jn.lda * 2); hstepBn = (unsigned)(HALF * jn.ldb * 2); ntn = jn.nt;
            nA = (const char*)jn.A + (size_t)nxt.pm * 2 * hstepAn; nB = (const char*)jn.Bt + (size_t)nxt.pn * 2 * hstepBn; }
        for (int t = 0; t < nt; t += 2) {
            const bool last = (t == nt - 2);
            const char* a1 = cA + (size_t)(t + 1) * kstep;
            const char* a2 = last ? nA : cA + (size_t)(t + 2) * kstep; const char* b2 = last ? nB : cB + (size_t)(t + 2) * kstep;
            const char* a3 = a2 + kstep; const char* b3 = b2 + kstep;
            const unsigned hA2 = last ? hstepAn : hstepA, hB2 = last ? hstepBn : hstepB;
            unsigned vA2[2], vB2[2];
            vA2[0] = last ? voffAn[0] : voffA[0]; vA2[1] = last ? voffAn[1] : voffA[1]; vB2[0] = last ? voffBn[0] : voffB[0]; vB2[1] = last ? voffBn[1] : voffB[1];
            PG8_LDB(B0, 0, 0); PG8_LDB(B1, 0, 1); PG8_SCHED; PG8_LDA(At, 0, 0); PG8_STAGE(PG8_SA(1, 1), a1 + hstepA, voffA);
            PG8_WAIT_V(8); PG8_WAIT_L(0); PG8_BAR; PG8_MMA(0, 0, At, B0); PG8_MMA(0, 1, At, B1); PG8_BAR; PG8_SCHED;
            PG8_LDA(At, 0, 1); PG8_STAGE(PG8_SB(0, 0), b2, vB2); PG8_STAGE(PG8_SB(0, 1), b2 + hB2, vB2); PG8_STAGE(PG8_SA(0, 0), a2, vA2);
            PG8_WAIT_V(8); PG8_WAIT_L(0); PG8_BAR; PG8_MMA(1, 0, At, B0); PG8_MMA(1, 1, At, B1); PG8_BAR; PG8_SCHED;
            PG8_LDB(B0, 1, 0); PG8_LDB(B1, 1, 1); PG8_SCHED; PG8_LDA(At, 1, 0); PG8_STAGE(PG8_SA(0, 1), a2 + hA2, vA2);
            PG8_WAIT_V(8); PG8_WAIT_L(0); PG8_BAR; PG8_MMA(0, 0, At, B0); PG8_MMA(0, 1, At, B1); PG8_BAR; PG8_SCHED;
            PG8_LDA(At, 1, 1); PG8_STAGE(PG8_SB(1, 0), b3, vB2); PG8_STAGE(PG8_SB(1, 1), b3 + hB2, vB2); PG8_STAGE(PG8_SA(1, 0), a3, vA2);
            PG8_WAIT_V(8); PG8_WAIT_L(0); PG8_BAR; PG8_MMA(1, 0, At, B0); PG8_MMA(1, 1, At, B1); PG8_BAR; PG8_SCHED;
        }
        if (wr == 0) PG8_BAR;
        P.epilogue(acc, cur, wr, wc, fr, fq);
        if (!has_next) break;
#pragma unroll
        for (int a = 0; a < 2; ++a)
#pragma unroll
            for (int b = 0; b < 2; ++b)
#pragma unroll
                for (int m = 0; m < 4; ++m)
#pragma unroll
                    for (int n = 0; n < 2; ++n) acc[a][b][m][n] = (f32x4){0.f, 0.f, 0.f, 0.f};
        cur = nxt; cA = nA; cB = nB; nt = ntn; hstepA = hstepAn; hstepB = hstepBn; voffA[0] = voffAn[0]; voffA[1] = voffAn[1]; voffB[0] = voffBn[0]; voffB[1] = voffBn[1];
        if (wr == 1) PG8_BAR;
    }
    PG8_WAIT_V(0);
    PG8_BAR;
#undef PG8_VOFF
}
#undef PG8_SA
#undef PG8_SB
#undef PG8_STAGE
#undef PG8_LDA
#undef PG8_LDB
#undef PG8_MMA
#undef PG8_WAIT_V
#undef PG8_WAIT_L
#undef PG8_BAR
#undef PG8_SCHED
}

constexpr int NWAVES = 8, NTHREADS = 512;
constexpr int LDS_BYTES = 147456;

DI float wave_sum(float v) {
#pragma unroll
    for (int o = 1; o < 64; o <<= 1) v += __shfl_xor(v, o);
    return v;
}

DI void transpose_item(const float* W, int K, int N, const float* gk, bf16_t* WT, int dst_row0, int k0, int n0, LAS float* scr, int lane) {
    f32x4 wv[8]; float gv[8];
#pragma unroll
    for (int i = 0; i < 8; ++i) { const int kk = 8 * i + (lane >> 3), nq = (lane & 7) * 4; wv[i] = __builtin_nontemporal_load((const f32x4*)(W + (size_t)(k0 + kk) * N + n0 + nq));     gv[i] = gk ? gk[k0 + kk] : 1.0f; }
    asm volatile("" ::: "memory");
#pragma unroll
    for (int i = 0; i < 8; ++i) { const int kk = 8 * i + (lane >> 3), nq = (lane & 7) * 4; const f32x4 w = wv[i] * gv[i];
        LAS float* d = scr + kk * 33 + nq; d[0] = w[0]; d[1] = w[1]; d[2] = w[2]; d[3] = w[3]; }
    asm volatile("s_waitcnt lgkmcnt(0)" ::: "memory");
    const int c = lane & 7;
#pragma unroll
    for (int j = 0; j < 4; ++j) { const int n = (lane >> 3) + 8 * j; const LAS float* s = scr + (8 * c) * 33 + n;
        u32x4 o; o.x = pkbf(s[0 * 33], s[1 * 33]); o.y = pkbf(s[2 * 33], s[3 * 33]); o.z = pkbf(s[4 * 33], s[5 * 33]); o.w = pkbf(s[6 * 33], s[7 * 33]);
        *(u32x4*)(WT + (size_t)(dst_row0 + n) * K + k0 + 8 * c) = o; }
    asm volatile("s_waitcnt lgkmcnt(0)" ::: "memory");
}

struct Args { const float* in[22]; float* out; unsigned char* ws; };
constexpr int PTR_OFF = 131072;
DI unsigned long long ldq(LAS unsigned char* lds, int i) {
    unsigned off = (unsigned)(PTR_OFF + 8 * i); asm volatile("" : "+v"(off));
    const unsigned long long v = *(const LAS unsigned long long*)(lds + off);
    const unsigned lo = __builtin_amdgcn_readfirstlane((unsigned)v), hi = __builtin_amdgcn_readfirstlane((unsigned)(v >> 32));
    return ((unsigned long long)hi << 32) | lo;
}
#define GAS __attribute__((address_space(1)))
#define INP(i) ((const float*)(const GAS float*)ldq(lds, (i)))
#define OUTP ((float*)(GAS float*)ldq(lds, 22))
#define WSP ((unsigned char*)(GAS unsigned char*)ldq(lds, 23))

DI void prep_weights(int l, LAS unsigned char* lds, int gw, int NGW, int wave, int lane, int part = 0) {
    LAS float* scr = (LAS float*)(lds + wave * 16384);
    unsigned char* ws = WSP;
    constexpr int I_IN = 16 * 224, I_BR = 8 * 32, I_SQ = 16 * 32, I_GU = 16 * 88, I_DN = 44 * 32;
    constexpr int NSQ = 7; constexpr int NITEMS = I_IN + 3 * I_BR + NSQ * I_SQ + 2 * I_GU + I_DN;
    const int it_lo = part == 2 ? NITEMS - I_DN : 0, it_hi = part == 1 ? NITEMS - I_DN : NITEMS;
    for (int it = it_lo + gw; it < it_hi; it += NGW) {
        int r = it;
        if (r < I_IN) { const int kb = r / 224, nb = r % 224, n0 = nb * 32, seg = n0 >> 9;
            int base;
            switch (seg) { case 0: base = 0; break; case 1: base = 512; break; case 2: base = 3072; break; case 3: base = 1024; break; case 4: base = 3584; break;
                           case 5: base = 1536; break; case 6: base = 2048; break; case 7: base = 2560; break; default: base = seg * 512; break; }
            transpose_item(INP(3) + (size_t)l * D * INC, D, INC, INP(2) + l * D, (bf16_t*)(ws + WS_WIN), base + (n0 & 511), kb * 64, n0, scr, lane); continue; }
        r -= I_IN;
        if (r < 3 * I_BR) { const int n = r / I_BR, q = r % I_BR, kb = q / 32, nb = q % 32;
            transpose_item(INP(9) + ((size_t)l * 3 + n) * 512 * D, 512, D, nullptr, (bf16_t*)(ws + WS_WB) + (size_t)n * D * 512, nb * 32, kb * 64, nb * 32, scr, lane); continue; }
        r -= 3 * I_BR;
        if (r < NSQ * I_SQ) { const int w = r / I_SQ, q = r % I_SQ, kb = q / 32, nb = q % 32;
            const float* src; const float* gk = nullptr; size_t dst;
            if (l == 0 && w >= 5) {
                transpose_item(INP(w == 5 ? 14 : 15) + (size_t)D * D, D, D, nullptr, (bf16_t*)(ws + (w == 5 ? WS_WK1 : WS_WV1)), nb * 32, kb * 64, nb * 32, scr, lane); continue; }
            if (w >= 5 || (l == 1 && (w == 2 || w == 3))) continue;
            switch (w) { case 0: src = INP(10); dst = WS_WOUT; break; case 1: src = INP(13); dst = WS_WQ; gk = INP(11) + l * D; break; case 2: src = INP(14); dst = WS_WK; break;
                         case 3: src = INP(15); dst = WS_WV; break; default: src = INP(16); dst = WS_WOX; break; }
            transpose_item(src + (size_t)l * D * D, D, D, gk, (bf16_t*)(ws + dst), nb * 32, kb * 64, nb * 32, scr, lane); continue; }
        r -= NSQ * I_SQ;
        if (r < 2 * I_GU) { const int w = r / I_GU, q = r % I_GU, kb = q / 88, nb = q % 88, n0 = nb * 32;
            transpose_item(INP(18 + w) + (size_t)l * D * FF, D, FF, INP(17) + l * D, (bf16_t*)(ws + WS_WGU), (n0 >> 7) * 256 + w * 128 + (n0 & 127), kb * 64, n0, scr, lane); continue; }
        r -= 2 * I_GU;
        { const int kb = r / 32, nb = r % 32;
          transpose_item(INP(20) + (size_t)l * FF * D, FF, D, nullptr, (bf16_t*)(ws + WS_WD), nb * 32, kb * 64, nb * 32, scr, lane); }
    }
    if (l == 0) {
        for (int row2 = gw; row2 < 2 * NBATCH * 256; row2 += NGW) {
            const int lay = row2 >> 10, row = row2 & 1023; const float* mg = INP(12) + lay * D;
            const f32x4* xr = (const f32x4*)(INP(1) + (size_t)row * D) + lane; f32x4 v[4]; float s = 0.f;
#pragma unroll
            for (int j = 0; j < 4; ++j) { v[j] = xr[64 * j]; s += (v[j][0] * v[j][0] + v[j][1] * v[j][1]) + (v[j][2] * v[j][2] + v[j][3] * v[j][3]); }
            const float rs = 1.0f / sqrtf(wave_sum(s) * (1.0f / D) + RMS_EPS);
            u32x2* o = (u32x2*)((bf16_t*)(ws + (lay ? WS_MB1 : WS_MB)) + (size_t)row * D) + lane;
#pragma unroll
            for (int j = 0; j < 4; ++j) { const f32x4 gv = *((const f32x4*)mg + lane + 64 * j); u32x2 w; w.x = pkbf(v[j][0] * rs * gv[0], v[j][1] * rs * gv[1]); w.y = pkbf(v[j][2] * rs * gv[2], v[j][3] * rs * gv[3]); o[64 * j] = w; }
        }
    }
}

DI void prep_x(LAS unsigned char* lds, int gw, int NGW, int lane) {
    unsigned char* ws = WSP; const float* xin = INP(0);
    float* ssp = (float*)(ws + WS_SSP);
    constexpr int NR = 4;
    for (int row0 = gw; row0 < M; row0 += NR * NGW) {
        f32x4 v[NR][4];
#pragma unroll
        for (int r = 0; r < NR; ++r) { const int row = row0 + r * NGW < M ? row0 + r * NGW : row0; const f32x4* xr = (const f32x4*)(xin + (size_t)row * D) + lane;
#pragma unroll
            for (int j = 0; j < 4; ++j) v[r][j] = __builtin_nontemporal_load(xr + 64 * j); }
        asm volatile("" ::: "memory");
#pragma unroll
        for (int r = 0; r < NR; ++r) { const int row = row0 + r * NGW; if (row < M) { float s = 0.f;
#pragma unroll
            for (int j = 0; j < 4; ++j) s += (v[r][j][0] * v[r][j][0] + v[r][j][1] * v[r][j][1]) + (v[r][j][2] * v[r][j][2] + v[r][j][3] * v[r][j][3]);
            s = wave_sum(s);
            u32x2* o = (u32x2*)((bf16_t*)(ws + WS_XB) + (size_t)row * D) + lane;
#pragma unroll
            for (int j = 0; j < 4; ++j) { u32x2 w; w.x = pkbf(v[r][j][0], v[r][j][1]); w.y = pkbf(v[r][j][2], v[r][j][3]); o[64 * j] = w; }
            if (lane < 16) ssp[(size_t)row * 16 + lane] = lane == 0 ? s : 0.f; } }
    }
}

DI void final_norm(LAS unsigned char* lds, int gw, int NGW, int lane) {
    const float* fg = INP(21); float* outp = OUTP; const float* ssp = (const float*)(WSP + WS_SSP); const bf16_t* xb = (const bf16_t*)(WSP + WS_XB);
    f32x4 gv[4];
#pragma unroll
    for (int j = 0; j < 4; ++j) gv[j] = *((const f32x4*)fg + lane + 64 * j);
    constexpr int NR = 4;
    for (int row0 = gw; row0 < M; row0 += NR * NGW) {
        u32x2 w[NR][4]; float sp[NR];
#pragma unroll
        for (int r = 0; r < NR; ++r) { const int row = row0 + r * NGW < M ? row0 + r * NGW : row0; const u32x2* xbr = (const u32x2*)(xb + (size_t)row * D) + lane;
            sp[r] = lane < 16 ? ssp[(size_t)row * 16 + lane] : 0.f;
#pragma unroll
            for (int j = 0; j < 4; ++j) w[r][j] = __builtin_nontemporal_load(xbr + 64 * j); }
        asm volatile("" ::: "memory");
#pragma unroll
        for (int r = 0; r < NR; ++r) { const int row = row0 + r * NGW; if (row < M) {
            const float rs = 1.0f / sqrtf(wave_sum(sp[r]) * (1.0f / D) + RMS_EPS);
            f32x4* xr = (f32x4*)(outp + (size_t)row * D) + lane;
#pragma unroll
            for (int j = 0; j < 4; ++j) __builtin_nontemporal_store((f32x4){bflo(w[r][j].x), bfhi(w[r][j].x), bflo(w[r][j].y), bfhi(w[r][j].y)} * rs * gv[j], xr + 64 * j); } }
    }
}

DI void sb_attn_item(bf16_t* p, const bf16_t* T, int item, int lane) {
    const int b = item >> 10, h = (item >> 7) & 7, qb = item & 127;
    const int hl = lane >> 5, li = lane & 31;
    const size_t rowbase = (size_t)b * SEQ;
    const int kperm = (li & 16) | ((li & 4) << 1) | ((li & 8) >> 1) | (li & 3);
    const bf16_t* qrow = p + (rowbase + qb * 32 + li) * PC + h * 64 + 8 * hl;
    bf16x8 qf[4];
#pragma unroll
    for (int kk = 0; kk < 4; ++kk) qf[kk] = *(const bf16x8*)(qrow + 16 * kk);
    bf16x8 U[2];
#pragma unroll
    for (int c = 0; c < 2; ++c)
#pragma unroll
        for (int e = 0; e < 8; ++e) U[c][e] = (16 * c + 8 * hl + e >= kperm) ? (short)0x3f80 : (short)0;
    f32x16 o0, o1;
#pragma unroll
    for (int r = 0; r < 16; ++r) { o0[r] = 0.f; o1[r] = 0.f; }
    float carry = 0.f;
    const bf16_t* vt0 = T + (size_t)(h * 64 + li) * M + rowbase + 8 * hl;
    for (int kb = qb; kb >= 0; --kb) {
        const int s0 = kb * 32;
        const bf16_t* krow = p + (rowbase + s0 + kperm) * PC + 512 + h * 64 + 8 * hl;
        bf16x8 kf[4], vf[4];
#pragma unroll
        for (int kk = 0; kk < 4; ++kk) kf[kk] = *(const bf16x8*)(krow + 16 * kk);
#pragma unroll
        for (int c = 0; c < 2; ++c) { vf[c] = *(const bf16x8*)(vt0 + s0 + 16 * c); vf[2 + c] = *(const bf16x8*)(vt0 + (size_t)32 * M + s0 + 16 * c); }
        f32x16 z;
#pragma unroll
        for (int r = 0; r < 16; ++r) z[r] = 0.f;
#pragma unroll
        for (int kk = 0; kk < 4; ++kk) z = MFMA32(kf[kk], qf[kk], z);
        const bool diag = (kb == qb);
        float Lv[16];
#pragma unroll
        for (int r = 0; r < 16; ++r) {
            const float zz = z[r];
            float L = fmaxf(zz, 0.f) + LN2 * __builtin_amdgcn_logf(1.0f + __builtin_amdgcn_exp2f(-fabsf(zz) * LOG2E));
            if (diag && !(16 * (r >> 3) + 8 * hl + (r & 7) < li)) L = 0.f;
            Lv[r] = L;
        }
        bf16x8 Lh[2], Ll[2];
#pragma unroll
        for (int c = 0; c < 2; ++c) { u32x4 wh, wl;
#pragma unroll
            for (int e = 0; e < 4; ++e) { const float a0 = Lv[8 * c + 2 * e], a1 = Lv[8 * c + 2 * e + 1]; const unsigned hp = pkbf(a0, a1); wh[e] = hp; wl[e] = pkbf(a0 - bflo(hp), a1 - bfhi(hp)); }
            Lh[c] = __builtin_bit_cast(bf16x8, wh); Ll[c] = __builtin_bit_cast(bf16x8, wl); }
        f32x16 C;
#pragma unroll
        for (int r = 0; r < 16; ++r) C[r] = carry;
        C = MFMA32(U[0], Lh[0], C); C = MFMA32(U[1], Lh[1], C); C = MFMA32(U[0], Ll[0], C); C = MFMA32(U[1], Ll[1], C);
        bf16x8 pf[2];
#pragma unroll
        for (int c = 0; c < 2; ++c) { u32x4 w;
#pragma unroll
            for (int e = 0; e < 4; ++e) { float a0, a1; { const int r = 8 * c + 2 * e; a0 = __builtin_amdgcn_exp2f((z[r] - C[r]) * LOG2E); a1 = __builtin_amdgcn_exp2f((z[r + 1] - C[r + 1]) * LOG2E);
                    if (diag) { if (!(16 * c + 8 * hl + 2 * e < li)) a0 = 0.f; if (!(16 * c + 8 * hl + 2 * e + 1 < li)) a1 = 0.f; } }
                w[e] = pkbf(a0, a1); }
            pf[c] = __builtin_bit_cast(bf16x8, w); }
        carry = __shfl(C[0], li);
        o0 = MFMA32(vf[0], pf[0], o0); o0 = MFMA32(vf[1], pf[1], o0);
        o1 = MFMA32(vf[2], pf[0], o1); o1 = MFMA32(vf[3], pf[1], o1);
        if (__all(carry > SB_EXIT)) break;
    }
    bf16_t* orow = p + (rowbase + qb * 32 + li) * PC + h * 64 + 4 * hl;
#pragma unroll
    for (int g = 0; g < 4; ++g) {
        u32x2 w0, w1; w0.x = pkbf(o0[4 * g], o0[4 * g + 1]); w0.y = pkbf(o0[4 * g + 2], o0[4 * g + 3]); w1.x = pkbf(o1[4 * g], o1[4 * g + 1]); w1.y = pkbf(o1[4 * g + 2], o1[4 * g + 3]);
        *(u32x2*)(orow + 8 * g) = w0; *(u32x2*)(orow + 32 + 8 * g) = w1; }
}

DI void sgu_item(int l, bf16_t* p, const bf16_t* T, int item, LAS unsigned char* lds, int tid, int wave, int lane) {
    const int g = item & 3, n = (item >> 2) & 31, b = item >> 7;
    const size_t tok0 = (size_t)b * SEQ + n * 128;
    const bf16_t* zv = T + (size_t)512 * M;
    LAS float* red = (LAS float*)lds;
    LAS float* mean = (LAS float*)(lds + 8192);
    LAS float* rstd = (LAS float*)(lds + 8192 + 512);
    {
        float s0 = 0.f, s1 = 0.f, q0 = 0.f, q1 = 0.f;
        const bf16_t* src = zv + (size_t)(wave * 64) * M + tok0 + 2 * lane;
#pragma unroll 1
        for (int jb = 0; jb < 64; jb += 16) {
            unsigned wv[16];
#pragma unroll
            for (int j = 0; j < 16; ++j) wv[j] = *(const unsigned*)(src + (size_t)(jb + j) * M);
            asm volatile("" ::: "memory");
#pragma unroll
            for (int j = 0; j < 16; ++j) { const float a0 = bflo(wv[j]), a1 = bfhi(wv[j]); s0 += a0; s1 += a1; q0 += a0 * a0; q1 += a1 * a1; }
        }
        *(LAS f32x4*)(red + (wave * 64 + lane) * 4) = (f32x4){s0, q0, s1, q1};
    }
    __syncthreads();
    if (tid < 128) { float s = 0.f, q = 0.f;
#pragma unroll
        for (int w = 0; w < 8; ++w) { const f32x2 v = *(LAS f32x2*)(red + (w * 64 + (tid >> 1)) * 4 + (tid & 1) * 2); s += v.x; q += v.y; }
        const float mu = s * (1.0f / 512.0f), var = fmaxf(q * (1.0f / 512.0f) - mu * mu, 0.f);
        mean[tid] = mu; rstd[tid] = 1.0f / sqrtf(var + LN_EPS); }
    __syncthreads();
    const int cblk = wave & 3, th = wave >> 2, hl = lane >> 5, li = lane & 31;
    const int cch = g * 128 + cblk * 32 + li;
    const float lg = INP(4)[l * 512 + cch], lb = INP(5)[l * 512 + cch];
    const bf16_t* arow = zv + (size_t)cch * M + tok0 + 8 * hl;
    const float* wsp = INP(6) + ((size_t)(l * 4 + g) * 128) * 128;
    f32x16 acc0, acc1;
#pragma unroll
    for (int r = 0; r < 16; ++r) { acc0[r] = 0.f; acc1[r] = 0.f; }
#pragma unroll
    for (int hf = 0; hf < 2; ++hf) if (hf == 0 || th) {
        u32x4 raw[4]; f32x4 wv[4][2][2];
#pragma unroll
        for (int k4 = 0; k4 < 4; ++k4) { const int kk = 4 * hf + k4, sb = 16 * kk + 8 * hl;
            raw[k4] = *(const u32x4*)(arow + 16 * kk);
#pragma unroll
            for (int tb = 0; tb < 2; ++tb) { const int t = th * 64 + tb * 32 + li; wv[k4][tb][0] = *(const f32x4*)(wsp + (size_t)t * 128 + sb); wv[k4][tb][1] = *(const f32x4*)(wsp + (size_t)t * 128 + sb + 4); } }
        asm volatile("" ::: "memory");
#pragma unroll
        for (int k4 = 0; k4 < 4; ++k4) { const int kk = 4 * hf + k4, sb = 16 * kk + 8 * hl;
            const f32x4 m0 = *(LAS f32x4*)(mean + sb), m1 = *(LAS f32x4*)(mean + sb + 4), r0 = *(LAS f32x4*)(rstd + sb), r1 = *(LAS f32x4*)(rstd + sb + 4);
            const u32x4 rw = raw[k4]; u32x4 aw;
            aw.x = pkbf((bflo(rw.x) - m0[0]) * r0[0] * lg + lb, (bfhi(rw.x) - m0[1]) * r0[1] * lg + lb);
            aw.y = pkbf((bflo(rw.y) - m0[2]) * r0[2] * lg + lb, (bfhi(rw.y) - m0[3]) * r0[3] * lg + lb);
            aw.z = pkbf((bflo(rw.z) - m1[0]) * r1[0] * lg + lb, (bfhi(rw.z) - m1[1]) * r1[1] * lg + lb);
            aw.w = pkbf((bflo(rw.w) - m1[2]) * r1[2] * lg + lb, (bfhi(rw.w) - m1[3]) * r1[3] * lg + lb);
            const bf16x8 af = __builtin_bit_cast(bf16x8, aw);
#pragma unroll
            for (int tb = 0; tb < 2; ++tb) { const f32x4 w0 = wv[k4][tb][0], w1 = wv[k4][tb][1];
                u32x4 bw; bw.x = pkbf(w0[0], w0[1]); bw.y = pkbf(w0[2], w0[3]); bw.z = pkbf(w1[0], w1[1]); bw.w = pkbf(w1[2], w1[3]);
                const bf16x8 bfr = __builtin_bit_cast(bf16x8, bw);
                if (tb == 0) acc0 = MFMA32(af, bfr, acc0); else acc1 = MFMA32(af, bfr, acc1); } }
    }
#pragma unroll
    for (int tb = 0; tb < 2; ++tb) {
        const int t = th * 64 + tb * 32 + li; const float bs = INP(7)[(l * 4 + g) * 128 + t];
        bf16_t* urow = p + (tok0 + t) * PC + 1024 + g * 128 + cblk * 32 + 4 * hl;
        u32x2 uws[4];
#pragma unroll
        for (int q = 0; q < 4; ++q) uws[q] = *(const u32x2*)(urow + 8 * q);
#pragma unroll
        for (int q = 0; q < 4; ++q) { const u32x2 uw = uws[q];
            float v0, v1, v2, v3;
            if (tb == 0) { v0 = acc0[4 * q]; v1 = acc0[4 * q + 1]; v2 = acc0[4 * q + 2]; v3 = acc0[4 * q + 3]; } else { v0 = acc1[4 * q]; v1 = acc1[4 * q + 1]; v2 = acc1[4 * q + 2]; v3 = acc1[4 * q + 3]; }
            u32x2 ow; ow.x = pkbf(bflo(uw.x) * (v0 + bs), bfhi(uw.x) * (v1 + bs)); ow.y = pkbf(bflo(uw.y) * (v2 + bs), bfhi(uw.y) * (v3 + bs));
            *(u32x2*)(urow + 8 * q) = ow; }
    }
    __syncthreads();
}

DI void conv_phase(int l, bf16_t* p, LAS unsigned char* lds, int gtid, int NGT) {
    const float* cw = INP(8) + (size_t)l * 3 * 512;
    for (int it = gtid; it < M * 64; it += NGT) {
        const int row = it >> 6, c8 = (it & 63) * 8, t = row & (SEQ - 1);
        bf16_t* pr = p + (size_t)row * PC;
        float accv[8];
#pragma unroll
        for (int e = 0; e < 8; ++e) accv[e] = 0.f;
        u32x4 ccv[3], cxv[3];
#pragma unroll
        for (int j = 0; j < 3; ++j) { const int dt = (t - (2 - j) >= 0) ? 2 - j : 0;
            ccv[j] = *(const u32x4*)(pr - (size_t)dt * PC + 2048 + c8); cxv[j] = *(const u32x4*)(pr - (size_t)dt * PC + 2560 + c8); }
        const u32x4 cb = *(const u32x4*)(pr + 1536 + c8);
        asm volatile("" ::: "memory");
#pragma unroll
        for (int j = 0; j < 3; ++j) { const int dt = 2 - j;
            if (t - dt >= 0) {
                const u32x4 cc = ccv[j], cx = cxv[j];
                const f32x4 w0 = *(const f32x4*)(cw + j * 512 + c8), w1 = *(const f32x4*)(cw + j * 512 + c8 + 4);
                accv[0] += w0[0] * bflo(cc.x) * bflo(cx.x); accv[1] += w0[1] * bfhi(cc.x) * bfhi(cx.x); accv[2] += w0[2] * bflo(cc.y) * bflo(cx.y); accv[3] += w0[3] * bfhi(cc.y) * bfhi(cx.y);
                accv[4] += w1[0] * bflo(cc.z) * bflo(cx.z); accv[5] += w1[1] * bfhi(cc.z) * bfhi(cx.z); accv[6] += w1[2] * bflo(cc.w) * bflo(cx.w); accv[7] += w1[3] * bfhi(cc.w) * bfhi(cx.w); } }
        u32x4 o; o.x = pkbf(bflo(cb.x) * accv[0], bfhi(cb.x) * accv[1]); o.y = pkbf(bflo(cb.y) * accv[2], bfhi(cb.y) * accv[3]); o.z = pkbf(bflo(cb.z) * accv[4], bfhi(cb.z) * accv[5]); o.w = pkbf(bflo(cb.w) * accv[6], bfhi(cb.w) * accv[7]);
        *(u32x4*)(pr + 1536 + c8) = o;
    }
}

DI void xattn_wg(const bf16_t* qx, const bf16_t* memK, const bf16_t* memVT, bf16_t* ox, int item, int tid, int wave, int lane, LAS unsigned char* lds) {
    const int b = item >> 6, h = (item >> 4) & 3, qb = (item & 15) * 8 + wave;
    const int hl = lane >> 5, li = lane & 31;
    const size_t qrow = (size_t)b * SEQ + qb * 32 + li;
    bf16x8 qf[16];
#pragma unroll
    for (int kk = 0; kk < 16; ++kk) qf[kk] = *(const bf16x8*)(qx + qrow * D + h * 256 + 16 * kk + 8 * hl);
    const int sr = tid >> 4, sp0 = (tid & 15) * 2;
    const int kperm_sr = (sr & 16) | ((sr & 4) << 1) | ((sr & 8) >> 1) | (sr & 3);
    const bf16_t* kbase = memK + (size_t)(b * 256) * D + h * 256;
    const bf16_t* vbase = memVT + (size_t)(h * 256) * D + b * 256;
    u32x4 st[2], sn[2];
#define XA_LOAD(R, c) do { if ((c) < 8) { _Pragma("unroll") for (int e = 0; e < 2; ++e) R[e] = *(const u32x4*)(kbase + (size_t)((c) * 32 + sr) * D + (sp0 + e) * 8); } \
                           else { _Pragma("unroll") for (int e = 0; e < 2; ++e) R[e] = *(const u32x4*)(vbase + (size_t)(((c) - 8) * 32 + sr) * D + (sp0 + e) * 8); } } while (0)
#define XA_STORE(R, c) do { const int rl = (c) < 8 ? kperm_sr : sr; _Pragma("unroll") for (int e = 0; e < 2; ++e) { const int p = sp0 + e; \
                           *(LAS u32x4*)(lds + ((c) & 1) * 16384 + (((p >> 1) * 64) + (p & 1) * 32 + rl) * 16) = R[e]; } } while (0)
    XA_LOAD(st, 0); XA_STORE(st, 0); XA_LOAD(st, 1);
    __syncthreads();
    f32x16 S[8];
#pragma unroll
    for (int c = 0; c < 8; ++c) {
        XA_LOAD(sn, c + 2);
        f32x16 z;
#pragma unroll
        for (int r = 0; r < 16; ++r) z[r] = 0.f;
        const LAS unsigned char* buf = lds + (c & 1) * 16384 + lane * 16;
#pragma unroll
        for (int kk = 0; kk < 16; ++kk) { const bf16x8 kf = *(const LAS bf16x8*)(buf + kk * 1024); z = MFMA32(kf, qf[kk], z); }
        S[c] = z;
        XA_STORE(st, c + 1);
        __syncthreads();
        st[0] = sn[0]; st[1] = sn[1];
    }
    float mx = -3.0e38f;
#pragma unroll
    for (int kb = 0; kb < 8; ++kb)
#pragma unroll
        for (int r = 0; r < 16; ++r) mx = fmaxf(mx, S[kb][r]);
    mx = fmaxf(mx, __shfl_xor(mx, 32));
    float sum = 0.f;
    bf16x8 pf[16];
#pragma unroll
    for (int kb = 0; kb < 8; ++kb)
#pragma unroll
        for (int c = 0; c < 2; ++c) { u32x4 w;
#pragma unroll
            for (int e = 0; e < 4; ++e) { const float a0 = __builtin_amdgcn_exp2f((S[kb][8 * c + 2 * e] - mx) * LOG2E), a1 = __builtin_amdgcn_exp2f((S[kb][8 * c + 2 * e + 1] - mx) * LOG2E); sum += a0 + a1; w[e] = pkbf(a0, a1); }
            pf[2 * kb + c] = __builtin_bit_cast(bf16x8, w); }
    sum += __shfl_xor(sum, 32);
    const float inv = 1.0f / sum;
    bf16_t* orow = ox + qrow * D + h * 256 + 4 * hl;
#pragma unroll 1
    for (int c = 8; c < 16; ++c) {
        if (c + 2 < 16) XA_LOAD(sn, c + 2);
        f32x16 o;
#pragma unroll
        for (int r = 0; r < 16; ++r) o[r] = 0.f;
        const LAS unsigned char* buf = lds + (c & 1) * 16384 + lane * 16;
#pragma unroll
        for (int s = 0; s < 16; ++s) { const bf16x8 vf = *(const LAS bf16x8*)(buf + s * 1024); o = MFMA32(vf, pf[s], o); }
        const int db = c - 8;
#pragma unroll
        for (int g = 0; g < 4; ++g) { u32x2 w; w.x = pkbf(o[4 * g] * inv, o[4 * g + 1] * inv); w.y = pkbf(o[4 * g + 2] * inv, o[4 * g + 3] * inv); *(u32x2*)(orow + db * 32 + 8 * g) = w; }
        if (c + 1 < 16) XA_STORE(st, c + 1);
        __syncthreads();
        st[0] = sn[0]; st[1] = sn[1];
    }
#undef XA_LOAD
#undef XA_STORE
}

constexpr int RSD_OFF = 131072 + 768, RS_OFF = 131072 + 1024, RS_MAXU = 15;
template <class Prog>
DI void fill_rs(LAS unsigned char* lds, Prog P2, const float* ssp, int tid) {
    LAS int* desc = (LAS int*)(lds + RSD_OFF);
    if (tid == 0) { pg8::UnitX x; int n = 0; while (n < RS_MAXU && P2.next(x)) { desc[n] = P2.rs_base(x); ++n; } desc[RS_MAXU] = n; }
    __syncthreads();
    const int n = desc[RS_MAXU];
    for (int kb = 0; kb < n; kb += 8) {
        f32x4 sv[4][4]; int ok[4];
#pragma unroll
        for (int j = 0; j < 4; ++j) { const int k = kb + 2 * j + (tid >> 8); const int base = k < n ? desc[k] : -1; ok[j] = base >= 0;
            const f32x4* sp = (const f32x4*)(ssp + (size_t)((ok[j] ? base : 0) + (tid & 255)) * 16);
#pragma unroll
            for (int q = 0; q < 4; ++q) sv[j][q] = ok[j] ? sp[q] : (f32x4){0.f, 0.f, 0.f, 0.f}; }
        asm volatile("" ::: "memory");
#pragma unroll
        for (int j = 0; j < 4; ++j) if (ok[j]) { const int k = kb + 2 * j + (tid >> 8); float s = 0.f;
#pragma unroll
            for (int q = 0; q < 4; ++q) s += (sv[j][q][0] + sv[j][q][1]) + (sv[j][q][2] + sv[j][q][3]);
            ((LAS float*)(lds + RS_OFF))[k * 256 + (tid & 255)] = 1.0f / sqrtf(s * (1.0f / D) + RMS_EPS); }
    }
    __syncthreads();
}
struct ProgC {
    unsigned char* ws; LAS unsigned char* lds; int G, c; int j, i, kk; pg8::Unit u; bool have;
    DI int rs_base(const pg8::UnitX& x) const { return (x.job & 1) ? -1 : x.pm * 256; }
    DI void init(unsigned char* ws_, int G_, int c_, LAS unsigned char* lds_) { lds = lds_; kk = 0; ws = ws_; G = G_; c = c_; j = 0; i = 0; pg8::StaticOrder S; S.init(M, D, G, c); have = S.next(0, u); }
    DI bool next(pg8::UnitX& x) {
        if (have && j >= 6) { pg8::StaticOrder S; S.init(M, D, G, c); ++i; j = 0; have = S.next(i, u); }
        if (!have) return false;
        x.pm = u.pm; x.pn = u.pn; x.job = j; x.k = kk; ++kk; ++j; return true; }
    DI pg8::JobP job(int jj) const { const int n = jj >> 1; pg8::JobP p;
        if ((jj & 1) == 0) { p.A = (const bf16_t*)(ws + WS_XB); p.Bt = (const bf16_t*)(ws + WS_WIN) + (size_t)(4096 + n * 1024) * D; p.lda = D; p.ldb = D; p.nt = D / 64; }
        else { const int acol = n == 0 ? 0 : (n == 1 ? 1024 : 1536); p.A = (const bf16_t*)(ws + WS_P) + acol; p.Bt = (const bf16_t*)(ws + WS_WB) + (size_t)n * D * 512; p.lda = PC; p.ldb = 512; p.nt = 512 / 64; }
        return p; }
    DI void epilogue(const f32x4 (&acc)[2][2][4][2], const pg8::UnitX& x, int wr, int wc, int fr, int fq) const {
        pg8::EpiArgs ea{}; const pg8::Unit uu{x.pm, x.pn};
        if ((x.job & 1) == 0) { ea.O = (bf16_t*)(ws + WS_T); ea.ldc = D; ea.ssp = (const float*)(ws + WS_SSP); ea.rstab = x.k < RS_MAXU ? (const LAS float*)(lds + RS_OFF) + x.k * 256 : nullptr; ea.cscale = 1.f; pg8::Epi<pg8::E_GATE> E{ea}; E(acc, uu, wr, wc, fr, fq); }
        else { ea.O = (bf16_t*)(ws + WS_X2); ea.ldc = D; ea.G = (const bf16_t*)(ws + WS_T);
            if (x.job == 1) { pg8::Epi<pg8::E_BR0> E{ea}; E(acc, uu, wr, wc, fr, fq); } else { pg8::Epi<pg8::E_BRN> E{ea}; E(acc, uu, wr, wc, fr, fq); } }
    }
};
struct ProgA {
    unsigned char* ws; LAS unsigned char* lds; int G, c; int jb, i, njobs, kk;
    DI int rs_base(const pg8::UnitX& x) const { return x.job == 0 ? x.pm * 256 : (x.job == 1 ? x.pn * 256 : -1); }
    DI void init(unsigned char* ws_, int G_, int c_, int l, LAS unsigned char* lds_) { lds = lds_; kk = 0; ws = ws_; G = G_; c = c_; jb = 0; i = 0; njobs = l == 0 ? 4 : 2; }
    DI bool next(pg8::UnitX& x) {
        for (; jb < njobs; ++jb, i = 0) {
            pg8::StaticOrder S; pg8::Unit u;
            if (jb == 0) S.init(M, 3072, G, c); else if (jb == 1) S.init(1024, M, G, c); else if (jb == 2) S.init(1024, D, G, (c + 64) % G); else S.init(D, 1024, G, (c + 192) % G);
            if (S.next(i, u)) { x.pm = u.pm; x.pn = u.pn; x.job = jb; x.k = kk; ++kk; ++i; return true; }
        }
        return false;
    }
    DI pg8::JobP job(int jj) const { pg8::JobP p; p.lda = D; p.ldb = D; p.nt = D / 64;
        if (jj == 0) { p.A = (const bf16_t*)(ws + WS_XB); p.Bt = (const bf16_t*)(ws + WS_WIN); }
        else if (jj == 1) { p.A = (const bf16_t*)(ws + WS_WIN) + (size_t)3072 * D; p.Bt = (const bf16_t*)(ws + WS_XB); }
        else if (jj == 2) { p.A = (const bf16_t*)(ws + WS_MB); p.Bt = (const bf16_t*)(ws + WS_WK); }
        else { p.A = (const bf16_t*)(ws + WS_WV); p.Bt = (const bf16_t*)(ws + WS_MB); }
        return p; }
    DI void epilogue(const f32x4 (&acc)[2][2][4][2], const pg8::UnitX& x, int wr, int wc, int fr, int fq) const {
        pg8::EpiArgs ea{}; const pg8::Unit uu{x.pm, x.pn};
        const LAS float* rst = x.k < RS_MAXU ? (const LAS float*)(lds + RS_OFF) + x.k * 256 : nullptr;
        if (x.job == 0) { ea.O = (bf16_t*)(ws + WS_P); ea.ldc = PC; ea.ssp = (const float*)(ws + WS_SSP); ea.rstab = rst; ea.cscale = 1.f; pg8::Epi<pg8::E_INPROJ> E{ea}; E(acc, uu, wr, wc, fr, fq); }
        else if (x.job == 2) { ea.O = (bf16_t*)(ws + WS_MEMK); ea.ldc = D; ea.ssp = nullptr; ea.cscale = 1.f; pg8::Epi<pg8::E_ROWSCALE> E{ea}; E(acc, uu, wr, wc, fr, fq); }
        else { if (x.job == 1) { ea.O = (bf16_t*)(ws + WS_T); ea.ldc = M; ea.ssp = (const float*)(ws + WS_SSP); ea.rstab = rst; } else { ea.O = (bf16_t*)(ws + WS_MEMVT); ea.ldc = 1024; ea.ssp = nullptr; }
            pg8::Epi<pg8::E_TRANS> E{ea}; E(acc, uu, wr, wc, fr, fq); }
    }
};
struct ProgJ {
    unsigned char* ws; LAS unsigned char* lds; int G, c; int jb, i, njobs, kk;
    DI int rs_base(const pg8::UnitX& x) const { return x.job == 0 ? x.pm * 256 : -1; }
    DI void init(unsigned char* ws_, int G_, int c_, int l, LAS unsigned char* lds_) { lds = lds_; kk = 0; ws = ws_; G = G_; c = c_; jb = 0; i = 0; njobs = l == 0 ? 3 : 1; }
    DI bool next(pg8::UnitX& x) {
        for (; jb < njobs; ++jb, i = 0) {
            pg8::StaticOrder S; pg8::Unit u;
            if (jb == 0) S.init(M, 2 * FF, G, c); else if (jb == 1) S.init(1024, D, G, (c + 128) % G); else S.init(D, 1024, G, (c + 96) % G);
            if (S.next(i, u)) { x.pm = u.pm; x.pn = u.pn; x.job = jb; x.k = kk; ++kk; ++i; return true; }
        }
        return false;
    }
    DI pg8::JobP job(int jj) const { pg8::JobP p; p.lda = D; p.ldb = D; p.nt = D / 64;
        if (jj == 0) { p.A = (const bf16_t*)(ws + WS_XB); p.Bt = (const bf16_t*)(ws + WS_WGU); }
        else if (jj == 1) { p.A = (const bf16_t*)(ws + WS_MB1); p.Bt = (const bf16_t*)(ws + WS_WK1); }
        else { p.A = (const bf16_t*)(ws + WS_WV1); p.Bt = (const bf16_t*)(ws + WS_MB1); }
        return p; }
    DI void epilogue(const f32x4 (&acc)[2][2][4][2], const pg8::UnitX& x, int wr, int wc, int fr, int fq) const {
        pg8::EpiArgs ea{}; const pg8::Unit uu{x.pm, x.pn};
        if (x.job == 0) { ea.O = (bf16_t*)(ws + WS_P); ea.ldc = FF; ea.ssp = (const float*)(ws + WS_SSP) + (size_t)2 * M * 16; ea.rstab = x.k < RS_MAXU ? (const LAS float*)(lds + RS_OFF) + x.k * 256 : nullptr; pg8::Epi<pg8::E_SWIGLU> E{ea}; E(acc, uu, wr, wc, fr, fq); }
        else if (x.job == 1) { ea.O = (bf16_t*)(ws + WS_MEMK1); ea.ldc = D; ea.ssp = nullptr; ea.cscale = 1.f; pg8::Epi<pg8::E_ROWSCALE> E{ea}; E(acc, uu, wr, wc, fr, fq); }
        else { ea.O = (bf16_t*)(ws + WS_MEMVT1); ea.ldc = 1024; ea.ssp = nullptr; pg8::Epi<pg8::E_TRANS> E{ea}; E(acc, uu, wr, wc, fr, fq); }
    }
};
#define XB_TMO      128
#define XB_XCNT(j)  (256  + 64 * (j))
#define XB_XSUB(j)  (1280 + 64 * (j))
#define XB_XGEN(j)  (2304 + 64 * (j))
#define XB_TOP      3328
#define XB_TOPGEN   3392
#define XCD_BAR_WORDS 3456
#define XB_SPIN_CAP (1u << 18)

__device__ __forceinline__ unsigned xb_ld(unsigned* p)              { return __hip_atomic_load(p, __ATOMIC_RELAXED, __HIP_MEMORY_SCOPE_AGENT); }
__device__ __forceinline__ unsigned xb_add(unsigned* p, unsigned v) { return __hip_atomic_fetch_add(p, v, __ATOMIC_RELAXED, __HIP_MEMORY_SCOPE_AGENT); }
__device__ __forceinline__ unsigned xb_xcc_id() { return (unsigned)__builtin_amdgcn_s_getreg((3 << 11) | 20) & 0xFu; }
#define XB_SPIN(cond, bar) do { unsigned _sp = 0; while (cond) { __builtin_amdgcn_s_sleep(1); \
    if ((++_sp & 255u) == 0u) { if (xb_ld(&(bar)[XB_TMO])) break; if (_sp > XB_SPIN_CAP) { atomicAdd(&(bar)[XB_TMO], 1u); break; } } } } while (0)

struct XcdBarrier {
    unsigned* bar; unsigned x;
    volatile LAS unsigned* st;
};

__device__ __forceinline__ XcdBarrier xcd_barrier_post(unsigned* bar, volatile LAS unsigned* st) {
    XcdBarrier b; b.bar = bar; b.x = xb_xcc_id(); b.st = st;
    if (threadIdx.x == 0) (void)xb_add(&bar[XB_XCNT(b.x)], 1u);
    return b;
}
__device__ __forceinline__ void xcd_barrier_complete(unsigned* bar, unsigned x, unsigned& nloc, unsigned& nx) {
    const unsigned G = gridDim.x * gridDim.y * gridDim.z;
    unsigned sum, cnt, mine, sp = 0u;
    for (;;) {
        sum = 0u; cnt = 0u; mine = 0u;
#pragma unroll
        for (unsigned j = 0; j < 16; ++j) { const unsigned c = xb_ld(&bar[XB_XCNT(j)]); sum += c; cnt += (c > 0u) ? 1u : 0u; mine = (j == x) ? c : mine; }
        if (sum == G) break;
        __builtin_amdgcn_s_sleep(1);
        if ((++sp & 255u) == 0u) { if (xb_ld(&bar[XB_TMO])) break; if (sp > XB_SPIN_CAP) { atomicAdd(&bar[XB_TMO], 1u); break; } }
    }
    nloc = mine > 0u ? mine : 1u; nx = cnt > 0u ? cnt : 1u;
}

__device__ __forceinline__ void xcd_barrier(const XcdBarrier& b) {
    asm volatile("s_waitcnt vmcnt(0)" ::: "memory");
    __syncthreads();
    if (threadIdx.x == 0) {
        unsigned* bar = b.bar;
        __builtin_amdgcn_s_waitcnt(0);
        unsigned nloc = b.st[0], nx = b.st[1];
        if (nloc == 0u) { xcd_barrier_complete(bar, b.x, nloc, nx); b.st[0] = nloc; b.st[1] = nx; }
        const unsigned old = xb_add(&bar[XB_XSUB(b.x)], 1u);
        const unsigned gen = old / nloc;
        if (old + 1u == (gen + 1u) * nloc) {
            __builtin_amdgcn_fence(__ATOMIC_RELEASE, "agent");
            asm volatile("s_waitcnt vmcnt(0)" ::: "memory");
            const unsigned og = xb_add(&bar[XB_TOP], 1u);
            const unsigned tg = og / nx;
            if (og + 1u == (tg + 1u) * nx) xb_add(&bar[XB_TOPGEN], 1u);
            else XB_SPIN(xb_ld(&bar[XB_TOPGEN]) == tg, bar);
            __builtin_amdgcn_fence(__ATOMIC_ACQUIRE, "agent");
            xb_add(&bar[XB_XGEN(b.x)], 1u);
            asm volatile("s_waitcnt vmcnt(0)" ::: "memory");
        } else {
            XB_SPIN(xb_ld(&bar[XB_XGEN(b.x)]) == gen, bar);
            __builtin_amdgcn_fence(__ATOMIC_ACQUIRE, "agent");
            asm volatile("s_waitcnt vmcnt(0)" ::: "memory");
        }
    }
    __syncthreads();
}

#define WSB(off) ((bf16_t*)(WSP + (off)))
#define WSF(off) ((float*)(WSP + (off)))
__global__ void __launch_bounds__(NTHREADS, 2) fwd_megakernel(Args A_unused) {
    extern __shared__ __attribute__((aligned(16))) unsigned char lds_raw[];
    LAS unsigned char* lds = (LAS unsigned char*)lds_raw;
    cg::grid_group grid = cg::this_grid();
    { const int tid = threadIdx.x;
    if (tid < 24) { const unsigned long long* ka = (const unsigned long long*)__builtin_amdgcn_kernarg_segment_ptr(); *(LAS unsigned long long*)(lds + PTR_OFF + 8 * tid) = ka[tid]; } }
    if (threadIdx.x < 8) ((LAS unsigned*)(lds + PTR_OFF + 256))[threadIdx.x] = 0u;
    __syncthreads();
    if (blockIdx.x == 0) { unsigned* bw = (unsigned*)ldq(lds, 23); for (int w = threadIdx.x; w < XCD_BAR_WORDS; w += NTHREADS) __hip_atomic_store(bw + w, 0u, __ATOMIC_RELAXED, __HIP_MEMORY_SCOPE_AGENT); }
    asm volatile("s_waitcnt vmcnt(0)" ::: "memory");
    __syncthreads();
    grid.sync();
    const XcdBarrier bar = xcd_barrier_post((unsigned*)ldq(lds, 23), (volatile LAS unsigned*)(lds + PTR_OFF + 256));
#define XBAR() do { XcdBarrier b2_ = bar; asm volatile("" : "+s"(b2_.x)); xcd_barrier(b2_); } while (0)
#define FRESH_IDS const int tid = fresh_tid(), lane = tid & 63, wave = __builtin_amdgcn_readfirstlane(tid >> 6); (void)lane; (void)wave
#define GRID_ ((int)gridDim.x)
#define BID_ ((int)blockIdx.x)
#define GW_ (BID_ * NWAVES + wave)
#define NGW_ (GRID_ * NWAVES)
    constexpr size_t SSPB = (size_t)M * 16 * 4;
    using namespace pg8;

    { FRESH_IDS; prep_x(lds, GW_, NGW_, lane); }
    { FRESH_IDS; prep_weights(0, lds, GW_, NGW_, wave, lane); }
    XBAR();
    for (int l = 0; l < DEPTH; ++l) {
        { ProgA PA; PA.init(WSP, GRID_, BID_, l, lds); { FRESH_IDS; fill_rs(lds, PA, WSF(WS_SSP), tid); } gemm_stream(lds, PA); }
        XBAR();
        if (l > 0) { FRESH_IDS; prep_weights(l, lds, GW_, NGW_, wave, lane, 2); __syncthreads(); }
        { FRESH_IDS;
          for (int it0 = BID_; it0 < NBATCH * 32 * 4; it0 += GRID_) { int it = it0;
              if (GRID_ == 256) { const int r = it0 >> 8, bx = it0 & 255, xcd = bx & 7, slot = bx >> 3; it = (r * 64 + xcd * 8 + (slot >> 2)) * 4 + (slot & 3); }
              sgu_item(l, WSB(WS_P), WSB(WS_T), it, lds, tid, wave, lane); } }
        { FRESH_IDS; for (int it = GW_; it < NBATCH * 8 * 128; it += NGW_) sb_attn_item(WSB(WS_P), WSB(WS_T), it, lane); }
        { FRESH_IDS; conv_phase(l, WSB(WS_P), lds, BID_ * NTHREADS + tid, GRID_ * NTHREADS); }
        XBAR();
        { ProgC PCg; PCg.init(WSP, GRID_, BID_, lds); { FRESH_IDS; fill_rs(lds, PCg, WSF(WS_SSP), tid); } gemm_stream(lds, PCg); }
        XBAR();
        {
            StaticOrder S; S.init(M, D, GRID_, BID_);
            EpiArgs ea{}; Gemm g{WSB(WS_X2), WSB(WS_WOUT), M, D, D, D, D}; ea.xb = WSB(WS_XB); ea.sspo = WSF(WS_SSP + SSPB); Epi<E_RESID> E{ea}; gemm_phase(lds, g, S, E);
        }
        XBAR();
        {
            StaticOrder S; S.init(M, D, GRID_, BID_);
            EpiArgs ea{}; Gemm g{WSB(WS_XB), WSB(WS_WQ), M, D, D, D, D}; ea.O = WSB(WS_T); ea.ldc = D; ea.ssp = WSF(WS_SSP + SSPB); ea.cscale = 0.0625f; Epi<E_ROWSCALE> E{ea}; gemm_phase(lds, g, S, E);
            Unit u;
            for (int i = 0; S.next(i, u); ++i) { FRESH_IDS; xattn_wg(WSB(WS_T), WSB(l ? WS_MEMK1 : WS_MEMK), WSB(l ? WS_MEMVT1 : WS_MEMVT), WSB(WS_X2), (u.pm >> 4) * 64 + u.pn * 16 + (u.pm & 15), tid, wave, lane, lds); }
        }
        XBAR();
        {
            StaticOrder S; S.init(M, D, GRID_, BID_);
            EpiArgs ea{}; Gemm g{WSB(WS_X2), WSB(WS_WOX), M, D, D, D, D}; ea.xb = WSB(WS_XB); ea.sspo = WSF(WS_SSP + 2 * SSPB); Epi<E_RESID> E{ea}; gemm_phase(lds, g, S, E);
        }
        XBAR();
        { ProgJ PJ; PJ.init(WSP, GRID_, BID_, l, lds); { FRESH_IDS; fill_rs(lds, PJ, WSF(WS_SSP + 2 * SSPB), tid); } gemm_stream(lds, PJ); }
        XBAR();
        {
            StaticOrder S; S.init(M, D, GRID_, BID_);
            EpiArgs ea{}; Gemm g{WSB(WS_P), WSB(WS_WD), M, D, FF, FF, FF}; ea.xb = WSB(WS_XB); ea.sspo = WSF(WS_SSP); Epi<E_RESID> E{ea}; gemm_phase(lds, g, S, E);
        }
        if (l + 1 < DEPTH) { FRESH_IDS; prep_weights(l + 1, lds, GW_, NGW_, wave, lane, 1); }
        XBAR();
    }
    { FRESH_IDS; final_norm(lds, GW_, NGW_, lane); }
}

extern "C" void kernel_launch(void* const* d_in, const int* in_sizes, int n_in, void* d_out, int out_size, void* d_ws, size_t ws_size, hipStream_t stream) {
    static int grid = 0;
    if (grid == 0) {
        if (n_in != 22 || in_sizes[0] != M * D || out_size != M * D || ws_size < WS_END) { fprintf(stderr, "kernel_launch: unexpected shapes (n_in %d, in0 %d, out %d, ws %zu)\n", n_in, n_in > 0 ? in_sizes[0] : -1, out_size, ws_size); grid = -1; return; }
        int dev = 0, cus = 0, per_cu = 0;
        hipGetDevice(&dev); hipDeviceGetAttribute(&cus, hipDeviceAttributeMultiprocessorCount, dev);
        hipFuncSetAttribute((const void*)fwd_megakernel, hipFuncAttributeMaxDynamicSharedMemorySize, LDS_BYTES);
        hipOccupancyMaxActiveBlocksPerMultiprocessor(&per_cu, (const void*)fwd_megakernel, NTHREADS, LDS_BYTES);
        if (per_cu < 1) { fprintf(stderr, "kernel_launch: occupancy query says %d blocks per CU\n", per_cu); per_cu = 1; }
        (void)hipGetLastError();
        grid = cus;
    }
    if (grid < 0) return;
    Args a{};
    for (int i = 0; i < 22; ++i) a.in[i] = (const float*)d_in[i];
    a.out = (float*)d_out; a.ws = (unsigned char*)d_ws;
    void* args[] = {&a};
    hipError_t e = hipLaunchCooperativeKernel((const void*)fwd_megakernel, dim3(grid), dim3(NTHREADS), args, LDS_BYTES, stream);
    if (e != hipSuccess) fprintf(stderr, "cooperative launch failed: %s (grid %d)\n", hipGetErrorString(e), grid);
}
```

```cpp
#include <hip/hip_runtime.h>
#include <hip/hip_cooperative_groups.h>
#include <cstdio>
#include <cstdint>
namespace cg = cooperative_groups;

#define LAS __attribute__((address_space(3)))
typedef unsigned short bf16_t;
typedef short bf16x8 __attribute__((ext_vector_type(8)));
typedef float f32x4 __attribute__((ext_vector_type(4)));
typedef float f32x2 __attribute__((ext_vector_type(2)));
typedef float f32x16 __attribute__((ext_vector_type(16)));
typedef unsigned u32x4 __attribute__((ext_vector_type(4)));
typedef unsigned u32x2 __attribute__((ext_vector_type(2)));
typedef __bf16 bf16x2n __attribute__((ext_vector_type(2)));

#define DI __device__ __forceinline__
DI unsigned pkbf(float lo, float hi) { f32x2 v = {lo, hi}; bf16x2n b = __builtin_convertvector(v, bf16x2n); return __builtin_bit_cast(unsigned, b); }
DI float bflo(unsigned u) { return __uint_as_float(u << 16); }
DI float bfhi(unsigned u) { return __uint_as_float(u & 0xffff0000u); }
DI int fresh_tid() { int t = threadIdx.x; asm volatile("" : "+v"(t)); return t; }
#define MFMA32(a, b, c) __builtin_amdgcn_mfma_f32_32x32x16_bf16((a), (b), (c), 0, 0, 0)

constexpr int M = 16384, D = 1024, SEQ = 4096, NBATCH = 4, DEPTH = 2;
constexpr int PC = 3072;
constexpr int FF = 2816;
constexpr int INC = 7168;
constexpr float RMS_EPS = 1e-6f, LN_EPS = 1e-5f;
constexpr float LOG2E = 1.4426950408889634f, LN2 = 0.6931471805599453f;
constexpr float SB_EXIT = 110.0f;

constexpr size_t MiB = (size_t)1 << 20;
constexpr size_t WS_WIN = 1 * MiB;
constexpr size_t WS_WB = 15 * MiB;
constexpr size_t WS_WOUT = 18 * MiB, WS_WQ = 20 * MiB, WS_WK = 22 * MiB, WS_WV = 24 * MiB, WS_WOX = 26 * MiB;
constexpr size_t WS_WGU = 28 * MiB;
constexpr size_t WS_WD = 39 * MiB;
constexpr size_t WS_MB = 45 * MiB, WS_MEMK = 47 * MiB, WS_MEMVT = 49 * MiB;
constexpr size_t WS_XB = 51 * MiB;
constexpr size_t WS_P = 83 * MiB;
constexpr size_t WS_T = 179 * MiB;
constexpr size_t WS_X2 = 211 * MiB;
constexpr size_t WS_SSP = 243 * MiB;
constexpr size_t WS_WK1 = 246 * MiB, WS_WV1 = 248 * MiB, WS_MB1 = 250 * MiB, WS_MEMK1 = 252 * MiB, WS_MEMVT1 = 254 * MiB;
constexpr size_t WS_END = 256 * MiB;

namespace pg8 {
constexpr int BM = 256, BK = 64, HALF = 128, HTB = HALF * BK * 2, STAGE_BYTES = 8 * HTB, NXCD = 8, WGM = 8;
DI int lds_byte(int r, int c) { const int st = (r >> 4) * 2 + (c >> 5), rr = r & 15, cc = c & 31, ob = rr * 64 + cc * 2; return st * 1024 + (ob ^ (((ob >> 9) & 1) << 5)); }
DI void stage_rc(int b, int& R, int& C) { const int st = b / 1024, sb = b % 1024, swz = sb ^ (((sb >> 9) & 1) << 5); R = (st >> 1) * 16 + swz / 64; C = (st & 1) * 32 + (swz % 64) / 2; }
DI int perm32(int rho) { const int n = rho >> 4, i = rho & 15; return 8 * (i >> 2) + 4 * n + (i & 3); }

struct Unit { int pm, pn; };
struct Gemm { const bf16_t* A; const bf16_t* Bt; int M, N, K, lda, ldb; };

struct StaticOrder {
    int nM, nN, nwg, G, c;
    DI void init(int M_, int N_, int G_, int c_) { nM = M_ / BM; nN = N_ / BM; nwg = nM * nN; G = G_; c = c_; }
    DI bool next(int i, Unit& u) const {
        const long L = (long)i * G + c; if (L >= nwg) return false;
        int wgid = (int)L; { const int q = nwg / NXCD, r = nwg % NXCD, xcd = wgid % NXCD, off = wgid / NXCD; wgid = (xcd < r ? xcd * (q + 1) : r * (q + 1) + (xcd - r) * q) + off; }
        const int nig = WGM * nN, gid = wgid / nig, fm = gid * WGM, gsz = (nM - fm) < WGM ? (nM - fm) : WGM;
        u.pm = fm + ((wgid % nig) % gsz); u.pn = (wgid % nig) / gsz; return true;
    }
};

DI f32x2 gelu_pk(f32x2 v) {
    const f32x2 av = __builtin_elementwise_abs(v), d = av * 0.2316418882f + 1.0f;
    f32x2 t; t.x = __builtin_amdgcn_rcpf(d.x); t.y = __builtin_amdgcn_rcpf(d.y);
    f32x2 q = t * 0.5307027145f + (-0.7265760135f); q = q * t + 0.7107068705f; q = q * t + (-0.142248368f); q = q * t + 0.127414796f; q = q * t;
    const f32x2 s = (v * v) * (-0.72134752044f);
    f32x2 e; e.x = __builtin_amdgcn_exp2f(s.x); e.y = __builtin_amdgcn_exp2f(s.y);
    const f32x2 m = v * (q * e), r = v - m;
    f32x2 o; o.x = v.x < 0.f ? m.x : r.x; o.y = v.y < 0.f ? m.y : r.y; return o;
}
DI f32x4 gelu4(f32x4 v) { f32x2 a = gelu_pk((f32x2){v[0], v[1]}), b = gelu_pk((f32x2){v[2], v[3]}); return (f32x4){a.x, a.y, b.x, b.y}; }
DI float sigmoidf_(float x) { return __builtin_amdgcn_rcpf(1.0f + __builtin_amdgcn_exp2f(-x * LOG2E)); }
DI f32x4 sigmoid4(f32x4 v) { return (f32x4){sigmoidf_(v[0]), sigmoidf_(v[1]), sigmoidf_(v[2]), sigmoidf_(v[3])}; }

DI float row_rs(const float* ssp, int row, int fq) {
    const f32x4 v = *(const f32x4*)(ssp + (size_t)row * 16 + fq * 4);
    float s = (v[0] + v[1]) + (v[2] + v[3]);
    s += __shfl_xor(s, 16); s += __shfl_xor(s, 32);
    return 1.0f / sqrtf(s * (1.0f / D) + RMS_EPS);
}

DI void row_rs8(const float* ssp, int row0, int fq, float (&rs)[2][4]) {
    f32x4 v[2][4];
#pragma unroll
    for (int ai = 0; ai < 2; ++ai)
#pragma unroll
        for (int m = 0; m < 4; ++m) v[ai][m] = *(const f32x4*)(ssp + (size_t)(row0 + ai * HALF + m * 16) * 16 + fq * 4);
    asm volatile("" ::: "memory");
#pragma unroll
    for (int ai = 0; ai < 2; ++ai)
#pragma unroll
        for (int m = 0; m < 4; ++m) { float s = (v[ai][m][0] + v[ai][m][1]) + (v[ai][m][2] + v[ai][m][3]); s += __shfl_xor(s, 16); s += __shfl_xor(s, 32); rs[ai][m] = 1.0f / sqrtf(s * (1.0f / D) + RMS_EPS); }
}

DI void row_rs8_lds(const LAS float* tab, int wr, int fr, float (&rs)[2][4]) {
#pragma unroll
    for (int ai = 0; ai < 2; ++ai)
#pragma unroll
        for (int m = 0; m < 4; ++m) rs[ai][m] = tab[ai * HALF + wr * 64 + m * 16 + fr];
}

enum { E_INPROJ = 0, E_TRANS = 1, E_GATE = 2, E_BR0 = 3, E_BRN = 4, E_RESID = 5, E_ROWSCALE = 6, E_SWIGLU = 7 };
struct EpiArgs {
    bf16_t* O; int ldc;
    const float* ssp;
    float cscale;
    const float* xsrc; float* xdst; bf16_t* xb; float* sspo;
    const bf16_t* G;
    const LAS float* rstab;
};
template <int MODE> struct Epi {
    static constexpr bool PERM = true;
    EpiArgs a;
    DI void store8(bf16_t* p, f32x4 v0, f32x4 v1) const { u32x4 w; w.x = pkbf(v0[0], v0[1]); w.y = pkbf(v0[2], v0[3]); w.z = pkbf(v1[0], v1[1]); w.w = pkbf(v1[2], v1[3]); *(u32x4*)p = w; }
    DI void operator()(const f32x4 (&acc)[2][2][4][2], const Unit& u, int wr, int wc, int fr, int fq) const {
        const int row0 = u.pm * BM + wr * 64 + fr, col0 = u.pn * BM + wc * 32 + 8 * fq;
        if constexpr (MODE == E_TRANS) {
            float rsc[2][8];
            if (a.rstab) {
#pragma unroll
                for (int bj = 0; bj < 2; ++bj) { const f32x4 t0 = *(const LAS f32x4*)(a.rstab + bj * HALF + wc * 32 + 8 * fq), t1 = *(const LAS f32x4*)(a.rstab + bj * HALF + wc * 32 + 8 * fq + 4);
                    rsc[bj][0] = t0[0]; rsc[bj][1] = t0[1]; rsc[bj][2] = t0[2]; rsc[bj][3] = t0[3]; rsc[bj][4] = t1[0]; rsc[bj][5] = t1[1]; rsc[bj][6] = t1[2]; rsc[bj][7] = t1[3]; }
            } else if (a.ssp) {
                const int lane = fq * 16 + fr, tok = u.pn * BM + (lane >> 5) * HALF + wc * 32 + (lane & 31);
                const f32x4* sp = (const f32x4*)(a.ssp + (size_t)tok * 16);
                const f32x4 s0 = sp[0], s1 = sp[1], s2 = sp[2], s3 = sp[3];
                const float s = ((s0[0] + s0[1]) + (s0[2] + s0[3])) + ((s1[0] + s1[1]) + (s1[2] + s1[3])) + ((s2[0] + s2[1]) + (s2[2] + s2[3])) + ((s3[0] + s3[1]) + (s3[2] + s3[3]));
                const float rs = 1.0f / sqrtf(s * (1.0f / D) + RMS_EPS);
#pragma unroll
                for (int bj = 0; bj < 2; ++bj)
#pragma unroll
                    for (int e = 0; e < 8; ++e) rsc[bj][e] = __shfl(rs, bj * 32 + 8 * fq + e);
            } else {
#pragma unroll
                for (int bj = 0; bj < 2; ++bj)
#pragma unroll
                    for (int e = 0; e < 8; ++e) rsc[bj][e] = 1.0f;
            }
            const bool act = a.ssp != nullptr && u.pm >= 2;
#pragma unroll
            for (int ai = 0; ai < 2; ++ai)
#pragma unroll
                for (int m = 0; m < 4; ++m) { bf16_t* rowp = a.O + (size_t)(row0 + ai * HALF + m * 16) * a.ldc + col0;
#pragma unroll
                    for (int bj = 0; bj < 2; ++bj) {
                        f32x4 v0 = acc[ai][bj][m][0], v1 = acc[ai][bj][m][1];
                        v0 = v0 * (f32x4){rsc[bj][0], rsc[bj][1], rsc[bj][2], rsc[bj][3]}; v1 = v1 * (f32x4){rsc[bj][4], rsc[bj][5], rsc[bj][6], rsc[bj][7]};
                        if (act) { v0 = gelu4(v0); v1 = gelu4(v1); }
                        store8(rowp + bj * HALF, v0, v1); } }
        } else if constexpr (MODE == E_RESID) {
#pragma unroll
            for (int ai = 0; ai < 2; ++ai) {
                u32x4 xw[4][2];
#pragma unroll
                for (int m = 0; m < 4; ++m)
#pragma unroll
                    for (int bj = 0; bj < 2; ++bj) xw[m][bj] = *(const u32x4*)(a.xb + (size_t)(row0 + ai * HALF + m * 16) * D + col0 + bj * HALF);
                asm volatile("" ::: "memory");
#pragma unroll
                for (int m = 0; m < 4; ++m) { const int row = row0 + ai * HALF + m * 16; const size_t off = (size_t)row * D + col0; float ss = 0.f;
#pragma unroll
                    for (int bj = 0; bj < 2; ++bj) { const u32x4 w = xw[m][bj];
                        const f32x4 v0 = (f32x4){bflo(w.x), bfhi(w.x), bflo(w.y), bfhi(w.y)} + acc[ai][bj][m][0], v1 = (f32x4){bflo(w.z), bfhi(w.z), bflo(w.w), bfhi(w.w)} + acc[ai][bj][m][1];
                        store8(a.xb + off + bj * HALF, v0, v1);
                        ss += (v0[0] * v0[0] + v0[1] * v0[1]) + (v0[2] * v0[2] + v0[3] * v0[3]) + (v1[0] * v1[0] + v1[1] * v1[1]) + (v1[2] * v1[2] + v1[3] * v1[3]); }
                    ss += __shfl_xor(ss, 16); ss += __shfl_xor(ss, 32);
                    if (fq == 0) a.sspo[(size_t)row * 16 + u.pn * 4 + wc] = ss; }
            }
        } else if constexpr (MODE == E_SWIGLU) {
            const int ocol = u.pn * HALF + wc * 32 + 8 * fq;
            float rs8[2][4]; if (a.rstab) row_rs8_lds(a.rstab, wr, fr, rs8); else row_rs8(a.ssp, row0, fq, rs8);
#pragma unroll
            for (int ai = 0; ai < 2; ++ai)
#pragma unroll
                for (int m = 0; m < 4; ++m) { const int row = row0 + ai * HALF + m * 16; const float rs = rs8[ai][m];
                    const f32x4 g0 = acc[ai][0][m][0] * rs, g1 = acc[ai][0][m][1] * rs, u0 = acc[ai][1][m][0] * rs, u1 = acc[ai][1][m][1] * rs;
                    store8(a.O + (size_t)row * a.ldc + ocol, g0 * sigmoid4(g0) * u0, g1 * sigmoid4(g1) * u1); }
        } else {
            float sc = a.cscale; bool gelu = false;
            if constexpr (MODE == E_INPROJ) { sc = (u.pn < 2) ? 0.125f : 1.0f; gelu = (u.pn == 4 || u.pn == 5); }
            if constexpr (MODE == E_INPROJ || MODE == E_GATE || MODE == E_ROWSCALE) {
                float rs8[2][4];
                if (a.rstab) row_rs8_lds(a.rstab, wr, fr, rs8); else if (a.ssp) row_rs8(a.ssp, row0, fq, rs8); else {
#pragma unroll
                    for (int ai = 0; ai < 2; ++ai)
#pragma unroll
                        for (int m = 0; m < 4; ++m) rs8[ai][m] = 1.0f; }
#pragma unroll
                for (int ai = 0; ai < 2; ++ai)
#pragma unroll
                    for (int m = 0; m < 4; ++m) { const int row = row0 + ai * HALF + m * 16; const float rs = sc * rs8[ai][m];
#pragma unroll
                        for (int bj = 0; bj < 2; ++bj) { const size_t off = (size_t)row * a.ldc + col0 + bj * HALF;
                            f32x4 v0 = acc[ai][bj][m][0] * rs, v1 = acc[ai][bj][m][1] * rs;
                            if constexpr (MODE == E_INPROJ) { if (gelu) { v0 = gelu4(v0); v1 = gelu4(v1); } }
                            else if constexpr (MODE == E_GATE) { v0 = sigmoid4(v0); v1 = sigmoid4(v1); }
                            store8(a.O + off, v0, v1); } }
            } else {
#pragma unroll
                for (int ai = 0; ai < 2; ++ai) {
                    u32x4 gw[4][2], pw[4][2];
#pragma unroll
                    for (int m = 0; m < 4; ++m)
#pragma unroll
                        for (int bj = 0; bj < 2; ++bj) { const size_t off = (size_t)(row0 + ai * HALF + m * 16) * a.ldc + col0 + bj * HALF;
                            gw[m][bj] = *(const u32x4*)(a.G + off); if constexpr (MODE == E_BRN) pw[m][bj] = *(const u32x4*)(a.O + off); }
                    asm volatile("" ::: "memory");
#pragma unroll
                    for (int m = 0; m < 4; ++m)
#pragma unroll
                        for (int bj = 0; bj < 2; ++bj) { const size_t off = (size_t)(row0 + ai * HALF + m * 16) * a.ldc + col0 + bj * HALF; const u32x4 g = gw[m][bj];
                            f32x4 v0 = acc[ai][bj][m][0] * (f32x4){bflo(g.x), bfhi(g.x), bflo(g.y), bfhi(g.y)}, v1 = acc[ai][bj][m][1] * (f32x4){bflo(g.z), bfhi(g.z), bflo(g.w), bfhi(g.w)};
                            if constexpr (MODE == E_BRN) { const u32x4 q = pw[m][bj];
                                v0 = v0 + (f32x4){bflo(q.x), bfhi(q.x), bflo(q.y), bfhi(q.y)}; v1 = v1 + (f32x4){bflo(q.z), bfhi(q.z), bflo(q.w), bfhi(q.w)}; }
                            store8(a.O + off, v0, v1); }
                }
            }
        }
    }
};

template <class EpiT>
DI void gemm_phase(LAS unsigned char* lds, const Gemm g, const StaticOrder& S, const EpiT& E) {
    const int tid = fresh_tid(), wid = __builtin_amdgcn_readfirstlane(tid >> 6), lane = tid & 63, wr = wid >> 2, wc = wid & 3, fr = lane & 15, fq = lane >> 4;
    const int nt = g.K / BK;
    unsigned voffA[2], voffB[2];
#pragma unroll
    for (int i = 0; i < 2; ++i) { int R, C; stage_rc(tid * 16 + i * 8192, R, C); const int Rb = EpiT::PERM ? ((R & ~31) + perm32(R & 31)) : R;
        voffA[i] = (unsigned)(R * g.lda + C) * 2u; voffB[i] = (unsigned)(Rb * g.ldb + C) * 2u; }
    const size_t kstep = (size_t)(BK * 2);
    const size_t hstepA = (size_t)HALF * g.lda * 2, hstepB = (size_t)HALF * g.ldb * 2;
    const size_t tstepA = 2 * hstepA, tstepB = 2 * hstepB;
    const unsigned ldsw = (unsigned)wid * 1024u;
    const int aoff = lds_byte(wr * 64 + fr, fq * 8), boff = lds_byte(wc * 32 + fr, fq * 8);
#define PG8_SA(b, h) (((b) * 2 + (h)) * HTB)
#define PG8_SB(b, h) ((4 + (b) * 2 + (h)) * HTB)
#define PG8_STAGE(bufoff, gbase, voff) do { _Pragma("unroll") for (int _i = 0; _i < 2; ++_i) \
        __builtin_amdgcn_global_load_lds((const unsigned*)((const char*)(gbase) + (voff)[_i]), (LAS unsigned*)(lds + (bufoff) + ldsw + _i * 8192), 16, 0, 0); } while (0)
#define PG8_LDA(dst, b, h) do { _Pragma("unroll") for (int m = 0; m < 4; ++m) _Pragma("unroll") for (int k = 0; k < 2; ++k) dst[m][k] = *(const LAS bf16x8*)(lds + PG8_SA(b, h) + aoff + m * 2048 + k * 1024); } while (0)
#define PG8_LDB(dst, b, h) do { _Pragma("unroll") for (int n = 0; n < 2; ++n) _Pragma("unroll") for (int k = 0; k < 2; ++k) dst[n][k] = *(const LAS bf16x8*)(lds + PG8_SB(b, h) + boff + n * 2048 + k * 1024); } while (0)
#define PG8_MMA(ai, bj, At, Bt) do { __builtin_amdgcn_s_setprio(1); _Pragma("unroll") for (int m = 0; m < 4; ++m) _Pragma("unroll") for (int n = 0; n < 2; ++n) _Pragma("unroll") for (int k = 0; k < 2; ++k) \
        acc[ai][bj][m][n] = __builtin_amdgcn_mfma_f32_16x16x32_bf16(Bt[n][k], At[m][k], acc[ai][bj][m][n], 0, 0, 0); __builtin_amdgcn_s_setprio(0); } while (0)
#define PG8_WAIT_V(n) asm volatile("s_waitcnt vmcnt(" #n ")" ::: "memory")
#define PG8_WAIT_L(n) asm volatile("s_waitcnt lgkmcnt(" #n ")" ::: "memory")
#define PG8_BAR __builtin_amdgcn_s_barrier()
#define PG8_SCHED __builtin_amdgcn_sched_barrier(0)
    Unit cur, nxt; int ui = 0;
    if (!S.next(0, cur)) return;
    f32x4 acc[2][2][4][2];
#pragma unroll
    for (int a = 0; a < 2; ++a)
#pragma unroll
        for (int b = 0; b < 2; ++b)
#pragma unroll
            for (int m = 0; m < 4; ++m)
#pragma unroll
                for (int n = 0; n < 2; ++n) acc[a][b][m][n] = (f32x4){0.f, 0.f, 0.f, 0.f};
    bf16x8 At[4][2], B0[2][2], B1[2][2];
    const char* cA = (const char*)g.A + (size_t)cur.pm * tstepA; const char* cB = (const char*)g.Bt + (size_t)cur.pn * tstepB;
    PG8_STAGE(PG8_SB(0, 0), cB, voffB); PG8_STAGE(PG8_SB(0, 1), cB + hstepB, voffB); PG8_STAGE(PG8_SA(0, 0), cA, voffA); PG8_STAGE(PG8_SA(0, 1), cA + hstepA, voffA);
    if (wr == 1) PG8_BAR;
    PG8_WAIT_V(2); PG8_BAR;
    PG8_STAGE(PG8_SB(1, 0), cB + kstep, voffB); PG8_STAGE(PG8_SA(1, 0), cA + kstep, voffA); PG8_STAGE(PG8_SB(1, 1), cB + hstepB + kstep, voffB);
    PG8_WAIT_V(6); PG8_BAR;
    for (;;) {
        const bool has_next = S.next(ui + 1, nxt);
        const char* nA = has_next ? (const char*)g.A + (size_t)nxt.pm * tstepA : cA; const char* nB = has_next ? (const char*)g.Bt + (size_t)nxt.pn * tstepB : cB;
        for (int t = 0; t < nt; t += 2) {
            const bool last = (t == nt - 2);
            const char* a1 = cA + (size_t)(t + 1) * kstep;
            const char* a2 = last ? nA : cA + (size_t)(t + 2) * kstep; const char* b2 = last ? nB : cB + (size_t)(t + 2) * kstep;
            const char* a3 = a2 + kstep; const char* b3 = b2 + kstep;
            PG8_LDB(B0, 0, 0); PG8_LDB(B1, 0, 1); PG8_SCHED; PG8_LDA(At, 0, 0); PG8_STAGE(PG8_SA(1, 1), a1 + hstepA, voffA);
            PG8_WAIT_V(8); PG8_WAIT_L(0); PG8_BAR; PG8_MMA(0, 0, At, B0); PG8_MMA(0, 1, At, B1); PG8_BAR; PG8_SCHED;
            PG8_LDA(At, 0, 1); PG8_STAGE(PG8_SB(0, 0), b2, voffB); PG8_STAGE(PG8_SB(0, 1), b2 + hstepB, voffB); PG8_STAGE(PG8_SA(0, 0), a2, voffA);
            PG8_WAIT_V(8); PG8_WAIT_L(0); PG8_BAR; PG8_MMA(1, 0, At, B0); PG8_MMA(1, 1, At, B1); PG8_BAR; PG8_SCHED;
            PG8_LDB(B0, 1, 0); PG8_LDB(B1, 1, 1); PG8_SCHED; PG8_LDA(At, 1, 0); PG8_STAGE(PG8_SA(0, 1), a2 + hstepA, voffA);
            PG8_WAIT_V(8); PG8_WAIT_L(0); PG8_BAR; PG8_MMA(0, 0, At, B0); PG8_MMA(0, 1, At, B1); PG8_BAR; PG8_SCHED;
            PG8_LDA(At, 1, 1); PG8_STAGE(PG8_SB(1, 0), b3, voffB); PG8_STAGE(PG8_SB(1, 1), b3 + hstepB, voffB); PG8_STAGE(PG8_SA(1, 0), a3, voffA);
            PG8_WAIT_V(8); PG8_WAIT_L(0); PG8_BAR; PG8_MMA(1, 0, At, B0); PG8_MMA(1, 1, At, B1); PG8_BAR; PG8_SCHED;
        }
        if (wr == 0) PG8_BAR;
        E(acc, cur, wr, wc, fr, fq);
        if (!has_next) break;
#pragma unroll
        for (int a = 0; a < 2; ++a)
#pragma unroll
            for (int b = 0; b < 2; ++b)
#pragma unroll
                for (int m = 0; m < 4; ++m)
#pragma unroll
                    for (int n = 0; n < 2; ++n) acc[a][b][m][n] = (f32x4){0.f, 0.f, 0.f, 0.f};
        cur = nxt; cA = nA; cB = nB; ++ui;
        if (wr == 1) PG8_BAR;
    }
    PG8_WAIT_V(0);
    PG8_BAR;

}

struct UnitX { int pm, pn, job, k; };
struct JobP { const bf16_t* A; const bf16_t* Bt; int lda, ldb, nt; };
template <class Prog>
DI void gemm_stream(LAS unsigned char* lds, Prog& P) {
    const int tid = fresh_tid(), wid = __builtin_amdgcn_readfirstlane(tid >> 6), lane = tid & 63, wr = wid >> 2, wc = wid & 3, fr = lane & 15, fq = lane >> 4;
    const size_t kstep = (size_t)(BK * 2);
    const unsigned ldsw = (unsigned)wid * 1024u;
    const int aoff = lds_byte(wr * 64 + fr, fq * 8), boff = lds_byte(wc * 32 + fr, fq * 8);
#define PG8_VOFF(vA, vB, j) do { _Pragma("unroll") for (int _i = 0; _i < 2; ++_i) { int sR_, sC_; stage_rc(tid * 16 + _i * 8192, sR_, sC_); const int sRb_ = (sR_ & ~31) + perm32(sR_ & 31); \
        vA[_i] = (unsigned)(sR_ * (j).lda + sC_) * 2u; vB[_i] = (unsigned)(sRb_ * (j).ldb + sC_) * 2u; } } while (0)
    UnitX cur, nxt;
    if (!P.next(cur)) return;
    JobP jc = P.job(cur.job);
    unsigned voffA[2], voffB[2], voffAn[2], voffBn[2];
    PG8_VOFF(voffA, voffB, jc);
    unsigned hstepA = (unsigned)(HALF * jc.lda * 2), hstepB = (unsigned)(HALF * jc.ldb * 2), hstepAn, hstepBn;
    int nt = jc.nt;
    f32x4 acc[2][2][4][2];
#pragma unroll
    for (int a = 0; a < 2; ++a)
#pragma unroll
        for (int b = 0; b < 2; ++b)
#pragma unroll
            for (int m = 0; m < 4; ++m)
#pragma unroll
                for (int n = 0; n < 2; ++n) acc[a][b][m][n] = (f32x4){0.f, 0.f, 0.f, 0.f};
    bf16x8 At[4][2], B0[2][2], B1[2][2];
    const char* cA = (const char*)jc.A + (size_t)cur.pm * 2 * hstepA; const char* cB = (const char*)jc.Bt + (size_t)cur.pn * 2 * hstepB;
    PG8_STAGE(PG8_SB(0, 0), cB, voffB); PG8_STAGE(PG8_SB(0, 1), cB + hstepB, voffB); PG8_STAGE(PG8_SA(0, 0), cA, voffA); PG8_STAGE(PG8_SA(0, 1), cA + hstepA, voffA);
    if (wr == 1) PG8_BAR;
    PG8_WAIT_V(2); PG8_BAR;
    PG8_STAGE(PG8_SB(1, 0), cB + kstep, voffB); PG8_STAGE(PG8_SA(1, 0), cA + kstep, voffA); PG8_STAGE(PG8_SB(1, 1), cB + hstepB + kstep, voffB);
    PG8_WAIT_V(6); PG8_BAR;
    for (;;) {
        const bool has_next = P.next(nxt);
        const char* nA = cA; const char* nB = cB; int ntn = nt;
        hstepAn = hstepA; hstepBn = hstepB; voffAn[0] = voffA[0]; voffAn[1] = voffA[1]; voffBn[0] = voffB[0]; voffBn[1] = voffB[1];
        if (has_next) { const JobP jn = P.job(nxt.job); PG8_VOFF(voffAn, voffBn, jn); hstepAn = (unsigned)(HALF * jn.lda * 2); hstepBn = (unsigned)(HALF * jn.ldb * 2); ntn = jn.nt;
            nA = (const char*)jn.A + (size_t)nxt.pm * 2 * hstepAn; nB = (const char*)jn.Bt + (size_t)nxt.pn * 2 * hstepBn; }
        for (int t = 0; t < nt; t += 2) {
            const bool last = (t == nt - 2);
            const char* a1 = cA + (size_t)(t + 1) * kstep;
            const char* a2 = last ? nA : cA + (size_t)(t + 2) * kstep; const char* b2 = last ? nB : cB + (size_t)(t + 2) * kstep;
            const char* a3 = a2 + kstep; const char* b3 = b2 + kstep;
            const unsigned hA2 = last ? hstepAn : hstepA, hB2 = last ? hstepBn : hstepB;
            unsigned vA2[2], vB2[2];
            vA2[0] = last ? voffAn[0] : voffA[0]; vA2[1] = last ? voffAn[1] : voffA[1]; vB2[0] = last ? voffBn[0] : voffB[0]; vB2[1] = last ? voffBn[1] : voffB[1];
            PG8_LDB(B0, 0, 0); PG8_LDB(B1, 0, 1); PG8_SCHED; PG8_LDA(At, 0, 0); PG8_STAGE(PG8_SA(1, 1), a1 + hstepA, voffA);
            PG8_WAIT_V(8); PG8_WAIT_L(0); PG8_BAR; PG8_MMA(0, 0, At, B0); PG8_MMA(0, 1, At, B1); PG8_BAR; PG8_SCHED;
            PG8_LDA(At, 0, 1); PG8_STAGE(PG8_SB(0, 0), b2, vB2); PG8_STAGE(PG8_SB(0, 1), b2 + hB2, vB2); PG8_STAGE(PG8_SA(0, 0), a2, vA2);
            PG8_WAIT_V(8); PG8_WAIT_L(0); PG8_BAR; PG8_MMA(1, 0, At, B0); PG8_MMA(1, 1, At, B1); PG8_BAR; PG8_SCHED;
            PG8_LDB(B0, 1, 0); PG8_LDB(B1, 1, 1); PG8_SCHED; PG8_LDA(At, 1, 0); PG8_STAGE(PG8_SA(0, 1), a2 + hA2, vA2);
            PG8_WAIT_V(8); PG8_WAIT_L(0); PG8_BAR; PG8_MMA(0, 0, At, B0); PG8_MMA(0, 1, At, B1); PG8_BAR; PG8_SCHED;
            PG8_LDA(At, 1, 1); PG8_STAGE(PG8_SB(1, 0), b3, vB2); PG8_STAGE(PG8_SB(1, 1), b3 + hB2, vB2); PG8_STAGE(PG8_SA(1, 0), a3, vA2);
            PG8_WAIT_V(8); PG8_WAIT_L(0); PG8_BAR; PG8_MMA(1, 0, At, B0); PG8_MMA(1, 1, At, B1); PG8_BAR; PG8_SCHED;
        }
        if (wr == 0) PG8_BAR;
        P.epilogue(acc, cur, wr, wc, fr, fq);
        if (!has_next) break;
#pragma unroll
        for (int a = 0; a < 2; ++a)
#pragma unroll
            for (int b = 0; b < 2; ++b)
#pragma unroll
                for (int m = 0; m < 4; ++m)
#pragma unroll
                    for (int n = 0; n < 2; ++n) acc[a][b][m][n] = (f32x4){0.f, 0.f, 0.f, 0.f};
        cur = nxt; cA = nA; cB = nB; nt = ntn; hstepA = hstepAn; hstepB = hstepBn; voffA[0] = voffAn[0]; voffA[1] = voffAn[1]; voffB[0] = voffBn[0]; voffB[1] = voffBn[1];
        if (wr == 1) PG8_BAR;
    }
    PG8_WAIT_V(0);
    PG8_BAR;
#undef PG8_VOFF
}
#undef PG8_SA
#undef PG8_SB
#undef PG8_STAGE
#undef PG8_LDA
#undef PG8_LDB
#undef PG8_MMA
#undef PG8_WAIT_V
#undef PG8_WAIT_L
#undef PG8_BAR
#undef PG8_SCHED
}

constexpr int NWAVES = 8, NTHREADS = 512;
constexpr int LDS_BYTES = 147456;

DI float wave_sum(float v) {
#pragma unroll
    for (int o = 1; o < 64; o <<= 1) v += __shfl_xor(v, o);
    return v;
}

DI void transpose_item(const float* W, int K, int N, const float* gk, bf16_t* WT, int dst_row0, int k0, int n0, LAS float* scr, int lane) {
    f32x4 wv[8]; float gv[8];
#pragma unroll
    for (int i = 0; i < 8; ++i) { const int kk = 8 * i + (lane >> 3), nq = (lane & 7) * 4; wv[i] = __builtin_nontemporal_load((const f32x4*)(W + (size_t)(k0 + kk) * N + n0 + nq));     gv[i] = gk ? gk[k0 + kk] : 1.0f; }
    asm volatile("" ::: "memory");
#pragma unroll
    for (int i = 0; i < 8; ++i) { const int kk = 8 * i + (lane >> 3), nq = (lane & 7) * 4; const f32x4 w = wv[i] * gv[i];
        LAS float* d = scr + kk * 33 + nq; d[0] = w[0]; d[1] = w[1]; d[2] = w[2]; d[3] = w[3]; }
    asm volatile("s_waitcnt lgkmcnt(0)" ::: "memory");
    const int c = lane & 7;
#pragma unroll
    for (int j = 0; j < 4; ++j) { const int n = (lane >> 3) + 8 * j; const LAS float* s = scr + (8 * c) * 33 + n;
        u32x4 o; o.x = pkbf(s[0 * 33], s[1 * 33]); o.y = pkbf(s[2 * 33], s[3 * 33]); o.z = pkbf(s[4 * 33], s[5 * 33]); o.w = pkbf(s[6 * 33], s[7 * 33]);
        *(u32x4*)(WT + (size_t)(dst_row0 + n) * K + k0 + 8 * c) = o; }
    asm volatile("s_waitcnt lgkmcnt(0)" ::: "memory");
}

struct Args { const float* in[22]; float* out; unsigned char* ws; };
constexpr int PTR_OFF = 131072;
DI unsigned long long ldq(LAS unsigned char* lds, int i) {
    unsigned off = (unsigned)(PTR_OFF + 8 * i); asm volatile("" : "+v"(off));
    const unsigned long long v = *(const LAS unsigned long long*)(lds + off);
    const unsigned lo = __builtin_amdgcn_readfirstlane((unsigned)v), hi = __builtin_amdgcn_readfirstlane((unsigned)(v >> 32));
    return ((unsigned long long)hi << 32) | lo;
}
#define GAS __attribute__((address_space(1)))
#define INP(i) ((const float*)(const GAS float*)ldq(lds, (i)))
#define OUTP ((float*)(GAS float*)ldq(lds, 22))
#define WSP ((unsigned char*)(GAS unsigned char*)ldq(lds, 23))

DI void prep_weights(int l, LAS unsigned char* lds, int gw, int NGW, int wave, int lane, int part = 0) {
    LAS float* scr = (LAS float*)(lds + wave * 16384);
    unsigned char* ws = WSP;
    constexpr int I_IN = 16 * 224, I_BR = 8 * 32, I_SQ = 16 * 32, I_GU = 16 * 88, I_DN = 44 * 32;
    constexpr int NSQ = 7; constexpr int NITEMS = I_IN + 3 * I_BR + NSQ * I_SQ + 2 * I_GU + I_DN;
    constexpr int I_EARLY = I_IN + 3 * I_BR + NSQ * I_SQ;
    const int it_lo = part == 2 ? NITEMS - I_DN : (part == 4 ? I_EARLY : 0), it_hi = part == 3 ? I_EARLY : ((part == 1 || part == 4) ? NITEMS - I_DN : NITEMS);
    for (int it = it_lo + gw; it < it_hi; it += NGW) {
        int r = it;
        if (r < I_IN) { const int kb = r / 224, nb = r % 224, n0 = nb * 32, seg = n0 >> 9;
            int base;
            switch (seg) { case 0: base = 0; break; case 1: base = 512; break; case 2: base = 3072; break; case 3: base = 1024; break; case 4: base = 3584; break;
                           case 5: base = 1536; break; case 6: base = 2048; break; case 7: base = 2560; break; default: base = seg * 512; break; }
            transpose_item(INP(3) + (size_t)l * D * INC, D, INC, INP(2) + l * D, (bf16_t*)(ws + WS_WIN), base + (n0 & 511), kb * 64, n0, scr, lane); continue; }
        r -= I_IN;
        if (r < 3 * I_BR) { const int n = r / I_BR, q = r % I_BR, kb = q / 32, nb = q % 32;
            transpose_item(INP(9) + ((size_t)l * 3 + n) * 512 * D, 512, D, nullptr, (bf16_t*)(ws + WS_WB) + (size_t)n * D * 512, nb * 32, kb * 64, nb * 32, scr, lane); continue; }
        r -= 3 * I_BR;
        if (r < NSQ * I_SQ) { const int w = r / I_SQ, q = r % I_SQ, kb = q / 32, nb = q % 32;
            const float* src; const float* gk = nullptr; size_t dst;
            if (l == 0 && w >= 5) {
                transpose_item(INP(w == 5 ? 14 : 15) + (size_t)D * D, D, D, nullptr, (bf16_t*)(ws + (w == 5 ? WS_WK1 : WS_WV1)), nb * 32, kb * 64, nb * 32, scr, lane); continue; }
            if (w >= 5 || (l == 1 && (w == 2 || w == 3))) continue;
            switch (w) { case 0: src = INP(10); dst = WS_WOUT; break; case 1: src = INP(13); dst = WS_WQ; gk = INP(11) + l * D; break; case 2: src = INP(14); dst = WS_WK; break;
                         case 3: src = INP(15); dst = WS_WV; break; default: src = INP(16); dst = WS_WOX; break; }
            transpose_item(src + (size_t)l * D * D, D, D, gk, (bf16_t*)(ws + dst), nb * 32, kb * 64, nb * 32, scr, lane); continue; }
        r -= NSQ * I_SQ;
        if (r < 2 * I_GU) { const int w = r / I_GU, q = r % I_GU, kb = q / 88, nb = q % 88, n0 = nb * 32;
            transpose_item(INP(18 + w) + (size_t)l * D * FF, D, FF, INP(17) + l * D, (bf16_t*)(ws + WS_WGU), (n0 >> 7) * 256 + w * 128 + (n0 & 127), kb * 64, n0, scr, lane); continue; }
        r -= 2 * I_GU;
        { const int kb = r / 32, nb = r % 32;
          transpose_item(INP(20) + (size_t)l * FF * D, FF, D, nullptr, (bf16_t*)(ws + WS_WD), nb * 32, kb * 64, nb * 32, scr, lane); }
    }
    if (l == 0) {
        for (int row2 = gw; row2 < 2 * NBATCH * 256; row2 += NGW) {
            const int lay = row2 >> 10, row = row2 & 1023; const float* mg = INP(12) + lay * D;
            const f32x4* xr = (const f32x4*)(INP(1) + (size_t)row * D) + lane; f32x4 v[4]; float s = 0.f;
#pragma unroll
            for (int j = 0; j < 4; ++j) { v[j] = xr[64 * j]; s += (v[j][0] * v[j][0] + v[j][1] * v[j][1]) + (v[j][2] * v[j][2] + v[j][3] * v[j][3]); }
            const float rs = 1.0f / sqrtf(wave_sum(s) * (1.0f / D) + RMS_EPS);
            u32x2* o = (u32x2*)((bf16_t*)(ws + (lay ? WS_MB1 : WS_MB)) + (size_t)row * D) + lane;
#pragma unroll
            for (int j = 0; j < 4; ++j) { const f32x4 gv = *((const f32x4*)mg + lane + 64 * j); u32x2 w; w.x = pkbf(v[j][0] * rs * gv[0], v[j][1] * rs * gv[1]); w.y = pkbf(v[j][2] * rs * gv[2], v[j][3] * rs * gv[3]); o[64 * j] = w; }
        }
    }
}

DI void prep_x(LAS unsigned char* lds, int gw, int NGW, int lane) {
    unsigned char* ws = WSP; const float* xin = INP(0);
    float* ssp = (float*)(ws + WS_SSP);
    constexpr int NR = 4;
    for (int row0 = gw; row0 < M; row0 += NR * NGW) {
        f32x4 v[NR][4];
#pragma unroll
        for (int r = 0; r < NR; ++r) { const int row = row0 + r * NGW < M ? row0 + r * NGW : row0; const f32x4* xr = (const f32x4*)(xin + (size_t)row * D) + lane;
#pragma unroll
            for (int j = 0; j < 4; ++j) v[r][j] = __builtin_nontemporal_load(xr + 64 * j); }
        asm volatile("" ::: "memory");
#pragma unroll
        for (int r = 0; r < NR; ++r) { const int row = row0 + r * NGW; if (row < M) { float s = 0.f;
#pragma unroll
            for (int j = 0; j < 4; ++j) s += (v[r][j][0] * v[r][j][0] + v[r][j][1] * v[r][j][1]) + (v[r][j][2] * v[r][j][2] + v[r][j][3] * v[r][j][3]);
            s = wave_sum(s);
            u32x2* o = (u32x2*)((bf16_t*)(ws + WS_XB) + (size_t)row * D) + lane;
#pragma unroll
            for (int j = 0; j < 4; ++j) { u32x2 w; w.x = pkbf(v[r][j][0], v[r][j][1]); w.y = pkbf(v[r][j][2], v[r][j][3]); o[64 * j] = w; }
            if (lane < 16) ssp[(size_t)row * 16 + lane] = lane == 0 ? s : 0.f; } }
    }
}

DI void final_norm(LAS unsigned char* lds, int gw, int NGW, int lane) {
    const float* fg = INP(21); float* outp = OUTP; const float* ssp = (const float*)(WSP + WS_SSP); const bf16_t* xb = (const bf16_t*)(WSP + WS_XB);
    f32x4 gv[4];
#pragma unroll
    for (int j = 0; j < 4; ++j) gv[j] = *((const f32x4*)fg + lane + 64 * j);
    constexpr int NR = 4;
    for (int row0 = gw; row0 < M; row0 += NR * NGW) {
        u32x2 w[NR][4]; float sp[NR];
#pragma unroll
        for (int r = 0; r < NR; ++r) { const int row = row0 + r * NGW < M ? row0 + r * NGW : row0; const u32x2* xbr = (const u32x2*)(xb + (size_t)row * D) + lane;
            sp[r] = lane < 16 ? ssp[(size_t)row * 16 + lane] : 0.f;
#pragma unroll
            for (int j = 0; j < 4; ++j) w[r][j] = __builtin_nontemporal_load(xbr + 64 * j); }
        asm volatile("" ::: "memory");
#pragma unroll
        for (int r = 0; r < NR; ++r) { const int row = row0 + r * NGW; if (row < M) {
            const float rs = 1.0f / sqrtf(wave_sum(sp[r]) * (1.0f / D) + RMS_EPS);
            f32x4* xr = (f32x4*)(outp + (size_t)row * D) + lane;
#pragma unroll
            for (int j = 0; j < 4; ++j) __builtin_nontemporal_store((f32x4){bflo(w[r][j].x), bfhi(w[r][j].x), bflo(w[r][j].y), bfhi(w[r][j].y)} * rs * gv[j], xr + 64 * j); } }
    }
}

DI void sb_attn_item(bf16_t* p, const bf16_t* T, int item, int lane) {
    const int b = item >> 10, h = (item >> 7) & 7, qb = item & 127;
    const int hl = lane >> 5, li = lane & 31;
    const size_t rowbase = (size_t)b * SEQ;
    const int kperm = (li & 16) | ((li & 4) << 1) | ((li & 8) >> 1) | (li & 3);
    const bf16_t* qrow = p + (rowbase + qb * 32 + li) * PC + h * 64 + 8 * hl;
    bf16x8 qf[4];
#pragma unroll
    for (int kk = 0; kk < 4; ++kk) qf[kk] = *(const bf16x8*)(qrow + 16 * kk);
    bf16x8 U[2];
#pragma unroll
    for (int c = 0; c < 2; ++c)
#pragma unroll
        for (int e = 0; e < 8; ++e) U[c][e] = (16 * c + 8 * hl + e >= kperm) ? (short)0x3f80 : (short)0;
    f32x16 o0, o1;
#pragma unroll
    for (int r = 0; r < 16; ++r) { o0[r] = 0.f; o1[r] = 0.f; }
    float carry = 0.f;
    const bf16_t* vt0 = T + (size_t)(h * 64 + li) * M + rowbase + 8 * hl;
    for (int kb = qb; kb >= 0; --kb) {
        const int s0 = kb * 32;
        const bf16_t* krow = p + (rowbase + s0 + kperm) * PC + 512 + h * 64 + 8 * hl;
        bf16x8 kf[4], vf[4];
#pragma unroll
        for (int kk = 0; kk < 4; ++kk) kf[kk] = *(const bf16x8*)(krow + 16 * kk);
#pragma unroll
        for (int c = 0; c < 2; ++c) { vf[c] = *(const bf16x8*)(vt0 + s0 + 16 * c); vf[2 + c] = *(const bf16x8*)(vt0 + (size_t)32 * M + s0 + 16 * c); }
        f32x16 z;
#pragma unroll
        for (int r = 0; r < 16; ++r) z[r] = 0.f;
#pragma unroll
        for (int kk = 0; kk < 4; ++kk) z = MFMA32(kf[kk], qf[kk], z);
        const bool diag = (kb == qb);
        float Lv[16];
#pragma unroll
        for (int r = 0; r < 16; ++r) {
            const float zz = z[r];
            float L = fmaxf(zz, 0.f) + LN2 * __builtin_amdgcn_logf(1.0f + __builtin_amdgcn_exp2f(-fabsf(zz) * LOG2E));
            if (diag && !(16 * (r >> 3) + 8 * hl + (r & 7) < li)) L = 0.f;
            Lv[r] = L;
        }
        bf16x8 Lh[2], Ll[2];
#pragma unroll
        for (int c = 0; c < 2; ++c) { u32x4 wh, wl;
#pragma unroll
            for (int e = 0; e < 4; ++e) { const float a0 = Lv[8 * c + 2 * e], a1 = Lv[8 * c + 2 * e + 1]; const unsigned hp = pkbf(a0, a1); wh[e] = hp; wl[e] = pkbf(a0 - bflo(hp), a1 - bfhi(hp)); }
            Lh[c] = __builtin_bit_cast(bf16x8, wh); Ll[c] = __builtin_bit_cast(bf16x8, wl); }
        f32x16 C;
#pragma unroll
        for (int r = 0; r < 16; ++r) C[r] = carry;
        C = MFMA32(U[0], Lh[0], C); C = MFMA32(U[1], Lh[1], C); C = MFMA32(U[0], Ll[0], C); C = MFMA32(U[1], Ll[1], C);
        bf16x8 pf[2];
#pragma unroll
        for (int c = 0; c < 2; ++c) { u32x4 w;
#pragma unroll
            for (int e = 0; e < 4; ++e) { float a0, a1; { const int r = 8 * c + 2 * e; a0 = __builtin_amdgcn_exp2f((z[r] - C[r]) * LOG2E); a1 = __builtin_amdgcn_exp2f((z[r + 1] - C[r + 1]) * LOG2E);
                    if (diag) { if (!(16 * c + 8 * hl + 2 * e < li)) a0 = 0.f; if (!(16 * c + 8 * hl + 2 * e + 1 < li)) a1 = 0.f; } }
                w[e] = pkbf(a0, a1); }
            pf[c] = __builtin_bit_cast(bf16x8, w); }
        carry = __shfl(C[0], li);
        o0 = MFMA32(vf[0], pf[0], o0); o0 = MFMA32(vf[1], pf[1], o0);
        o1 = MFMA32(vf[2], pf[0], o1); o1 = MFMA32(vf[3], pf[1], o1);
        if (__all(carry > SB_EXIT)) break;
    }
    bf16_t* orow = p + (rowbase + qb * 32 + li) * PC + h * 64 + 4 * hl;
#pragma unroll
    for (int g = 0; g < 4; ++g) {
        u32x2 w0, w1; w0.x = pkbf(o0[4 * g], o0[4 * g + 1]); w0.y = pkbf(o0[4 * g + 2], o0[4 * g + 3]); w1.x = pkbf(o1[4 * g], o1[4 * g + 1]); w1.y = pkbf(o1[4 * g + 2], o1[4 * g + 3]);
        *(u32x2*)(orow + 8 * g) = w0; *(u32x2*)(orow + 32 + 8 * g) = w1; }
}

DI void sgu_item(int l, bf16_t* p, const bf16_t* T, int item, LAS unsigned char* lds, int tid, int wave, int lane) {
    const int g = item & 3, n = (item >> 2) & 31, b = item >> 7;
    const size_t tok0 = (size_t)b * SEQ + n * 128;
    const bf16_t* zv = T + (size_t)512 * M;
    LAS float* red = (LAS float*)lds;
    LAS float* mean = (LAS float*)(lds + 8192);
    LAS float* rstd = (LAS float*)(lds + 8192 + 512);
    {
        float s0 = 0.f, s1 = 0.f, q0 = 0.f, q1 = 0.f;
        const bf16_t* src = zv + (size_t)(wave * 64) * M + tok0 + 2 * lane;
#pragma unroll 1
        for (int jb = 0; jb < 64; jb += 16) {
            unsigned wv[16];
#pragma unroll
            for (int j = 0; j < 16; ++j) wv[j] = *(const unsigned*)(src + (size_t)(jb + j) * M);
            asm volatile("" ::: "memory");
#pragma unroll
            for (int j = 0; j < 16; ++j) { const float a0 = bflo(wv[j]), a1 = bfhi(wv[j]); s0 += a0; s1 += a1; q0 += a0 * a0; q1 += a1 * a1; }
        }
        *(LAS f32x4*)(red + (wave * 64 + lane) * 4) = (f32x4){s0, q0, s1, q1};
    }
    __syncthreads();
    if (tid < 128) { float s = 0.f, q = 0.f;
#pragma unroll
        for (int w = 0; w < 8; ++w) { const f32x2 v = *(LAS f32x2*)(red + (w * 64 + (tid >> 1)) * 4 + (tid & 1) * 2); s += v.x; q += v.y; }
        const float mu = s * (1.0f / 512.0f), var = fmaxf(q * (1.0f / 512.0f) - mu * mu, 0.f);
        mean[tid] = mu; rstd[tid] = 1.0f / sqrtf(var + LN_EPS); }
    __syncthreads();
    const int cblk = wave & 3, th = wave >> 2, hl = lane >> 5, li = lane & 31;
    const int cch = g * 128 + cblk * 32 + li;
    const float lg = INP(4)[l * 512 + cch], lb = INP(5)[l * 512 + cch];
    const bf16_t* arow = zv + (size_t)cch * M + tok0 + 8 * hl;
    const float* wsp = INP(6) + ((size_t)(l * 4 + g) * 128) * 128;
    f32x16 acc0, acc1;
#pragma unroll
    for (int r = 0; r < 16; ++r) { acc0[r] = 0.f; acc1[r] = 0.f; }
#pragma unroll
    for (int hf = 0; hf < 2; ++hf) if (hf == 0 || th) {
        u32x4 raw[4]; f32x4 wv[4][2][2];
#pragma unroll
        for (int k4 = 0; k4 < 4; ++k4) { const int kk = 4 * hf + k4, sb = 16 * kk + 8 * hl;
            raw[k4] = *(const u32x4*)(arow + 16 * kk);
#pragma unroll
            for (int tb = 0; tb < 2; ++tb) { const int t = th * 64 + tb * 32 + li; wv[k4][tb][0] = *(const f32x4*)(wsp + (size_t)t * 128 + sb); wv[k4][tb][1] = *(const f32x4*)(wsp + (size_t)t * 128 + sb + 4); } }
        asm volatile("" ::: "memory");
#pragma unroll
        for (int k4 = 0; k4 < 4; ++k4) { const int kk = 4 * hf + k4, sb = 16 * kk + 8 * hl;
            const f32x4 m0 = *(LAS f32x4*)(mean + sb), m1 = *(LAS f32x4*)(mean + sb + 4), r0 = *(LAS f32x4*)(rstd + sb), r1 = *(LAS f32x4*)(rstd + sb + 4);
            const u32x4 rw = raw[k4]; u32x4 aw;
            aw.x = pkbf((bflo(rw.x) - m0[0]) * r0[0] * lg + lb, (bfhi(rw.x) - m0[1]) * r0[1] * lg + lb);
            aw.y = pkbf((bflo(rw.y) - m0[2]) * r0[2] * lg + lb, (bfhi(rw.y) - m0[3]) * r0[3] * lg + lb);
            aw.z = pkbf((bflo(rw.z) - m1[0]) * r1[0] * lg + lb, (bfhi(rw.z) - m1[1]) * r1[1] * lg + lb);
            aw.w = pkbf((bflo(rw.w) - m1[2]) * r1[2] * lg + lb, (bfhi(rw.w) - m1[3]) * r1[3] * lg + lb);
            const bf16x8 af = __builtin_bit_cast(bf16x8, aw);
#pragma unroll
            for (int tb = 0; tb < 2; ++tb) { const f32x4 w0 = wv[k4][tb][0], w1 = wv[k4][tb][1];
                u32x4 bw; bw.x = pkbf(w0[0], w0[1]); bw.y = pkbf(w0[2], w0[3]); bw.z = pkbf(w1[0], w1[1]); bw.w = pkbf(w1[2], w1[3]);
                const bf16x8 bfr = __builtin_bit_cast(bf16x8, bw);
                if (tb == 0) acc0 = MFMA32(af, bfr, acc0); else acc1 = MFMA32(af, bfr, acc1); } }
    }
#pragma unroll
    for (int tb = 0; tb < 2; ++tb) {
        const int t = th * 64 + tb * 32 + li; const float bs = INP(7)[(l * 4 + g) * 128 + t];
        bf16_t* urow = p + (tok0 + t) * PC + 1024 + g * 128 + cblk * 32 + 4 * hl;
        u32x2 uws[4];
#pragma unroll
        for (int q = 0; q < 4; ++q) uws[q] = *(const u32x2*)(urow + 8 * q);
#pragma unroll
        for (int q = 0; q < 4; ++q) { const u32x2 uw = uws[q];
            float v0, v1, v2, v3;
            if (tb == 0) { v0 = acc0[4 * q]; v1 = acc0[4 * q + 1]; v2 = acc0[4 * q + 2]; v3 = acc0[4 * q + 3]; } else { v0 = acc1[4 * q]; v1 = acc1[4 * q + 1]; v2 = acc1[4 * q + 2]; v3 = acc1[4 * q + 3]; }
            u32x2 ow; ow.x = pkbf(bflo(uw.x) * (v0 + bs), bfhi(uw.x) * (v1 + bs)); ow.y = pkbf(bflo(uw.y) * (v2 + bs), bfhi(uw.y) * (v3 + bs));
            *(u32x2*)(urow + 8 * q) = ow; }
    }
    __syncthreads();
}

DI void conv_phase(int l, bf16_t* p, LAS unsigned char* lds, int gtid, int NGT) {
    const float* cw = INP(8) + (size_t)l * 3 * 512;
    for (int it = gtid; it < M * 64; it += NGT) {
        const int row = it >> 6, c8 = (it & 63) * 8, t = row & (SEQ - 1);
        bf16_t* pr = p + (size_t)row * PC;
        float accv[8];
#pragma unroll
        for (int e = 0; e < 8; ++e) accv[e] = 0.f;
        u32x4 ccv[3], cxv[3];
#pragma unroll
        for (int j = 0; j < 3; ++j) { const int dt = (t - (2 - j) >= 0) ? 2 - j : 0;
            ccv[j] = *(const u32x4*)(pr - (size_t)dt * PC + 2048 + c8); cxv[j] = *(const u32x4*)(pr - (size_t)dt * PC + 2560 + c8); }
        const u32x4 cb = *(const u32x4*)(pr + 1536 + c8);
        asm volatile("" ::: "memory");
#pragma unroll
        for (int j = 0; j < 3; ++j) { const int dt = 2 - j;
            if (t - dt >= 0) {
                const u32x4 cc = ccv[j], cx = cxv[j];
                const f32x4 w0 = *(const f32x4*)(cw + j * 512 + c8), w1 = *(const f32x4*)(cw + j * 512 + c8 + 4);
                accv[0] += w0[0] * bflo(cc.x) * bflo(cx.x); accv[1] += w0[1] * bfhi(cc.x) * bfhi(cx.x); accv[2] += w0[2] * bflo(cc.y) * bflo(cx.y); accv[3] += w0[3] * bfhi(cc.y) * bfhi(cx.y);
                accv[4] += w1[0] * bflo(cc.z) * bflo(cx.z); accv[5] += w1[1] * bfhi(cc.z) * bfhi(cx.z); accv[6] += w1[2] * bflo(cc.w) * bflo(cx.w); accv[7] += w1[3] * bfhi(cc.w) * bfhi(cx.w); } }
        u32x4 o; o.x = pkbf(bflo(cb.x) * accv[0], bfhi(cb.x) * accv[1]); o.y = pkbf(bflo(cb.y) * accv[2], bfhi(cb.y) * accv[3]); o.z = pkbf(bflo(cb.z) * accv[4], bfhi(cb.z) * accv[5]); o.w = pkbf(bflo(cb.w) * accv[6], bfhi(cb.w) * accv[7]);
        *(u32x4*)(pr + 1536 + c8) = o;
    }
}

DI void xattn_wg(const bf16_t* qx, const bf16_t* memK, const bf16_t* memVT, bf16_t* ox, int item, int tid, int wave, int lane, LAS unsigned char* lds) {
    const int b = item >> 6, h = (item >> 4) & 3, qb = (item & 15) * 8 + wave;
    const int hl = lane >> 5, li = lane & 31;
    const size_t qrow = (size_t)b * SEQ + qb * 32 + li;
    bf16x8 qf[16];
#pragma unroll
    for (int kk = 0; kk < 16; ++kk) qf[kk] = *(const bf16x8*)(qx + qrow * D + h * 256 + 16 * kk + 8 * hl);
    const int sr = tid >> 4, sp0 = (tid & 15) * 2;
    const int kperm_sr = (sr & 16) | ((sr & 4) << 1) | ((sr & 8) >> 1) | (sr & 3);
    const bf16_t* kbase = memK + (size_t)(b * 256) * D + h * 256;
    const bf16_t* vbase = memVT + (size_t)(h * 256) * D + b * 256;
    u32x4 st[2], sn[2];
#define XA_LOAD(R, c) do { if ((c) < 8) { _Pragma("unroll") for (int e = 0; e < 2; ++e) R[e] = *(const u32x4*)(kbase + (size_t)((c) * 32 + sr) * D + (sp0 + e) * 8); } \
                           else { _Pragma("unroll") for (int e = 0; e < 2; ++e) R[e] = *(const u32x4*)(vbase + (size_t)(((c) - 8) * 32 + sr) * D + (sp0 + e) * 8); } } while (0)
#define XA_STORE(R, c) do { const int rl = (c) < 8 ? kperm_sr : sr; _Pragma("unroll") for (int e = 0; e < 2; ++e) { const int p = sp0 + e; \
                           *(LAS u32x4*)(lds + ((c) & 1) * 16384 + (((p >> 1) * 64) + (p & 1) * 32 + rl) * 16) = R[e]; } } while (0)
    XA_LOAD(st, 0); XA_STORE(st, 0); XA_LOAD(st, 1);
    __syncthreads();
    f32x16 S[8];
#pragma unroll
    for (int c = 0; c < 8; ++c) {
        XA_LOAD(sn, c + 2);
        f32x16 z;
#pragma unroll
        for (int r = 0; r < 16; ++r) z[r] = 0.f;
        const LAS unsigned char* buf = lds + (c & 1) * 16384 + lane * 16;
#pragma unroll
        for (int kk = 0; kk < 16; ++kk) { const bf16x8 kf = *(const LAS bf16x8*)(buf + kk * 1024); z = MFMA32(kf, qf[kk], z); }
        S[c] = z;
        XA_STORE(st, c + 1);
        __syncthreads();
        st[0] = sn[0]; st[1] = sn[1];
    }
    float mx = -3.0e38f;
#pragma unroll
    for (int kb = 0; kb < 8; ++kb)
#pragma unroll
        for (int r = 0; r < 16; ++r) mx = fmaxf(mx, S[kb][r]);
    mx = fmaxf(mx, __shfl_xor(mx, 32));
    float sum = 0.f;
    bf16x8 pf[16];
#pragma unroll
    for (int kb = 0; kb < 8; ++kb)
#pragma unroll
        for (int c = 0; c < 2; ++c) { u32x4 w;
#pragma unroll
            for (int e = 0; e < 4; ++e) { const float a0 = __builtin_amdgcn_exp2f((S[kb][8 * c + 2 * e] - mx) * LOG2E), a1 = __builtin_amdgcn_exp2f((S[kb][8 * c + 2 * e + 1] - mx) * LOG2E); sum += a0 + a1; w[e] = pkbf(a0, a1); }
            pf[2 * kb + c] = __builtin_bit_cast(bf16x8, w); }
    sum += __shfl_xor(sum, 32);
    const float inv = 1.0f / sum;
    bf16_t* orow = ox + qrow * D + h * 256 + 4 * hl;
#pragma unroll 1
    for (int c = 8; c < 16; ++c) {
        if (c + 2 < 16) XA_LOAD(sn, c + 2);
        f32x16 o;
#pragma unroll
        for (int r = 0; r < 16; ++r) o[r] = 0.f;
        const LAS unsigned char* buf = lds + (c & 1) * 16384 + lane * 16;
#pragma unroll
        for (int s = 0; s < 16; ++s) { const bf16x8 vf = *(const LAS bf16x8*)(buf + s * 1024); o = MFMA32(vf, pf[s], o); }
        const int db = c - 8;
#pragma unroll
        for (int g = 0; g < 4; ++g) { u32x2 w; w.x = pkbf(o[4 * g] * inv, o[4 * g + 1] * inv); w.y = pkbf(o[4 * g + 2] * inv, o[4 * g + 3] * inv); *(u32x2*)(orow + db * 32 + 8 * g) = w; }
        if (c + 1 < 16) XA_STORE(st, c + 1);
        __syncthreads();
        st[0] = sn[0]; st[1] = sn[1];
    }
#undef XA_LOAD
#undef XA_STORE
}

constexpr int RSD_OFF = 131072 + 768, RS_OFF = 131072 + 1024, RS_MAXU = 15;
template <class Prog>
DI void fill_rs(LAS unsigned char* lds, Prog P2, const float* ssp, int tid) {
    LAS int* desc = (LAS int*)(lds + RSD_OFF);
    if (tid == 0) { pg8::UnitX x; int n = 0; while (n < RS_MAXU && P2.next(x)) { desc[n] = P2.rs_base(x); ++n; } desc[RS_MAXU] = n; }
    __syncthreads();
    const int n = desc[RS_MAXU];
    for (int kb = 0; kb < n; kb += 8) {
        f32x4 sv[4][4]; int ok[4];
#pragma unroll
        for (int j = 0; j < 4; ++j) { const int k = kb + 2 * j + (tid >> 8); const int base = k < n ? desc[k] : -1; ok[j] = base >= 0;
            const f32x4* sp = (const f32x4*)(ssp + (size_t)((ok[j] ? base : 0) + (tid & 255)) * 16);
#pragma unroll
            for (int q = 0; q < 4; ++q) sv[j][q] = ok[j] ? sp[q] : (f32x4){0.f, 0.f, 0.f, 0.f}; }
        asm volatile("" ::: "memory");
#pragma unroll
        for (int j = 0; j < 4; ++j) if (ok[j]) { const int k = kb + 2 * j + (tid >> 8); float s = 0.f;
#pragma unroll
            for (int q = 0; q < 4; ++q) s += (sv[j][q][0] + sv[j][q][1]) + (sv[j][q][2] + sv[j][q][3]);
            ((LAS float*)(lds + RS_OFF))[k * 256 + (tid & 255)] = 1.0f / sqrtf(s * (1.0f / D) + RMS_EPS); }
    }
    __syncthreads();
}
DI int wrapg(int v, int G) { while (v >= G) v -= G; return v; }
struct ProgC {
    unsigned char* ws; LAS unsigned char* lds; int G, c; int j, i, kk; pg8::Unit u; bool have;
    DI int rs_base(const pg8::UnitX& x) const { return (x.job & 1) ? -1 : x.pm * 256; }
    DI void init(unsigned char* ws_, int G_, int c_, LAS unsigned char* lds_) { lds = lds_; kk = 0; ws = ws_; G = G_; c = c_; j = 0; i = 0; pg8::StaticOrder S; S.init(M, D, G, c); have = S.next(0, u); }
    DI bool next(pg8::UnitX& x) {
        if (have && j >= 6) { pg8::StaticOrder S; S.init(M, D, G, c); ++i; j = 0; have = S.next(i, u); }
        if (!have) return false;
        x.pm = u.pm; x.pn = u.pn; x.job = j; x.k = kk; ++kk; ++j; return true; }
    DI pg8::JobP job(int jj) const { const int n = jj >> 1; pg8::JobP p;
        if ((jj & 1) == 0) { p.A = (const bf16_t*)(ws + WS_XB); p.Bt = (const bf16_t*)(ws + WS_WIN) + (size_t)(4096 + n * 1024) * D; p.lda = D; p.ldb = D; p.nt = D / 64; }
        else { const int acol = n == 0 ? 0 : (n == 1 ? 1024 : 1536); p.A = (const bf16_t*)(ws + WS_P) + acol; p.Bt = (const bf16_t*)(ws + WS_WB) + (size_t)n * D * 512; p.lda = PC; p.ldb = 512; p.nt = 512 / 64; }
        return p; }
    DI void epilogue(const f32x4 (&acc)[2][2][4][2], const pg8::UnitX& x, int wr, int wc, int fr, int fq) const {
        pg8::EpiArgs ea{}; const pg8::Unit uu{x.pm, x.pn};
        if ((x.job & 1) == 0) { ea.O = (bf16_t*)(ws + WS_T); ea.ldc = D; ea.ssp = (const float*)(ws + WS_SSP); ea.rstab = x.k < RS_MAXU ? (const LAS float*)(lds + RS_OFF) + x.k * 256 : nullptr; ea.cscale = 1.f; pg8::Epi<pg8::E_GATE> E{ea}; E(acc, uu, wr, wc, fr, fq); }
        else { ea.O = (bf16_t*)(ws + WS_X2); ea.ldc = D; ea.G = (const bf16_t*)(ws + WS_T);
            if (x.job == 1) { pg8::Epi<pg8::E_BR0> E{ea}; E(acc, uu, wr, wc, fr, fq); } else { pg8::Epi<pg8::E_BRN> E{ea}; E(acc, uu, wr, wc, fr, fq); } }
    }
};
struct ProgA {
    unsigned char* ws; LAS unsigned char* lds; int G, c; int jb, i, njobs, kk;
    DI int rs_base(const pg8::UnitX& x) const { return x.job == 0 ? x.pm * 256 : (x.job == 1 ? x.pn * 256 : -1); }
    DI void init(unsigned char* ws_, int G_, int c_, int l, LAS unsigned char* lds_) { lds = lds_; kk = 0; ws = ws_; G = G_; c = c_; jb = 0; i = 0; njobs = l == 0 ? 4 : 2; }
    DI bool next(pg8::UnitX& x) {
        for (; jb < njobs; ++jb, i = 0) {
            pg8::StaticOrder S; pg8::Unit u;
            if (jb == 0) S.init(M, 3072, G, c); else if (jb == 1) S.init(1024, M, G, c); else if (jb == 2) S.init(1024, D, G, wrapg(c + 64, G)); else S.init(D, 1024, G, wrapg(c + 192, G));
            if (S.next(i, u)) { x.pm = u.pm; x.pn = u.pn; x.job = jb; x.k = kk; ++kk; ++i; return true; }
        }
        return false;
    }
    DI pg8::JobP job(int jj) const { pg8::JobP p; p.lda = D; p.ldb = D; p.nt = D / 64;
        if (jj == 0) { p.A = (const bf16_t*)(ws + WS_XB); p.Bt = (const bf16_t*)(ws + WS_WIN); }
        else if (jj == 1) { p.A = (const bf16_t*)(ws + WS_WIN) + (size_t)3072 * D; p.Bt = (const bf16_t*)(ws + WS_XB); }
        else if (jj == 2) { p.A = (const bf16_t*)(ws + WS_MB); p.Bt = (const bf16_t*)(ws + WS_WK); }
        else { p.A = (const bf16_t*)(ws + WS_WV); p.Bt = (const bf16_t*)(ws + WS_MB); }
        return p; }
    DI void epilogue(const f32x4 (&acc)[2][2][4][2], const pg8::UnitX& x, int wr, int wc, int fr, int fq) const {
        pg8::EpiArgs ea{}; const pg8::Unit uu{x.pm, x.pn};
        const LAS float* rst = x.k < RS_MAXU ? (const LAS float*)(lds + RS_OFF) + x.k * 256 : nullptr;
        if (x.job == 0) { ea.O = (bf16_t*)(ws + WS_P); ea.ldc = PC; ea.ssp = (const float*)(ws + WS_SSP); ea.rstab = rst; ea.cscale = 1.f; pg8::Epi<pg8::E_INPROJ> E{ea}; E(acc, uu, wr, wc, fr, fq); }
        else if (x.job == 2) { ea.O = (bf16_t*)(ws + WS_MEMK); ea.ldc = D; ea.ssp = nullptr; ea.cscale = 1.f; pg8::Epi<pg8::E_ROWSCALE> E{ea}; E(acc, uu, wr, wc, fr, fq); }
        else { if (x.job == 1) { ea.O = (bf16_t*)(ws + WS_T); ea.ldc = M; ea.ssp = (const float*)(ws + WS_SSP); ea.rstab = rst; } else { ea.O = (bf16_t*)(ws + WS_MEMVT); ea.ldc = 1024; ea.ssp = nullptr; }
            pg8::Epi<pg8::E_TRANS> E{ea}; E(acc, uu, wr, wc, fr, fq); }
    }
};
struct ProgJ {
    unsigned char* ws; LAS unsigned char* lds; int G, c; int jb, i, njobs, kk;
    DI int rs_base(const pg8::UnitX& x) const { return x.job == 0 ? x.pm * 256 : -1; }
    DI void init(unsigned char* ws_, int G_, int c_, int l, LAS unsigned char* lds_) { lds = lds_; kk = 0; ws = ws_; G = G_; c = c_; jb = 0; i = 0; njobs = l == 0 ? 3 : 1; }
    DI bool next(pg8::UnitX& x) {
        for (; jb < njobs; ++jb, i = 0) {
            pg8::StaticOrder S; pg8::Unit u;
            if (jb == 0) S.init(M, 2 * FF, G, c); else if (jb == 1) S.init(1024, D, G, wrapg(c + 128, G)); else S.init(D, 1024, G, wrapg(c + 96, G));
            if (S.next(i, u)) { x.pm = u.pm; x.pn = u.pn; x.job = jb; x.k = kk; ++kk; ++i; return true; }
        }
        return false;
    }
    DI pg8::JobP job(int jj) const { pg8::JobP p; p.lda = D; p.ldb = D; p.nt = D / 64;
        if (jj == 0) { p.A = (const bf16_t*)(ws + WS_XB); p.Bt = (const bf16_t*)(ws + WS_WGU); }
        else if (jj == 1) { p.A = (const bf16_t*)(ws + WS_MB1); p.Bt = (const bf16_t*)(ws + WS_WK1); }
        else { p.A = (const bf16_t*)(ws + WS_WV1); p.Bt = (const bf16_t*)(ws + WS_MB1); }
        return p; }
    DI void epilogue(const f32x4 (&acc)[2][2][4][2], const pg8::UnitX& x, int wr, int wc, int fr, int fq) const {
        pg8::EpiArgs ea{}; const pg8::Unit uu{x.pm, x.pn};
        if (x.job == 0) { ea.O = (bf16_t*)(ws + WS_P); ea.ldc = FF; ea.ssp = (const float*)(ws + WS_SSP) + (size_t)2 * M * 16; ea.rstab = x.k < RS_MAXU ? (const LAS float*)(lds + RS_OFF) + x.k * 256 : nullptr; pg8::Epi<pg8::E_SWIGLU> E{ea}; E(acc, uu, wr, wc, fr, fq); }
        else if (x.job == 1) { ea.O = (bf16_t*)(ws + WS_MEMK1); ea.ldc = D; ea.ssp = nullptr; ea.cscale = 1.f; pg8::Epi<pg8::E_ROWSCALE> E{ea}; E(acc, uu, wr, wc, fr, fq); }
        else { ea.O = (bf16_t*)(ws + WS_MEMVT1); ea.ldc = 1024; ea.ssp = nullptr; pg8::Epi<pg8::E_TRANS> E{ea}; E(acc, uu, wr, wc, fr, fq); }
    }
};
#define XB_TMO      128
#define XB_XCNT(j)  (256  + 64 * (j))
#define XB_XSUB(j)  (1280 + 64 * (j))
#define XB_XGEN(j)  (2304 + 64 * (j))
#define XB_TOP      3328
#define XB_TOPGEN   3392
#define XCD_BAR_WORDS 3456
#define XB_SPIN_CAP (1u << 18)

__device__ __forceinline__ unsigned xb_ld(unsigned* p)              { return __hip_atomic_load(p, __ATOMIC_RELAXED, __HIP_MEMORY_SCOPE_AGENT); }
__device__ __forceinline__ unsigned xb_add(unsigned* p, unsigned v) { return __hip_atomic_fetch_add(p, v, __ATOMIC_RELAXED, __HIP_MEMORY_SCOPE_AGENT); }
__device__ __forceinline__ unsigned xb_xcc_id() { return (unsigned)__builtin_amdgcn_s_getreg((3 << 11) | 20) & 0xFu; }
#define XB_SPIN(cond, bar) do { unsigned _sp = 0; while (cond) { __builtin_amdgcn_s_sleep(1); \
    if ((++_sp & 255u) == 0u) { if (xb_ld(&(bar)[XB_TMO])) break; if (_sp > XB_SPIN_CAP) { atomicAdd(&(bar)[XB_TMO], 1u); break; } } } } while (0)

struct XcdBarrier {
    unsigned* bar; unsigned x;
    volatile LAS unsigned* st;
};

__device__ __forceinline__ XcdBarrier xcd_barrier_post(unsigned* bar, volatile LAS unsigned* st) {
    XcdBarrier b; b.bar = bar; b.x = xb_xcc_id(); b.st = st;
    if (threadIdx.x == 0) (void)xb_add(&bar[XB_XCNT(b.x)], 1u);
    return b;
}
__device__ __forceinline__ void xcd_barrier_complete(unsigned* bar, unsigned x, unsigned& nloc, unsigned& nx) {
    const unsigned G = gridDim.x * gridDim.y * gridDim.z;
    unsigned sum, cnt, mine, sp = 0u;
    for (;;) {
        sum = 0u; cnt = 0u; mine = 0u;
#pragma unroll
        for (unsigned j = 0; j < 16; ++j) { const unsigned c = xb_ld(&bar[XB_XCNT(j)]); sum += c; cnt += (c > 0u) ? 1u : 0u; mine = (j == x) ? c : mine; }
        if (sum == G) break;
        __builtin_amdgcn_s_sleep(1);
        if ((++sp & 255u) == 0u) { if (xb_ld(&bar[XB_TMO])) break; if (sp > XB_SPIN_CAP) { atomicAdd(&bar[XB_TMO], 1u); break; } }
    }
    nloc = mine > 0u ? mine : 1u; nx = cnt > 0u ? cnt : 1u;
}

__device__ __forceinline__ void xcd_barrier(const XcdBarrier& b) {
    asm volatile("s_waitcnt vmcnt(0)" ::: "memory");
    __syncthreads();
    if (threadIdx.x == 0) {
        unsigned* bar = b.bar;
        __builtin_amdgcn_s_waitcnt(0);
        unsigned nloc = b.st[0], nx = b.st[1];
        if (nloc == 0u) { xcd_barrier_complete(bar, b.x, nloc, nx); b.st[0] = nloc; b.st[1] = nx; }
        const unsigned old = xb_add(&bar[XB_XSUB(b.x)], 1u);
        const unsigned gen = old / nloc;
        if (old + 1u == (gen + 1u) * nloc) {
            __builtin_amdgcn_fence(__ATOMIC_RELEASE, "agent");
            asm volatile("s_waitcnt vmcnt(0)" ::: "memory");
            const unsigned og = xb_add(&bar[XB_TOP], 1u);
            const unsigned tg = og / nx;
            if (og + 1u == (tg + 1u) * nx) xb_add(&bar[XB_TOPGEN], 1u);
            else XB_SPIN(xb_ld(&bar[XB_TOPGEN]) == tg, bar);
            __builtin_amdgcn_fence(__ATOMIC_ACQUIRE, "agent");
            xb_add(&bar[XB_XGEN(b.x)], 1u);
            asm volatile("s_waitcnt vmcnt(0)" ::: "memory");
        } else {
            XB_SPIN(xb_ld(&bar[XB_XGEN(b.x)]) == gen, bar);
            __builtin_amdgcn_fence(__ATOMIC_ACQUIRE, "agent");
            asm volatile("s_waitcnt vmcnt(0)" ::: "memory");
        }
    }
    __syncthreads();
}

#define WSB(off) ((bf16_t*)(WSP + (off)))
#define WSF(off) ((float*)(WSP + (off)))
__global__ void __launch_bounds__(NTHREADS, 2) fwd_megakernel(Args A_unused) {
    extern __shared__ __attribute__((aligned(16))) unsigned char lds_raw[];
    LAS unsigned char* lds = (LAS unsigned char*)lds_raw;
    cg::grid_group grid = cg::this_grid();
    { const int tid = threadIdx.x;
    if (tid < 24) { const unsigned long long* ka = (const unsigned long long*)__builtin_amdgcn_kernarg_segment_ptr(); *(LAS unsigned long long*)(lds + PTR_OFF + 8 * tid) = ka[tid]; } }
    if (threadIdx.x < 8) ((LAS unsigned*)(lds + PTR_OFF + 256))[threadIdx.x] = 0u;
    __syncthreads();
    if (blockIdx.x == 0) { unsigned* bw = (unsigned*)ldq(lds, 23); for (int w = threadIdx.x; w < XCD_BAR_WORDS; w += NTHREADS) __hip_atomic_store(bw + w, 0u, __ATOMIC_RELAXED, __HIP_MEMORY_SCOPE_AGENT); }
    asm volatile("s_waitcnt vmcnt(0)" ::: "memory");
    __syncthreads();
    grid.sync();
    const XcdBarrier bar = xcd_barrier_post((unsigned*)ldq(lds, 23), (volatile LAS unsigned*)(lds + PTR_OFF + 256));
#define XBAR() do { XcdBarrier b2_ = bar; asm volatile("" : "+s"(b2_.x)); xcd_barrier(b2_); } while (0)
#define FRESH_IDS const int tid = fresh_tid(), lane = tid & 63, wave = __builtin_amdgcn_readfirstlane(tid >> 6); (void)lane; (void)wave
#define GRID_ ((int)gridDim.x)
#define BID_ ((int)blockIdx.x)
#define GW_ (BID_ * NWAVES + wave)
#define NGW_ (GRID_ * NWAVES)
    constexpr size_t SSPB = (size_t)M * 16 * 4;
    using namespace pg8;

    { FRESH_IDS; prep_x(lds, GW_, NGW_, lane); }
    { FRESH_IDS; prep_weights(0, lds, GW_, NGW_, wave, lane); }
    XBAR();
    for (int l = 0; l < DEPTH; ++l) {
        { ProgA PA; PA.init(WSP, GRID_, BID_, l, lds); { FRESH_IDS; fill_rs(lds, PA, WSF(WS_SSP), tid); } gemm_stream(lds, PA); }
        XBAR();
        if (l > 0) { FRESH_IDS; prep_weights(l, lds, GW_, NGW_, wave, lane, 2); __syncthreads(); }
        { FRESH_IDS;
          for (int it0 = BID_; it0 < NBATCH * 32 * 4; it0 += GRID_) { int it = it0;
              if (GRID_ == 256) { const int r = it0 >> 8, bx = it0 & 255, xcd = bx & 7, slot = bx >> 3; it = (r * 64 + xcd * 8 + (slot >> 2)) * 4 + (slot & 3); }
              sgu_item(l, WSB(WS_P), WSB(WS_T), it, lds, tid, wave, lane); } }
        { FRESH_IDS; for (int it = GW_; it < NBATCH * 8 * 128; it += NGW_) sb_attn_item(WSB(WS_P), WSB(WS_T), it, lane); }
        { FRESH_IDS; conv_phase(l, WSB(WS_P), lds, BID_ * NTHREADS + tid, GRID_ * NTHREADS); }
        XBAR();
        { ProgC PCg; PCg.init(WSP, GRID_, BID_, lds); { FRESH_IDS; fill_rs(lds, PCg, WSF(WS_SSP), tid); } gemm_stream(lds, PCg); }
        XBAR();
        {
            StaticOrder S; S.init(M, D, GRID_, BID_);
            EpiArgs ea{}; Gemm g{WSB(WS_X2), WSB(WS_WOUT), M, D, D, D, D}; ea.xb = WSB(WS_XB); ea.sspo = WSF(WS_SSP + SSPB); Epi<E_RESID> E{ea}; gemm_phase(lds, g, S, E);
        }
        XBAR();
        {
            StaticOrder S; S.init(M, D, GRID_, BID_);
            EpiArgs ea{}; Gemm g{WSB(WS_XB), WSB(WS_WQ), M, D, D, D, D}; ea.O = WSB(WS_T); ea.ldc = D; ea.ssp = WSF(WS_SSP + SSPB); ea.cscale = 0.0625f; Epi<E_ROWSCALE> E{ea}; gemm_phase(lds, g, S, E);
            Unit u;
            for (int i = 0; S.next(i, u); ++i) { FRESH_IDS; xattn_wg(WSB(WS_T), WSB(l ? WS_MEMK1 : WS_MEMK), WSB(l ? WS_MEMVT1 : WS_MEMVT), WSB(WS_X2), (u.pm >> 4) * 64 + u.pn * 16 + (u.pm & 15), tid, wave, lane, lds); }
        }
        XBAR();
        {
            StaticOrder S; S.init(M, D, GRID_, BID_);
            EpiArgs ea{}; Gemm g{WSB(WS_X2), WSB(WS_WOX), M, D, D, D, D}; ea.xb = WSB(WS_XB); ea.sspo = WSF(WS_SSP + 2 * SSPB); Epi<E_RESID> E{ea}; gemm_phase(lds, g, S, E);
        }
        XBAR();
        { ProgJ PJ; PJ.init(WSP, GRID_, BID_, l, lds); { FRESH_IDS; fill_rs(lds, PJ, WSF(WS_SSP + 2 * SSPB), tid); } gemm_stream(lds, PJ); }
        if (l + 1 < DEPTH && GRID_ == 256) { const int c_ = __builtin_amdgcn_readfirstlane(BID_); const bool idle_ = (c_ >= 144 && c_ < 160) || c_ >= 176;
            if (idle_) { FRESH_IDS; const int idx_ = c_ < 160 ? c_ - 144 : 16 + (c_ - 176); prep_weights(l + 1, lds, idx_ * NWAVES + wave, 96 * NWAVES, wave, lane, 3); } }
        XBAR();
        {
            StaticOrder S; S.init(M, D, GRID_, BID_);
            EpiArgs ea{}; Gemm g{WSB(WS_P), WSB(WS_WD), M, D, FF, FF, FF}; ea.xb = WSB(WS_XB); ea.sspo = WSF(WS_SSP); Epi<E_RESID> E{ea}; gemm_phase(lds, g, S, E);
        }
        if (l + 1 < DEPTH) { FRESH_IDS; prep_weights(l + 1, lds, GW_, NGW_, wave, lane, GRID_ == 256 ? 4 : 1); }
        XBAR();
    }
    { FRESH_IDS; final_norm(lds, GW_, NGW_, lane); }
}

extern "C" void kernel_launch(void* const* d_in, const int* in_sizes, int n_in, void* d_out, int out_size, void* d_ws, size_t ws_size, hipStream_t stream) {
    static int grid = 0;
    if (grid == 0) {
        if (n_in != 22 || in_sizes[0] != M * D || out_size != M * D || ws_size < WS_END) { fprintf(stderr, "kernel_launch: unexpected shapes (n_in %d, in0 %d, out %d, ws %zu)\n", n_in, n_in > 0 ? in_sizes[0] : -1, out_size, ws_size); grid = -1; return; }
        int dev = 0, cus = 0, per_cu = 0;
        hipGetDevice(&dev); hipDeviceGetAttribute(&cus, hipDeviceAttributeMultiprocessorCount, dev);
        hipFuncSetAttribute((const void*)fwd_megakernel, hipFuncAttributeMaxDynamicSharedMemorySize, LDS_BYTES);
        hipOccupancyMaxActiveBlocksPerMultiprocessor(&per_cu, (const void*)fwd_megakernel, NTHREADS, LDS_BYTES);
        if (per_cu < 1) { fprintf(stderr, "kernel_launch: occupancy query says %d blocks per CU\n", per_cu); per_cu = 1; }
        (void)hipGetLastError();
        grid = cus;
    }
    if (grid < 0) return;
    Args a{};
    for (int i = 0; i < 22; ++i) a.in[i] = (const float*)d_in[i];
    a.out = (float*)d_out; a.ws = (unsigned char*)d_ws;
    void* args[] = {&a};
    hipError_t e = hipLaunchCooperativeKernel((const void*)fwd_megakernel, dim3(grid), dim3(NTHREADS), args, LDS_BYTES, stream);
    if (e != hipSuccess) fprintf(stderr, "cooperative launch failed: %s (grid %d)\n", hipGetErrorString(e), grid);
}
```

```cpp
#include <hip/hip_runtime.h>
#include <hip/hip_cooperative_groups.h>
#include <cstdio>
#include <cstdint>
namespace cg = cooperative_groups;

#define LAS __attribute__((address_space(3)))
typedef unsigned short bf16_t;
typedef short bf16x8 __attribute__((ext_vector_type(8)));
typedef float f32x4 __attribute__((ext_vector_type(4)));
typedef float f32x2 __attribute__((ext_vector_type(2)));
typedef float f32x16 __attribute__((ext_vector_type(16)));
typedef unsigned u32x4 __attribute__((ext_vector_type(4)));
typedef unsigned u32x2 __attribute__((ext_vector_type(2)));
typedef __bf16 bf16x2n __attribute__((ext_vector_type(2)));

#define DI __device__ __forceinline__
DI unsigned pkbf(float lo, float hi) { f32x2 v = {lo, hi}; bf16x2n b = __builtin_convertvector(v, bf16x2n); return __builtin_bit_cast(unsigned, b); }
DI float bflo(unsigned u) { return __uint_as_float(u << 16); }
DI float bfhi(unsigned u) { return __uint_as_float(u & 0xffff0000u); }
DI int fresh_tid() { int t = threadIdx.x; asm volatile("" : "+v"(t)); return t; }
#define MFMA32(a, b, c) __builtin_amdgcn_mfma_f32_32x32x16_bf16((a), (b), (c), 0, 0, 0)

constexpr int M = 16384, D = 1024, SEQ = 4096, NBATCH = 4, DEPTH = 2;
constexpr int PC = 3072;
constexpr int FF = 2816;
constexpr int INC = 7168;
constexpr float RMS_EPS = 1e-6f, LN_EPS = 1e-5f;
constexpr float LOG2E = 1.4426950408889634f, LN2 = 0.6931471805599453f;
constexpr float SB_EXIT = 110.0f;

constexpr size_t MiB = (size_t)1 << 20;
constexpr size_t WS_WIN = 1 * MiB;
constexpr size_t WS_WB = 15 * MiB;
constexpr size_t WS_WOUT = 18 * MiB, WS_WQ = 20 * MiB, WS_WK = 22 * MiB, WS_WV = 24 * MiB, WS_WOX = 26 * MiB;
constexpr size_t WS_WGU = 28 * MiB;
constexpr size_t WS_WD = 39 * MiB;
constexpr size_t WS_MB = 45 * MiB, WS_MEMK = 47 * MiB, WS_MEMVT = 49 * MiB;
constexpr size_t WS_XB = 51 * MiB;
constexpr size_t WS_P = 83 * MiB;
constexpr size_t WS_T = 179 * MiB;
constexpr size_t WS_X2 = 211 * MiB;
constexpr size_t WS_SSP = 243 * MiB;
constexpr size_t WS_WK1 = 246 * MiB, WS_WV1 = 248 * MiB, WS_MB1 = 250 * MiB, WS_MEMK1 = 252 * MiB, WS_MEMVT1 = 254 * MiB;
constexpr size_t WS_END = 256 * MiB;

namespace pg8 {
constexpr int BM = 256, BK = 64, HALF = 128, HTB = HALF * BK * 2, STAGE_BYTES = 8 * HTB, NXCD = 8, WGM = 8;
DI int lds_byte(int r, int c) { const int st = (r >> 4) * 2 + (c >> 5), rr = r & 15, cc = c & 31, ob = rr * 64 + cc * 2; return st * 1024 + (ob ^ (((ob >> 9) & 1) << 5)); }
DI void stage_rc(int b, int& R, int& C) { const int st = b / 1024, sb = b % 1024, swz = sb ^ (((sb >> 9) & 1) << 5); R = (st >> 1) * 16 + swz / 64; C = (st & 1) * 32 + (swz % 64) / 2; }
DI int perm32(int rho) { const int n = rho >> 4, i = rho & 15; return 8 * (i >> 2) + 4 * n + (i & 3); }

struct Unit { int pm, pn; };
struct Gemm { const bf16_t* A; const bf16_t* Bt; int M, N, K, lda, ldb; };

struct StaticOrder {
    int nM, nN, nwg, G, c;
    DI void init(int M_, int N_, int G_, int c_) { nM = M_ / BM; nN = N_ / BM; nwg = nM * nN; G = G_; c = c_; }
    DI bool next(int i, Unit& u) const {
        const long L = (long)i * G + c; if (L >= nwg) return false;
        int wgid = (int)L; { const int q = nwg / NXCD, r = nwg % NXCD, xcd = wgid % NXCD, off = wgid / NXCD; wgid = (xcd < r ? xcd * (q + 1) : r * (q + 1) + (xcd - r) * q) + off; }
        const int nig = WGM * nN, gid = wgid / nig, fm = gid * WGM, gsz = (nM - fm) < WGM ? (nM - fm) : WGM;
        u.pm = fm + ((wgid % nig) % gsz); u.pn = (wgid % nig) / gsz; return true;
    }
};

DI f32x2 gelu_pk(f32x2 v) {
    const f32x2 av = __builtin_elementwise_abs(v), d = av * 0.2316418882f + 1.0f;
    f32x2 t; t.x = __builtin_amdgcn_rcpf(d.x); t.y = __builtin_amdgcn_rcpf(d.y);
    f32x2 q = t * 0.5307027145f + (-0.7265760135f); q = q * t + 0.7107068705f; q = q * t + (-0.142248368f); q = q * t + 0.127414796f; q = q * t;
    const f32x2 s = (v * v) * (-0.72134752044f);
    f32x2 e; e.x = __builtin_amdgcn_exp2f(s.x); e.y = __builtin_amdgcn_exp2f(s.y);
    const f32x2 m = v * (q * e), r = v - m;
    f32x2 o; o.x = v.x < 0.f ? m.x : r.x; o.y = v.y < 0.f ? m.y : r.y; return o;
}
DI f32x4 gelu4(f32x4 v) { f32x2 a = gelu_pk((f32x2){v[0], v[1]}), b = gelu_pk((f32x2){v[2], v[3]}); return (f32x4){a.x, a.y, b.x, b.y}; }
DI float sigmoidf_(float x) { return __builtin_amdgcn_rcpf(1.0f + __builtin_amdgcn_exp2f(-x * LOG2E)); }
DI f32x4 sigmoid4(f32x4 v) { return (f32x4){sigmoidf_(v[0]), sigmoidf_(v[1]), sigmoidf_(v[2]), sigmoidf_(v[3])}; }

DI float row_rs(const float* ssp, int row, int fq) {
    const f32x4 v = *(const f32x4*)(ssp + (size_t)row * 16 + fq * 4);
    float s = (v[0] + v[1]) + (v[2] + v[3]);
    s += __shfl_xor(s, 16); s += __shfl_xor(s, 32);
    return 1.0f / sqrtf(s * (1.0f / D) + RMS_EPS);
}

DI void row_rs8(const float* ssp, int row0, int fq, float (&rs)[2][4]) {
    f32x4 v[2][4];
#pragma unroll
    for (int ai = 0; ai < 2; ++ai)
#pragma unroll
        for (int m = 0; m < 4; ++m) v[ai][m] = *(const f32x4*)(ssp + (size_t)(row0 + ai * HALF + m * 16) * 16 + fq * 4);
    asm volatile("" ::: "memory");
#pragma unroll
    for (int ai = 0; ai < 2; ++ai)
#pragma unroll
        for (int m = 0; m < 4; ++m) { float s = (v[ai][m][0] + v[ai][m][1]) + (v[ai][m][2] + v[ai][m][3]); s += __shfl_xor(s, 16); s += __shfl_xor(s, 32); rs[ai][m] = 1.0f / sqrtf(s * (1.0f / D) + RMS_EPS); }
}

DI void row_rs8_lds(const LAS float* tab, int wr, int fr, float (&rs)[2][4]) {
#pragma unroll
    for (int ai = 0; ai < 2; ++ai)
#pragma unroll
        for (int m = 0; m < 4; ++m) rs[ai][m] = tab[ai * HALF + wr * 64 + m * 16 + fr];
}

enum { E_INPROJ = 0, E_TRANS = 1, E_GATE = 2, E_BR0 = 3, E_BRN = 4, E_RESID = 5, E_ROWSCALE = 6, E_SWIGLU = 7 };
struct EpiArgs {
    bf16_t* O; int ldc;
    const float* ssp;
    float cscale;
    const float* xsrc; float* xdst; bf16_t* xb; float* sspo;
    const bf16_t* G;
    const LAS float* rstab;
};
template <int MODE> struct Epi {
    static constexpr bool PERM = true;
    EpiArgs a;
    DI void store8(bf16_t* p, f32x4 v0, f32x4 v1) const { u32x4 w; w.x = pkbf(v0[0], v0[1]); w.y = pkbf(v0[2], v0[3]); w.z = pkbf(v1[0], v1[1]); w.w = pkbf(v1[2], v1[3]); *(u32x4*)p = w; }
    DI void operator()(const f32x4 (&acc)[2][2][4][2], const Unit& u, int wr, int wc, int fr, int fq) const {
        const int row0 = u.pm * BM + wr * 64 + fr, col0 = u.pn * BM + wc * 32 + 8 * fq;
        if constexpr (MODE == E_TRANS) {
            float rsc[2][8];
            if (a.rstab) {
#pragma unroll
                for (int bj = 0; bj < 2; ++bj) { const f32x4 t0 = *(const LAS f32x4*)(a.rstab + bj * HALF + wc * 32 + 8 * fq), t1 = *(const LAS f32x4*)(a.rstab + bj * HALF + wc * 32 + 8 * fq + 4);
                    rsc[bj][0] = t0[0]; rsc[bj][1] = t0[1]; rsc[bj][2] = t0[2]; rsc[bj][3] = t0[3]; rsc[bj][4] = t1[0]; rsc[bj][5] = t1[1]; rsc[bj][6] = t1[2]; rsc[bj][7] = t1[3]; }
            } else if (a.ssp) {
                const int lane = fq * 16 + fr, tok = u.pn * BM + (lane >> 5) * HALF + wc * 32 + (lane & 31);
                const f32x4* sp = (const f32x4*)(a.ssp + (size_t)tok * 16);
                const f32x4 s0 = sp[0], s1 = sp[1], s2 = sp[2], s3 = sp[3];
                const float s = ((s0[0] + s0[1]) + (s0[2] + s0[3])) + ((s1[0] + s1[1]) + (s1[2] + s1[3])) + ((s2[0] + s2[1]) + (s2[2] + s2[3])) + ((s3[0] + s3[1]) + (s3[2] + s3[3]));
                const float rs = 1.0f / sqrtf(s * (1.0f / D) + RMS_EPS);
#pragma unroll
                for (int bj = 0; bj < 2; ++bj)
#pragma unroll
                    for (int e = 0; e < 8; ++e) rsc[bj][e] = __shfl(rs, bj * 32 + 8 * fq + e);
            } else {
#pragma unroll
                for (int bj = 0; bj < 2; ++bj)
#pragma unroll
                    for (int e = 0; e < 8; ++e) rsc[bj][e] = 1.0f;
            }
            const bool act = a.ssp != nullptr && u.pm >= 2;
#pragma unroll
            for (int ai = 0; ai < 2; ++ai)
#pragma unroll
                for (int m = 0; m < 4; ++m) { bf16_t* rowp = a.O + (size_t)(row0 + ai * HALF + m * 16) * a.ldc + col0;
#pragma unroll
                    for (int bj = 0; bj < 2; ++bj) {
                        f32x4 v0 = acc[ai][bj][m][0], v1 = acc[ai][bj][m][1];
                        v0 = v0 * (f32x4){rsc[bj][0], rsc[bj][1], rsc[bj][2], rsc[bj][3]}; v1 = v1 * (f32x4){rsc[bj][4], rsc[bj][5], rsc[bj][6], rsc[bj][7]};
                        if (act) { v0 = gelu4(v0); v1 = gelu4(v1); }
                        store8(rowp + bj * HALF, v0, v1); } }
        } else if constexpr (MODE == E_RESID) {
#pragma unroll
            for (int ai = 0; ai < 2; ++ai) {
                u32x4 xw[4][2];
#pragma unroll
                for (int m = 0; m < 4; ++m)
#pragma unroll
                    for (int bj = 0; bj < 2; ++bj) xw[m][bj] = *(const u32x4*)(a.xb + (size_t)(row0 + ai * HALF + m * 16) * D + col0 + bj * HALF);
                asm volatile("" ::: "memory");
#pragma unroll
                for (int m = 0; m < 4; ++m) { const int row = row0 + ai * HALF + m * 16; const size_t off = (size_t)row * D + col0; float ss = 0.f;
#pragma unroll
                    for (int bj = 0; bj < 2; ++bj) { const u32x4 w = xw[m][bj];
                        const f32x4 v0 = (f32x4){bflo(w.x), bfhi(w.x), bflo(w.y), bfhi(w.y)} + acc[ai][bj][m][0], v1 = (f32x4){bflo(w.z), bfhi(w.z), bflo(w.w), bfhi(w.w)} + acc[ai][bj][m][1];
                        store8(a.xb + off + bj * HALF, v0, v1);
                        ss += (v0[0] * v0[0] + v0[1] * v0[1]) + (v0[2] * v0[2] + v0[3] * v0[3]) + (v1[0] * v1[0] + v1[1] * v1[1]) + (v1[2] * v1[2] + v1[3] * v1[3]); }
                    ss += __shfl_xor(ss, 16); ss += __shfl_xor(ss, 32);
                    if (fq == 0) a.sspo[(size_t)row * 16 + u.pn * 4 + wc] = ss; }
            }
        } else if constexpr (MODE == E_SWIGLU) {
            const int ocol = u.pn * HALF + wc * 32 + 8 * fq;
            float rs8[2][4]; if (a.rstab) row_rs8_lds(a.rstab, wr, fr, rs8); else row_rs8(a.ssp, row0, fq, rs8);
#pragma unroll
            for (int ai = 0; ai < 2; ++ai)
#pragma unroll
                for (int m = 0; m < 4; ++m) { const int row = row0 + ai * HALF + m * 16; const float rs = rs8[ai][m];
                    const f32x4 g0 = acc[ai][0][m][0] * rs, g1 = acc[ai][0][m][1] * rs, u0 = acc[ai][1][m][0] * rs, u1 = acc[ai][1][m][1] * rs;
                    store8(a.O + (size_t)row * a.ldc + ocol, g0 * sigmoid4(g0) * u0, g1 * sigmoid4(g1) * u1); }
        } else {
            float sc = a.cscale; bool gelu = false;
            if constexpr (MODE == E_INPROJ) { sc = (u.pn < 2) ? 0.125f : 1.0f; gelu = (u.pn == 4 || u.pn == 5); }
            if constexpr (MODE == E_INPROJ || MODE == E_GATE || MODE == E_ROWSCALE) {
                float rs8[2][4];
                if (a.rstab) row_rs8_lds(a.rstab, wr, fr, rs8); else if (a.ssp) row_rs8(a.ssp, row0, fq, rs8); else {
#pragma unroll
                    for (int ai = 0; ai < 2; ++ai)
#pragma unroll
                        for (int m = 0; m < 4; ++m) rs8[ai][m] = 1.0f; }
#pragma unroll
                for (int ai = 0; ai < 2; ++ai)
#pragma unroll
                    for (int m = 0; m < 4; ++m) { const int row = row0 + ai * HALF + m * 16; const float rs = sc * rs8[ai][m];
#pragma unroll
                        for (int bj = 0; bj < 2; ++bj) { const size_t off = (size_t)row * a.ldc + col0 + bj * HALF;
                            f32x4 v0 = acc[ai][bj][m][0] * rs, v1 = acc[ai][bj][m][1] * rs;
                            if constexpr (MODE == E_INPROJ) { if (gelu) { v0 = gelu4(v0); v1 = gelu4(v1); } }
                            else if constexpr (MODE == E_GATE) { v0 = sigmoid4(v0); v1 = sigmoid4(v1); }
                            store8(a.O + off, v0, v1); } }
            } else {
#pragma unroll
                for (int ai = 0; ai < 2; ++ai) {
                    u32x4 gw[4][2], pw[4][2];
#pragma unroll
                    for (int m = 0; m < 4; ++m)
#pragma unroll
                        for (int bj = 0; bj < 2; ++bj) { const size_t off = (size_t)(row0 + ai * HALF + m * 16) * a.ldc + col0 + bj * HALF;
                            gw[m][bj] = *(const u32x4*)(a.G + off); if constexpr (MODE == E_BRN) pw[m][bj] = *(const u32x4*)(a.O + off); }
                    asm volatile("" ::: "memory");
#pragma unroll
                    for (int m = 0; m < 4; ++m)
#pragma unroll
                        for (int bj = 0; bj < 2; ++bj) { const size_t off = (size_t)(row0 + ai * HALF + m * 16) * a.ldc + col0 + bj * HALF; const u32x4 g = gw[m][bj];
                            f32x4 v0 = acc[ai][bj][m][0] * (f32x4){bflo(g.x), bfhi(g.x), bflo(g.y), bfhi(g.y)}, v1 = acc[ai][bj][m][1] * (f32x4){bflo(g.z), bfhi(g.z), bflo(g.w), bfhi(g.w)};
                            if constexpr (MODE == E_BRN) { const u32x4 q = pw[m][bj];
                                v0 = v0 + (f32x4){bflo(q.x), bfhi(q.x), bflo(q.y), bfhi(q.y)}; v1 = v1 + (f32x4){bflo(q.z), bfhi(q.z), bflo(q.w), bfhi(q.w)}; }
                            store8(a.O + off, v0, v1); }
                }
            }
        }
    }
};

template <class EpiT>
DI void gemm_phase(LAS unsigned char* lds, const Gemm g, const StaticOrder& S, const EpiT& E) {
    const int tid = fresh_tid(), wid = __builtin_amdgcn_readfirstlane(tid >> 6), lane = tid & 63, wr = wid >> 2, wc = wid & 3, fr = lane & 15, fq = lane >> 4;
    const int nt = g.K / BK;
    unsigned voffA[2], voffB[2];
#pragma unroll
    for (int i = 0; i < 2; ++i) { int R, C; stage_rc(tid * 16 + i * 8192, R, C); const int Rb = EpiT::PERM ? ((R & ~31) + perm32(R & 31)) : R;
        voffA[i] = (unsigned)(R * g.lda + C) * 2u; voffB[i] = (unsigned)(Rb * g.ldb + C) * 2u; }
    const size_t kstep = (size_t)(BK * 2);
    const size_t hstepA = (size_t)HALF * g.lda * 2, hstepB = (size_t)HALF * g.ldb * 2;
    const size_t tstepA = 2 * hstepA, tstepB = 2 * hstepB;
    const unsigned ldsw = (unsigned)wid * 1024u;
    const int aoff = lds_byte(wr * 64 + fr, fq * 8), boff = lds_byte(wc * 32 + fr, fq * 8);
#define PG8_SA(b, h) (((b) * 2 + (h)) * HTB)
#define PG8_SB(b, h) ((4 + (b) * 2 + (h)) * HTB)
#define PG8_STAGE(bufoff, gbase, voff) do { _Pragma("unroll") for (int _i = 0; _i < 2; ++_i) \
        __builtin_amdgcn_global_load_lds((const unsigned*)((const char*)(gbase) + (voff)[_i]), (LAS unsigned*)(lds + (bufoff) + ldsw + _i * 8192), 16, 0, 0); } while (0)
#define PG8_LDA(dst, b, h) do { _Pragma("unroll") for (int m = 0; m < 4; ++m) _Pragma("unroll") for (int k = 0; k < 2; ++k) dst[m][k] = *(const LAS bf16x8*)(lds + PG8_SA(b, h) + aoff + m * 2048 + k * 1024); } while (0)
#define PG8_LDB(dst, b, h) do { _Pragma("unroll") for (int n = 0; n < 2; ++n) _Pragma("unroll") for (int k = 0; k < 2; ++k) dst[n][k] = *(const LAS bf16x8*)(lds + PG8_SB(b, h) + boff + n * 2048 + k * 1024); } while (0)
#define PG8_MMA(ai, bj, At, Bt) do { __builtin_amdgcn_s_setprio(1); _Pragma("unroll") for (int m = 0; m < 4; ++m) _Pragma("unroll") for (int n = 0; n < 2; ++n) _Pragma("unroll") for (int k = 0; k < 2; ++k) \
        acc[ai][bj][m][n] = __builtin_amdgcn_mfma_f32_16x16x32_bf16(Bt[n][k], At[m][k], acc[ai][bj][m][n], 0, 0, 0); __builtin_amdgcn_s_setprio(0); } while (0)
#define PG8_WAIT_V(n) asm volatile("s_waitcnt vmcnt(" #n ")" ::: "memory")
#define PG8_WAIT_L(n) asm volatile("s_waitcnt lgkmcnt(" #n ")" ::: "memory")
#define PG8_BAR __builtin_amdgcn_s_barrier()
#define PG8_SCHED __builtin_amdgcn_sched_barrier(0)
    Unit cur, nxt; int ui = 0;
    if (!S.next(0, cur)) return;
    f32x4 acc[2][2][4][2];
#pragma unroll
    for (int a = 0; a < 2; ++a)
#pragma unroll
        for (int b = 0; b < 2; ++b)
#pragma unroll
            for (int m = 0; m < 4; ++m)
#pragma unroll
                for (int n = 0; n < 2; ++n) acc[a][b][m][n] = (f32x4){0.f, 0.f, 0.f, 0.f};
    bf16x8 At[4][2], B0[2][2], B1[2][2];
    const char* cA = (const char*)g.A + (size_t)cur.pm * tstepA; const char* cB = (const char*)g.Bt + (size_t)cur.pn * tstepB;
    PG8_STAGE(PG8_SB(0, 0), cB, voffB); PG8_STAGE(PG8_SB(0, 1), cB + hstepB, voffB); PG8_STAGE(PG8_SA(0, 0), cA, voffA); PG8_STAGE(PG8_SA(0, 1), cA + hstepA, voffA);
    if (wr == 1) PG8_BAR;
    PG8_WAIT_V(2); PG8_BAR;
    PG8_STAGE(PG8_SB(1, 0), cB + kstep, voffB); PG8_STAGE(PG8_SA(1, 0), cA + kstep, voffA); PG8_STAGE(PG8_SB(1, 1), cB + hstepB + kstep, voffB);
    PG8_WAIT_V(6); PG8_BAR;
    for (;;) {
        const bool has_next = S.next(ui + 1, nxt);
        const char* nA = has_next ? (const char*)g.A + (size_t)nxt.pm * tstepA : cA; const char* nB = has_next ? (const char*)g.Bt + (size_t)nxt.pn * tstepB : cB;
        for (int t = 0; t < nt; t += 2) {
            const bool last = (t == nt - 2);
            const char* a1 = cA + (size_t)(t + 1) * kstep;
            const char* a2 = last ? nA : cA + (size_t)(t + 2) * kstep; const char* b2 = last ? nB : cB + (size_t)(t + 2) * kstep;
            const char* a3 = a2 + kstep; const char* b3 = b2 + kstep;
            PG8_LDB(B0, 0, 0); PG8_LDB(B1, 0, 1); PG8_SCHED; PG8_LDA(At, 0, 0); PG8_STAGE(PG8_SA(1, 1), a1 + hstepA, voffA);
            PG8_WAIT_V(8); PG8_WAIT_L(0); PG8_BAR; PG8_MMA(0, 0, At, B0); PG8_MMA(0, 1, At, B1); PG8_BAR; PG8_SCHED;
            PG8_LDA(At, 0, 1); PG8_STAGE(PG8_SB(0, 0), b2, voffB); PG8_STAGE(PG8_SB(0, 1), b2 + hstepB, voffB); PG8_STAGE(PG8_SA(0, 0), a2, voffA);
            PG8_WAIT_V(8); PG8_WAIT_L(0); PG8_BAR; PG8_MMA(1, 0, At, B0); PG8_MMA(1, 1, At, B1); PG8_BAR; PG8_SCHED;
            PG8_LDB(B0, 1, 0); PG8_LDB(B1, 1, 1); PG8_SCHED; PG8_LDA(At, 1, 0); PG8_STAGE(PG8_SA(0, 1), a2 + hstepA, voffA);
            PG8_WAIT_V(8); PG8_WAIT_L(0); PG8_BAR; PG8_MMA(0, 0, At, B0); PG8_MMA(0, 1, At, B1); PG8_BAR; PG8_SCHED;
            PG8_LDA(At, 1, 1); PG8_STAGE(PG8_SB(1, 0), b3, voffB); PG8_STAGE(PG8_SB(1, 1), b3 + hstepB, voffB); PG8_STAGE(PG8_SA(1, 0), a3, voffA);
            PG8_WAIT_V(8); PG8_WAIT_L(0); PG8_BAR; PG8_MMA(1, 0, At, B0); PG8_MMA(1, 1, At, B1); PG8_BAR; PG8_SCHED;
        }
        if (wr == 0) PG8_BAR;
        E(acc, cur, wr, wc, fr, fq);
        if (!has_next) break;
#pragma unroll
        for (int a = 0; a < 2; ++a)
#pragma unroll
            for (int b = 0; b < 2; ++b)
#pragma unroll
                for (int m = 0; m < 4; ++m)
#pragma unroll
                    for (int n = 0; n < 2; ++n) acc[a][b][m][n] = (f32x4){0.f, 0.f, 0.f, 0.f};
        cur = nxt; cA = nA; cB = nB; ++ui;
        if (wr == 1) PG8_BAR;
    }
    PG8_WAIT_V(0);
    PG8_BAR;

}

struct UnitX { int pm, pn, job, k; };
struct JobP { const bf16_t* A; const bf16_t* Bt; int lda, ldb, nt; };
template <class Prog>
DI void gemm_stream(LAS unsigned char* lds, Prog& P) {
    const int tid = fresh_tid(), wid = __builtin_amdgcn_readfirstlane(tid >> 6), lane = tid & 63, wr = wid >> 2, wc = wid & 3, fr = lane & 15, fq = lane >> 4;
    const size_t kstep = (size_t)(BK * 2);
    const unsigned ldsw = (unsigned)wid * 1024u;
    const int aoff = lds_byte(wr * 64 + fr, fq * 8), boff = lds_byte(wc * 32 + fr, fq * 8);
#define PG8_VOFF(vA, vB, j) do { _Pragma("unroll") for (int _i = 0; _i < 2; ++_i) { int sR_, sC_; stage_rc(tid * 16 + _i * 8192, sR_, sC_); const int sRb_ = (sR_ & ~31) + perm32(sR_ & 31); \
        vA[_i] = (unsigned)(sR_ * (j).lda + sC_) * 2u; vB[_i] = (unsigned)(sRb_ * (j).ldb + sC_) * 2u; } } while (0)
    UnitX cur, nxt;
    if (!P.next(cur)) return;
    JobP jc = P.job(cur.job);
    unsigned voffA[2], voffB[2], voffAn[2], voffBn[2];
    PG8_VOFF(voffA, voffB, jc);
    unsigned hstepA = (unsigned)(HALF * jc.lda * 2), hstepB = (unsigned)(HALF * jc.ldb * 2), hstepAn, hstepBn;
    int nt = jc.nt;
    f32x4 acc[2][2][4][2];
#pragma unroll
    for (int a = 0; a < 2; ++a)
#pragma unroll
        for (int b = 0; b < 2; ++b)
#pragma unroll
            for (int m = 0; m < 4; ++m)
#pragma unroll
                for (int n = 0; n < 2; ++n) acc[a][b][m][n] = (f32x4){0.f, 0.f, 0.f, 0.f};
    bf16x8 At[4][2], B0[2][2], B1[2][2];
    const char* cA = (const char*)jc.A + (size_t)cur.pm * 2 * hstepA; const char* cB = (const char*)jc.Bt + (size_t)cur.pn * 2 * hstepB;
    PG8_STAGE(PG8_SB(0, 0), cB, voffB); PG8_STAGE(PG8_SB(0, 1), cB + hstepB, voffB); PG8_STAGE(PG8_SA(0, 0), cA, voffA); PG8_STAGE(PG8_SA(0, 1), cA + hstepA, voffA);
    if (wr == 1) PG8_BAR;
    PG8_WAIT_V(2); PG8_BAR;
    PG8_STAGE(PG8_SB(1, 0), cB + kstep, voffB); PG8_STAGE(PG8_SA(1, 0), cA + kstep, voffA); PG8_STAGE(PG8_SB(1, 1), cB + hstepB + kstep, voffB);
    PG8_WAIT_V(6); PG8_BAR;
    for (;;) {
        const bool has_next = P.next(nxt);
        const char* nA = cA; const char* nB = cB; int ntn = nt;
        hstepAn = hstepA; hstepBn = hstepB; voffAn[0] = voffA[0]; voffAn[1] = voffA[1]; voffBn[0] = voffB[0]; voffBn[1] = voffB[1];
        if (has_next) { const JobP jn = P.job(nxt.job); PG8_VOFF(voffAn, voffBn, jn); hstepAn = (unsigned)(HALF * jn.lda * 2); hstepBn = (unsigned)(HALF * jn.ldb * 2); ntn = jn.nt;
            nA = (const char*)jn.A + (size_t)nxt.pm * 2 * hstepAn; nB = (const char*)jn.Bt + (size_t)nxt.pn * 2 * hstepBn; }
        for (int t = 0; t < nt; t += 2) {
            const bool last = (t == nt - 2);
            const char* a1 = cA + (size_t)(t + 1) * kstep;
            const char* a2 = last ? nA : cA + (size_t)(t + 2) * kstep; const char* b2 = last ? nB : cB + (size_t)(t + 2) * kstep;
            const char* a3 = a2 + kstep; const char* b3 = b2 + kstep;
            const unsigned hA2 = last ? hstepAn : hstepA, hB2 = last ? hstepBn : hstepB;
            unsigned vA2[2], vB2[2];
            vA2[0] = last ? voffAn[0] : voffA[0]; vA2[1] = last ? voffAn[1] : voffA[1]; vB2[0] = last ? voffBn[0] : voffB[0]; vB2[1] = last ? voffBn[1] : voffB[1];
            PG8_LDB(B0, 0, 0); PG8_LDB(B1, 0, 1); PG8_SCHED; PG8_LDA(At, 0, 0); PG8_STAGE(PG8_SA(1, 1), a1 + hstepA, voffA);
            PG8_WAIT_V(8); PG8_WAIT_L(0); PG8_BAR; PG8_MMA(0, 0, At, B0); PG8_MMA(0, 1, At, B1); PG8_BAR; PG8_SCHED;
            PG8_LDA(At, 0, 1); PG8_STAGE(PG8_SB(0, 0), b2, vB2); PG8_STAGE(PG8_SB(0, 1), b2 + hB2, vB2); PG8_STAGE(PG8_SA(0, 0), a2, vA2);
            PG8_WAIT_V(8); PG8_WAIT_L(0); PG8_BAR; PG8_MMA(1, 0, At, B0); PG8_MMA(1, 1, At, B1); PG8_BAR; PG8_SCHED;
            PG8_LDB(B0, 1, 0); PG8_LDB(B1, 1, 1); PG8_SCHED; PG8_LDA(At, 1, 0); PG8_STAGE(PG8_SA(0, 1), a2 + hA2, vA2);
            PG8_WAIT_V(8); PG8_WAIT_L(0); PG8_BAR; PG8_MMA(0, 0, At, B0); PG8_MMA(0, 1, At, B1); PG8_BAR; PG8_SCHED;
            PG8_LDA(At, 1, 1); PG8_STAGE(PG8_SB(1, 0), b3, vB2); PG8_STAGE(PG8_SB(1, 1), b3 + hB2, vB2); PG8_STAGE(PG8_SA(1, 0), a3, vA2);
            PG8_WAIT_V(8); PG8_WAIT_L(0); PG8_BAR; PG8_MMA(1, 0, At, B0); PG8_MMA(1, 1, At, B1); PG8_BAR; PG8_SCHED;
        }
        if (wr == 0) PG8_BAR;
        P.epilogue(acc, cur, wr, wc, fr, fq);
        if (!has_next) break;
#pragma unroll
        for (int a = 0; a < 2; ++a)
#pragma unroll
            for (int b = 0; b < 2; ++b)
#pragma unroll
                for (int m = 0; m < 4; ++m)
#pragma unroll
                    for (int n = 0; n < 2; ++n) acc[a][b][m][n] = (f32x4){0.f, 0.f, 0.f, 0.f};
        cur = nxt; cA = nA; cB = nB; nt = ntn; hstepA = hstepAn; hstepB = hstepBn; voffA[0] = voffAn[0]; voffA[1] = voffAn[1]; voffB[0] = voffBn[0]; voffB[1] = voffBn[1];
        if (wr == 1) PG8_BAR;
    }
    PG8_WAIT_V(0);
    PG8_BAR;
#undef PG8_VOFF
}
#undef PG8_SA
#undef PG8_SB
#undef PG8_STAGE
#undef PG8_LDA
#undef PG8_LDB
#undef PG8_MMA
#undef PG8_WAIT_V
#undef PG8_WAIT_L
#undef PG8_BAR
#undef PG8_SCHED
}

constexpr int NWAVES = 8, NTHREADS = 512;
constexpr int LDS_BYTES = 147456;

DI float wave_sum(float v) {
#pragma unroll
    for (int o = 1; o < 64; o <<= 1) v += __shfl_xor(v, o);
    return v;
}

DI void transpose_item(const float* W, int K, int N, const float* gk, bf16_t* WT, int dst_row0, int k0, int n0, LAS float* scr, int lane) {
    f32x4 wv[8]; float gv[8];
#pragma unroll
    for (int i = 0; i < 8; ++i) { const int kk = 8 * i + (lane >> 3), nq = (lane & 7) * 4; wv[i] = __builtin_nontemporal_load((const f32x4*)(W + (size_t)(k0 + kk) * N + n0 + nq));     gv[i] = gk ? gk[k0 + kk] : 1.0f; }
    asm volatile("" ::: "memory");
#pragma unroll
    for (int i = 0; i < 8; ++i) { const int kk = 8 * i + (lane >> 3), nq = (lane & 7) * 4; const f32x4 w = wv[i] * gv[i];
        LAS float* d = scr + kk * 33 + nq; d[0] = w[0]; d[1] = w[1]; d[2] = w[2]; d[3] = w[3]; }
    asm volatile("s_waitcnt lgkmcnt(0)" ::: "memory");
    const int c = lane & 7;
#pragma unroll
    for (int j = 0; j < 4; ++j) { const int n = (lane >> 3) + 8 * j; const LAS float* s = scr + (8 * c) * 33 + n;
        u32x4 o; o.x = pkbf(s[0 * 33], s[1 * 33]); o.y = pkbf(s[2 * 33], s[3 * 33]); o.z = pkbf(s[4 * 33], s[5 * 33]); o.w = pkbf(s[6 * 33], s[7 * 33]);
        *(u32x4*)(WT + (size_t)(dst_row0 + n) * K + k0 + 8 * c) = o; }
    asm volatile("s_waitcnt lgkmcnt(0)" ::: "memory");
}

struct Args { const float* in[22]; float* out; unsigned char* ws; };
constexpr int PTR_OFF = 131072;
DI unsigned long long ldq(LAS unsigned char* lds, int i) {
    unsigned off = (unsigned)(PTR_OFF + 8 * i); asm volatile("" : "+v"(off));
    const unsigned long long v = *(const LAS unsigned long long*)(lds + off);
    const unsigned lo = __builtin_amdgcn_readfirstlane((unsigned)v), hi = __builtin_amdgcn_readfirstlane((unsigned)(v >> 32));
    return ((unsigned long long)hi << 32) | lo;
}
#define GAS __attribute__((address_space(1)))
#define INP(i) ((const float*)(const GAS float*)ldq(lds, (i)))
#define OUTP ((float*)(GAS float*)ldq(lds, 22))
#define WSP ((unsigned char*)(GAS unsigned char*)ldq(lds, 23))

DI void prep_weights(int l, LAS unsigned char* lds, int gw, int NGW, int wave, int lane, int part = 0) {
    LAS float* scr = (LAS float*)(lds + wave * 16384);
    unsigned char* ws = WSP;
    constexpr int I_IN = 16 * 224, I_BR = 8 * 32, I_SQ = 16 * 32, I_GU = 16 * 88, I_DN = 44 * 32;
    constexpr int NSQ = 7; constexpr int NITEMS = I_IN + 3 * I_BR + NSQ * I_SQ + 2 * I_GU + I_DN;
    constexpr int I_EARLY = I_IN + 3 * I_BR + NSQ * I_SQ;
    constexpr int I_P5 = I_IN + 2 * I_SQ, I_P6 = NITEMS - I_P5;
    const int it_lo = part == 2 ? NITEMS - I_DN : (part == 4 ? I_EARLY : 0);
    const int it_hi = part == 3 ? I_EARLY : ((part == 1 || part == 4) ? NITEMS - I_DN : (part == 5 ? I_P5 : (part == 6 ? I_P6 : NITEMS)));
    for (int it = it_lo + gw; it < it_hi; it += NGW) {
        int r = it;
        if (part == 5) r = it < I_IN ? it : I_IN + 3 * I_BR + 2 * I_SQ + (it - I_IN);
        if (part == 6) r = it < 3 * I_BR + 2 * I_SQ ? I_IN + it : I_IN + it + 2 * I_SQ;
        if (r < I_IN) { const int kb = r / 224, nb = r % 224, n0 = nb * 32, seg = n0 >> 9;
            int base;
            switch (seg) { case 0: base = 0; break; case 1: base = 512; break; case 2: base = 3072; break; case 3: base = 1024; break; case 4: base = 3584; break;
                           case 5: base = 1536; break; case 6: base = 2048; break; case 7: base = 2560; break; default: base = seg * 512; break; }
            transpose_item(INP(3) + (size_t)l * D * INC, D, INC, INP(2) + l * D, (bf16_t*)(ws + WS_WIN), base + (n0 & 511), kb * 64, n0, scr, lane); continue; }
        r -= I_IN;
        if (r < 3 * I_BR) { const int n = r / I_BR, q = r % I_BR, kb = q / 32, nb = q % 32;
            transpose_item(INP(9) + ((size_t)l * 3 + n) * 512 * D, 512, D, nullptr, (bf16_t*)(ws + WS_WB) + (size_t)n * D * 512, nb * 32, kb * 64, nb * 32, scr, lane); continue; }
        r -= 3 * I_BR;
        if (r < NSQ * I_SQ) { const int w = r / I_SQ, q = r % I_SQ, kb = q / 32, nb = q % 32;
            const float* src; const float* gk = nullptr; size_t dst;
            if (l == 0 && w >= 5) {
                transpose_item(INP(w == 5 ? 14 : 15) + (size_t)D * D, D, D, nullptr, (bf16_t*)(ws + (w == 5 ? WS_WK1 : WS_WV1)), nb * 32, kb * 64, nb * 32, scr, lane); continue; }
            if (w >= 5 || (l == 1 && (w == 2 || w == 3))) continue;
            switch (w) { case 0: src = INP(10); dst = WS_WOUT; break; case 1: src = INP(13); dst = WS_WQ; gk = INP(11) + l * D; break; case 2: src = INP(14); dst = WS_WK; break;
                         case 3: src = INP(15); dst = WS_WV; break; default: src = INP(16); dst = WS_WOX; break; }
            transpose_item(src + (size_t)l * D * D, D, D, gk, (bf16_t*)(ws + dst), nb * 32, kb * 64, nb * 32, scr, lane); continue; }
        r -= NSQ * I_SQ;
        if (r < 2 * I_GU) { const int w = r / I_GU, q = r % I_GU, kb = q / 88, nb = q % 88, n0 = nb * 32;
            transpose_item(INP(18 + w) + (size_t)l * D * FF, D, FF, INP(17) + l * D, (bf16_t*)(ws + WS_WGU), (n0 >> 7) * 256 + w * 128 + (n0 & 127), kb * 64, n0, scr, lane); continue; }
        r -= 2 * I_GU;
        { const int kb = r / 32, nb = r % 32;
          transpose_item(INP(20) + (size_t)l * FF * D, FF, D, nullptr, (bf16_t*)(ws + WS_WD), nb * 32, kb * 64, nb * 32, scr, lane); }
    }
    if (l == 0 && (part == 0 || part == 5)) {
        for (int row2 = gw; row2 < 2 * NBATCH * 256; row2 += NGW) {
            const int lay = row2 >> 10, row = row2 & 1023; const float* mg = INP(12) + lay * D;
            const f32x4* xr = (const f32x4*)(INP(1) + (size_t)row * D) + lane; f32x4 v[4]; float s = 0.f;
#pragma unroll
            for (int j = 0; j < 4; ++j) { v[j] = xr[64 * j]; s += (v[j][0] * v[j][0] + v[j][1] * v[j][1]) + (v[j][2] * v[j][2] + v[j][3] * v[j][3]); }
            const float rs = 1.0f / sqrtf(wave_sum(s) * (1.0f / D) + RMS_EPS);
            u32x2* o = (u32x2*)((bf16_t*)(ws + (lay ? WS_MB1 : WS_MB)) + (size_t)row * D) + lane;
#pragma unroll
            for (int j = 0; j < 4; ++j) { const f32x4 gv = *((const f32x4*)mg + lane + 64 * j); u32x2 w; w.x = pkbf(v[j][0] * rs * gv[0], v[j][1] * rs * gv[1]); w.y = pkbf(v[j][2] * rs * gv[2], v[j][3] * rs * gv[3]); o[64 * j] = w; }
        }
    }
}

DI void prep_x(LAS unsigned char* lds, int gw, int NGW, int lane) {
    unsigned char* ws = WSP; const float* xin = INP(0);
    float* ssp = (float*)(ws + WS_SSP);
    constexpr int NR = 4;
    for (int row0 = gw; row0 < M; row0 += NR * NGW) {
        f32x4 v[NR][4];
#pragma unroll
        for (int r = 0; r < NR; ++r) { const int row = row0 + r * NGW < M ? row0 + r * NGW : row0; const f32x4* xr = (const f32x4*)(xin + (size_t)row * D) + lane;
#pragma unroll
            for (int j = 0; j < 4; ++j) v[r][j] = __builtin_nontemporal_load(xr + 64 * j); }
        asm volatile("" ::: "memory");
#pragma unroll
        for (int r = 0; r < NR; ++r) { const int row = row0 + r * NGW; if (row < M) { float s = 0.f;
#pragma unroll
            for (int j = 0; j < 4; ++j) s += (v[r][j][0] * v[r][j][0] + v[r][j][1] * v[r][j][1]) + (v[r][j][2] * v[r][j][2] + v[r][j][3] * v[r][j][3]);
            s = wave_sum(s);
            u32x2* o = (u32x2*)((bf16_t*)(ws + WS_XB) + (size_t)row * D) + lane;
#pragma unroll
            for (int j = 0; j < 4; ++j) { u32x2 w; w.x = pkbf(v[r][j][0], v[r][j][1]); w.y = pkbf(v[r][j][2], v[r][j][3]); o[64 * j] = w; }
            if (lane < 16) ssp[(size_t)row * 16 + lane] = lane == 0 ? s : 0.f; } }
    }
}

DI void final_norm(LAS unsigned char* lds, int gw, int NGW, int lane) {
    const float* fg = INP(21); float* outp = OUTP; const float* ssp = (const float*)(WSP + WS_SSP); const bf16_t* xb = (const bf16_t*)(WSP + WS_XB);
    f32x4 gv[4];
#pragma unroll
    for (int j = 0; j < 4; ++j) gv[j] = *((const f32x4*)fg + lane + 64 * j);
    constexpr int NR = 4;
    for (int row0 = gw; row0 < M; row0 += NR * NGW) {
        u32x2 w[NR][4]; float sp[NR];
#pragma unroll
        for (int r = 0; r < NR; ++r) { const int row = row0 + r * NGW < M ? row0 + r * NGW : row0; const u32x2* xbr = (const u32x2*)(xb + (size_t)row * D) + lane;
            sp[r] = lane < 16 ? ssp[(size_t)row * 16 + lane] : 0.f;
#pragma unroll
            for (int j = 0; j < 4; ++j) w[r][j] = __builtin_nontemporal_load(xbr + 64 * j); }
        asm volatile("" ::: "memory");
#pragma unroll
        for (int r = 0; r < NR; ++r) { const int row = row0 + r * NGW; if (row < M) {
            const float rs = 1.0f / sqrtf(wave_sum(sp[r]) * (1.0f / D) + RMS_EPS);
            f32x4* xr = (f32x4*)(outp + (size_t)row * D) + lane;
#pragma unroll
            for (int j = 0; j < 4; ++j) __builtin_nontemporal_store((f32x4){bflo(w[r][j].x), bfhi(w[r][j].x), bflo(w[r][j].y), bfhi(w[r][j].y)} * rs * gv[j], xr + 64 * j); } }
    }
}

DI void sb_attn_item(bf16_t* p, const bf16_t* T, int item, int lane) {
    const int b = item >> 10, h = (item >> 7) & 7, qb = item & 127;
    const int hl = lane >> 5, li = lane & 31;
    const size_t rowbase = (size_t)b * SEQ;
    const int kperm = (li & 16) | ((li & 4) << 1) | ((li & 8) >> 1) | (li & 3);
    const bf16_t* qrow = p + (rowbase + qb * 32 + li) * PC + h * 64 + 8 * hl;
    bf16x8 qf[4];
#pragma unroll
    for (int kk = 0; kk < 4; ++kk) qf[kk] = *(const bf16x8*)(qrow + 16 * kk);
    bf16x8 U[2];
#pragma unroll
    for (int c = 0; c < 2; ++c)
#pragma unroll
        for (int e = 0; e < 8; ++e) U[c][e] = (16 * c + 8 * hl + e >= kperm) ? (short)0x3f80 : (short)0;
    f32x16 o0, o1;
#pragma unroll
    for (int r = 0; r < 16; ++r) { o0[r] = 0.f; o1[r] = 0.f; }
    float carry = 0.f;
    const bf16_t* vt0 = T + (size_t)(h * 64 + li) * M + rowbase + 8 * hl;
    for (int kb = qb; kb >= 0; --kb) {
        const int s0 = kb * 32;
        const bf16_t* krow = p + (rowbase + s0 + kperm) * PC + 512 + h * 64 + 8 * hl;
        bf16x8 kf[4], vf[4];
#pragma unroll
        for (int kk = 0; kk < 4; ++kk) kf[kk] = *(const bf16x8*)(krow + 16 * kk);
#pragma unroll
        for (int c = 0; c < 2; ++c) { vf[c] = *(const bf16x8*)(vt0 + s0 + 16 * c); vf[2 + c] = *(const bf16x8*)(vt0 + (size_t)32 * M + s0 + 16 * c); }
        f32x16 z;
#pragma unroll
        for (int r = 0; r < 16; ++r) z[r] = 0.f;
#pragma unroll
        for (int kk = 0; kk < 4; ++kk) z = MFMA32(kf[kk], qf[kk], z);
        const bool diag = (kb == qb);
        float Lv[16];
#pragma unroll
        for (int r = 0; r < 16; ++r) {
            const float zz = z[r];
            float L = fmaxf(zz, 0.f) + LN2 * __builtin_amdgcn_logf(1.0f + __builtin_amdgcn_exp2f(-fabsf(zz) * LOG2E));
            if (diag && !(16 * (r >> 3) + 8 * hl + (r & 7) < li)) L = 0.f;
            Lv[r] = L;
        }
        bf16x8 Lh[2], Ll[2];
#pragma unroll
        for (int c = 0; c < 2; ++c) { u32x4 wh, wl;
#pragma unroll
            for (int e = 0; e < 4; ++e) { const float a0 = Lv[8 * c + 2 * e], a1 = Lv[8 * c + 2 * e + 1]; const unsigned hp = pkbf(a0, a1); wh[e] = hp; wl[e] = pkbf(a0 - bflo(hp), a1 - bfhi(hp)); }
            Lh[c] = __builtin_bit_cast(bf16x8, wh); Ll[c] = __builtin_bit_cast(bf16x8, wl); }
        f32x16 C;
#pragma unroll
        for (int r = 0; r < 16; ++r) C[r] = carry;
        C = MFMA32(U[0], Lh[0], C); C = MFMA32(U[1], Lh[1], C); C = MFMA32(U[0], Ll[0], C); C = MFMA32(U[1], Ll[1], C);
        bf16x8 pf[2];
#pragma unroll
        for (int c = 0; c < 2; ++c) { u32x4 w;
#pragma unroll
            for (int e = 0; e < 4; ++e) { float a0, a1; { const int r = 8 * c + 2 * e; a0 = __builtin_amdgcn_exp2f((z[r] - C[r]) * LOG2E); a1 = __builtin_amdgcn_exp2f((z[r + 1] - C[r + 1]) * LOG2E);
                    if (diag) { if (!(16 * c + 8 * hl + 2 * e < li)) a0 = 0.f; if (!(16 * c + 8 * hl + 2 * e + 1 < li)) a1 = 0.f; } }
                w[e] = pkbf(a0, a1); }
            pf[c] = __builtin_bit_cast(bf16x8, w); }
        carry = __shfl(C[0], li);
        o0 = MFMA32(vf[0], pf[0], o0); o0 = MFMA32(vf[1], pf[1], o0);
        o1 = MFMA32(vf[2], pf[0], o1); o1 = MFMA32(vf[3], pf[1], o1);
        if (__all(carry > SB_EXIT)) break;
    }
    bf16_t* orow = p + (rowbase + qb * 32 + li) * PC + h * 64 + 4 * hl;
#pragma unroll
    for (int g = 0; g < 4; ++g) {
        u32x2 w0, w1; w0.x = pkbf(o0[4 * g], o0[4 * g + 1]); w0.y = pkbf(o0[4 * g + 2], o0[4 * g + 3]); w1.x = pkbf(o1[4 * g], o1[4 * g + 1]); w1.y = pkbf(o1[4 * g + 2], o1[4 * g + 3]);
        *(u32x2*)(orow + 8 * g) = w0; *(u32x2*)(orow + 32 + 8 * g) = w1; }
}

DI void sgu_item(int l, bf16_t* p, const bf16_t* T, int item, LAS unsigned char* lds, int tid, int wave, int lane) {
    const int g = item & 3, n = (item >> 2) & 31, b = item >> 7;
    const size_t tok0 = (size_t)b * SEQ + n * 128;
    const bf16_t* zv = T + (size_t)512 * M;
    LAS float* red = (LAS float*)lds;
    LAS float* mean = (LAS float*)(lds + 8192);
    LAS float* rstd = (LAS float*)(lds + 8192 + 512);
    {
        float s0 = 0.f, s1 = 0.f, q0 = 0.f, q1 = 0.f;
        const bf16_t* src = zv + (size_t)(wave * 64) * M + tok0 + 2 * lane;
#pragma unroll 1
        for (int jb = 0; jb < 64; jb += 16) {
            unsigned wv[16];
#pragma unroll
            for (int j = 0; j < 16; ++j) wv[j] = *(const unsigned*)(src + (size_t)(jb + j) * M);
            asm volatile("" ::: "memory");
#pragma unroll
            for (int j = 0; j < 16; ++j) { const float a0 = bflo(wv[j]), a1 = bfhi(wv[j]); s0 += a0; s1 += a1; q0 += a0 * a0; q1 += a1 * a1; }
        }
        *(LAS f32x4*)(red + (wave * 64 + lane) * 4) = (f32x4){s0, q0, s1, q1};
    }
    __syncthreads();
    if (tid < 128) { float s = 0.f, q = 0.f;
#pragma unroll
        for (int w = 0; w < 8; ++w) { const f32x2 v = *(LAS f32x2*)(red + (w * 64 + (tid >> 1)) * 4 + (tid & 1) * 2); s += v.x; q += v.y; }
        const float mu = s * (1.0f / 512.0f), var = fmaxf(q * (1.0f / 512.0f) - mu * mu, 0.f);
        mean[tid] = mu; rstd[tid] = 1.0f / sqrtf(var + LN_EPS); }
    __syncthreads();
    const int cblk = wave & 3, th = wave >> 2, hl = lane >> 5, li = lane & 31;
    const int cch = g * 128 + cblk * 32 + li;
    const float lg = INP(4)[l * 512 + cch], lb = INP(5)[l * 512 + cch];
    const bf16_t* arow = zv + (size_t)cch * M + tok0 + 8 * hl;
    const float* wsp = INP(6) + ((size_t)(l * 4 + g) * 128) * 128;
    f32x16 acc0, acc1;
#pragma unroll
    for (int r = 0; r < 16; ++r) { acc0[r] = 0.f; acc1[r] = 0.f; }
#pragma unroll
    for (int hf = 0; hf < 2; ++hf) if (hf == 0 || th) {
        u32x4 raw[4]; f32x4 wv[4][2][2];
#pragma unroll
        for (int k4 = 0; k4 < 4; ++k4) { const int kk = 4 * hf + k4, sb = 16 * kk + 8 * hl;
            raw[k4] = *(const u32x4*)(arow + 16 * kk);
#pragma unroll
            for (int tb = 0; tb < 2; ++tb) { const int t = th * 64 + tb * 32 + li; wv[k4][tb][0] = *(const f32x4*)(wsp + (size_t)t * 128 + sb); wv[k4][tb][1] = *(const f32x4*)(wsp + (size_t)t * 128 + sb + 4); } }
        asm volatile("" ::: "memory");
#pragma unroll
        for (int k4 = 0; k4 < 4; ++k4) { const int kk = 4 * hf + k4, sb = 16 * kk + 8 * hl;
            const f32x4 m0 = *(LAS f32x4*)(mean + sb), m1 = *(LAS f32x4*)(mean + sb + 4), r0 = *(LAS f32x4*)(rstd + sb), r1 = *(LAS f32x4*)(rstd + sb + 4);
            const u32x4 rw = raw[k4]; u32x4 aw;
            aw.x = pkbf((bflo(rw.x) - m0[0]) * r0[0] * lg + lb, (bfhi(rw.x) - m0[1]) * r0[1] * lg + lb);
            aw.y = pkbf((bflo(rw.y) - m0[2]) * r0[2] * lg + lb, (bfhi(rw.y) - m0[3]) * r0[3] * lg + lb);
            aw.z = pkbf((bflo(rw.z) - m1[0]) * r1[0] * lg + lb, (bfhi(rw.z) - m1[1]) * r1[1] * lg + lb);
            aw.w = pkbf((bflo(rw.w) - m1[2]) * r1[2] * lg + lb, (bfhi(rw.w) - m1[3]) * r1[3] * lg + lb);
            const bf16x8 af = __builtin_bit_cast(bf16x8, aw);
#pragma unroll
            for (int tb = 0; tb < 2; ++tb) { const f32x4 w0 = wv[k4][tb][0], w1 = wv[k4][tb][1];
                u32x4 bw; bw.x = pkbf(w0[0], w0[1]); bw.y = pkbf(w0[2], w0[3]); bw.z = pkbf(w1[0], w1[1]); bw.w = pkbf(w1[2], w1[3]);
                const bf16x8 bfr = __builtin_bit_cast(bf16x8, bw);
                if (tb == 0) acc0 = MFMA32(af, bfr, acc0); else acc1 = MFMA32(af, bfr, acc1); } }
    }
#pragma unroll
    for (int tb = 0; tb < 2; ++tb) {
        const int t = th * 64 + tb * 32 + li; const float bs = INP(7)[(l * 4 + g) * 128 + t];
        bf16_t* urow = p + (tok0 + t) * PC + 1024 + g * 128 + cblk * 32 + 4 * hl;
        u32x2 uws[4];
#pragma unroll
        for (int q = 0; q < 4; ++q) uws[q] = *(const u32x2*)(urow + 8 * q);
#pragma unroll
        for (int q = 0; q < 4; ++q) { const u32x2 uw = uws[q];
            float v0, v1, v2, v3;
            if (tb == 0) { v0 = acc0[4 * q]; v1 = acc0[4 * q + 1]; v2 = acc0[4 * q + 2]; v3 = acc0[4 * q + 3]; } else { v0 = acc1[4 * q]; v1 = acc1[4 * q + 1]; v2 = acc1[4 * q + 2]; v3 = acc1[4 * q + 3]; }
            u32x2 ow; ow.x = pkbf(bflo(uw.x) * (v0 + bs), bfhi(uw.x) * (v1 + bs)); ow.y = pkbf(bflo(uw.y) * (v2 + bs), bfhi(uw.y) * (v3 + bs));
            *(u32x2*)(urow + 8 * q) = ow; }
    }
    __syncthreads();
}

DI void conv_phase(int l, bf16_t* p, LAS unsigned char* lds, int gtid, int NGT) {
    const float* cw = INP(8) + (size_t)l * 3 * 512;
    for (int it = gtid; it < M * 64; it += NGT) {
        const int row = it >> 6, c8 = (it & 63) * 8, t = row & (SEQ - 1);
        bf16_t* pr = p + (size_t)row * PC;
        float accv[8];
#pragma unroll
        for (int e = 0; e < 8; ++e) accv[e] = 0.f;
        u32x4 ccv[3], cxv[3];
#pragma unroll
        for (int j = 0; j < 3; ++j) { const int dt = (t - (2 - j) >= 0) ? 2 - j : 0;
            ccv[j] = *(const u32x4*)(pr - (size_t)dt * PC + 2048 + c8); cxv[j] = *(const u32x4*)(pr - (size_t)dt * PC + 2560 + c8); }
        const u32x4 cb = *(const u32x4*)(pr + 1536 + c8);
        asm volatile("" ::: "memory");
#pragma unroll
        for (int j = 0; j < 3; ++j) { const int dt = 2 - j;
            if (t - dt >= 0) {
                const u32x4 cc = ccv[j], cx = cxv[j];
                const f32x4 w0 = *(const f32x4*)(cw + j * 512 + c8), w1 = *(const f32x4*)(cw + j * 512 + c8 + 4);
                accv[0] += w0[0] * bflo(cc.x) * bflo(cx.x); accv[1] += w0[1] * bfhi(cc.x) * bfhi(cx.x); accv[2] += w0[2] * bflo(cc.y) * bflo(cx.y); accv[3] += w0[3] * bfhi(cc.y) * bfhi(cx.y);
                accv[4] += w1[0] * bflo(cc.z) * bflo(cx.z); accv[5] += w1[1] * bfhi(cc.z) * bfhi(cx.z); accv[6] += w1[2] * bflo(cc.w) * bflo(cx.w); accv[7] += w1[3] * bfhi(cc.w) * bfhi(cx.w); } }
        u32x4 o; o.x = pkbf(bflo(cb.x) * accv[0], bfhi(cb.x) * accv[1]); o.y = pkbf(bflo(cb.y) * accv[2], bfhi(cb.y) * accv[3]); o.z = pkbf(bflo(cb.z) * accv[4], bfhi(cb.z) * accv[5]); o.w = pkbf(bflo(cb.w) * accv[6], bfhi(cb.w) * accv[7]);
        *(u32x4*)(pr + 1536 + c8) = o;
    }
}

DI void xattn_wg(const bf16_t* qx, const bf16_t* memK, const bf16_t* memVT, bf16_t* ox, int item, int tid, int wave, int lane, LAS unsigned char* lds) {
    const int b = item >> 6, h = (item >> 4) & 3, qb = (item & 15) * 8 + wave;
    const int hl = lane >> 5, li = lane & 31;
    const size_t qrow = (size_t)b * SEQ + qb * 32 + li;
    bf16x8 qf[16];
#pragma unroll
    for (int kk = 0; kk < 16; ++kk) qf[kk] = *(const bf16x8*)(qx + qrow * D + h * 256 + 16 * kk + 8 * hl);
    const int sr = tid >> 4, sp0 = (tid & 15) * 2;
    const int kperm_sr = (sr & 16) | ((sr & 4) << 1) | ((sr & 8) >> 1) | (sr & 3);
    const bf16_t* kbase = memK + (size_t)(b * 256) * D + h * 256;
    const bf16_t* vbase = memVT + (size_t)(h * 256) * D + b * 256;
    u32x4 st[2], sn[2];
#define XA_LOAD(R, c) do { if ((c) < 8) { _Pragma("unroll") for (int e = 0; e < 2; ++e) R[e] = *(const u32x4*)(kbase + (size_t)((c) * 32 + sr) * D + (sp0 + e) * 8); } \
                           else { _Pragma("unroll") for (int e = 0; e < 2; ++e) R[e] = *(const u32x4*)(vbase + (size_t)(((c) - 8) * 32 + sr) * D + (sp0 + e) * 8); } } while (0)
#define XA_STORE(R, c) do { const int rl = (c) < 8 ? kperm_sr : sr; _Pragma("unroll") for (int e = 0; e < 2; ++e) { const int p = sp0 + e; \
                           *(LAS u32x4*)(lds + ((c) & 1) * 16384 + (((p >> 1) * 64) + (p & 1) * 32 + rl) * 16) = R[e]; } } while (0)
    XA_LOAD(st, 0); XA_STORE(st, 0); XA_LOAD(st, 1);
    __syncthreads();
    f32x16 S[8];
#pragma unroll
    for (int c = 0; c < 8; ++c) {
        XA_LOAD(sn, c + 2);
        f32x16 z;
#pragma unroll
        for (int r = 0; r < 16; ++r) z[r] = 0.f;
        const LAS unsigned char* buf = lds + (c & 1) * 16384 + lane * 16;
#pragma unroll
        for (int kk = 0; kk < 16; ++kk) { const bf16x8 kf = *(const LAS bf16x8*)(buf + kk * 1024); z = MFMA32(kf, qf[kk], z); }
        S[c] = z;
        XA_STORE(st, c + 1);
        __syncthreads();
        st[0] = sn[0]; st[1] = sn[1];
    }
    float mx = -3.0e38f;
#pragma unroll
    for (int kb = 0; kb < 8; ++kb)
#pragma unroll
        for (int r = 0; r < 16; ++r) mx = fmaxf(mx, S[kb][r]);
    mx = fmaxf(mx, __shfl_xor(mx, 32));
    float sum = 0.f;
    bf16x8 pf[16];
#pragma unroll
    for (int kb = 0; kb < 8; ++kb)
#pragma unroll
        for (int c = 0; c < 2; ++c) { u32x4 w;
#pragma unroll
            for (int e = 0; e < 4; ++e) { const float a0 = __builtin_amdgcn_exp2f((S[kb][8 * c + 2 * e] - mx) * LOG2E), a1 = __builtin_amdgcn_exp2f((S[kb][8 * c + 2 * e + 1] - mx) * LOG2E); sum += a0 + a1; w[e] = pkbf(a0, a1); }
            pf[2 * kb + c] = __builtin_bit_cast(bf16x8, w); }
    sum += __shfl_xor(sum, 32);
    const float inv = 1.0f / sum;
    bf16_t* orow = ox + qrow * D + h * 256 + 4 * hl;
#pragma unroll 1
    for (int c = 8; c < 16; ++c) {
        if (c + 2 < 16) XA_LOAD(sn, c + 2);
        f32x16 o;
#pragma unroll
        for (int r = 0; r < 16; ++r) o[r] = 0.f;
        const LAS unsigned char* buf = lds + (c & 1) * 16384 + lane * 16;
#pragma unroll
        for (int s = 0; s < 16; ++s) { const bf16x8 vf = *(const LAS bf16x8*)(buf + s * 1024); o = MFMA32(vf, pf[s], o); }
        const int db = c - 8;
#pragma unroll
        for (int g = 0; g < 4; ++g) { u32x2 w; w.x = pkbf(o[4 * g] * inv, o[4 * g + 1] * inv); w.y = pkbf(o[4 * g + 2] * inv, o[4 * g + 3] * inv); *(u32x2*)(orow + db * 32 + 8 * g) = w; }
        if (c + 1 < 16) XA_STORE(st, c + 1);
        __syncthreads();
        st[0] = sn[0]; st[1] = sn[1];
    }
#undef XA_LOAD
#undef XA_STORE
}

constexpr int RSD_OFF = 131072 + 768, RS_OFF = 131072 + 1024, RS_MAXU = 15;
template <class Prog>
DI void fill_rs(LAS unsigned char* lds, Prog P2, const float* ssp, int tid) {
    LAS int* desc = (LAS int*)(lds + RSD_OFF);
    if (tid == 0) { pg8::UnitX x; int n = 0; while (n < RS_MAXU && P2.next(x)) { desc[n] = P2.rs_base(x); ++n; } desc[RS_MAXU] = n; }
    __syncthreads();
    const int n = desc[RS_MAXU];
    for (int kb = 0; kb < n; kb += 8) {
        f32x4 sv[4][4]; int ok[4];
#pragma unroll
        for (int j = 0; j < 4; ++j) { const int k = kb + 2 * j + (tid >> 8); const int base = k < n ? desc[k] : -1; ok[j] = base >= 0;
            const f32x4* sp = (const f32x4*)(ssp + (size_t)((ok[j] ? base : 0) + (tid & 255)) * 16);
#pragma unroll
            for (int q = 0; q < 4; ++q) sv[j][q] = ok[j] ? sp[q] : (f32x4){0.f, 0.f, 0.f, 0.f}; }
        asm volatile("" ::: "memory");
#pragma unroll
        for (int j = 0; j < 4; ++j) if (ok[j]) { const int k = kb + 2 * j + (tid >> 8); float s = 0.f;
#pragma unroll
            for (int q = 0; q < 4; ++q) s += (sv[j][q][0] + sv[j][q][1]) + (sv[j][q][2] + sv[j][q][3]);
            ((LAS float*)(lds + RS_OFF))[k * 256 + (tid & 255)] = 1.0f / sqrtf(s * (1.0f / D) + RMS_EPS); }
    }
    __syncthreads();
}
DI int wrapg(int v, int G) { while (v >= G) v -= G; return v; }
struct ProgC {
    unsigned char* ws; LAS unsigned char* lds; int G, c; int j, i, kk; pg8::Unit u; bool have;
    DI int rs_base(const pg8::UnitX& x) const { return (x.job & 1) ? -1 : x.pm * 256; }
    DI void init(unsigned char* ws_, int G_, int c_, LAS unsigned char* lds_) { lds = lds_; kk = 0; ws = ws_; G = G_; c = c_; j = 0; i = 0; pg8::StaticOrder S; S.init(M, D, G, c); have = S.next(0, u); }
    DI bool next(pg8::UnitX& x) {
        if (have && j >= 6) { pg8::StaticOrder S; S.init(M, D, G, c); ++i; j = 0; have = S.next(i, u); }
        if (!have) return false;
        x.pm = u.pm; x.pn = u.pn; x.job = j; x.k = kk; ++kk; ++j; return true; }
    DI pg8::JobP job(int jj) const { const int n = jj >> 1; pg8::JobP p;
        if ((jj & 1) == 0) { p.A = (const bf16_t*)(ws + WS_XB); p.Bt = (const bf16_t*)(ws + WS_WIN) + (size_t)(4096 + n * 1024) * D; p.lda = D; p.ldb = D; p.nt = D / 64; }
        else { const int acol = n == 0 ? 0 : (n == 1 ? 1024 : 1536); p.A = (const bf16_t*)(ws + WS_P) + acol; p.Bt = (const bf16_t*)(ws + WS_WB) + (size_t)n * D * 512; p.lda = PC; p.ldb = 512; p.nt = 512 / 64; }
        return p; }
    DI void epilogue(const f32x4 (&acc)[2][2][4][2], const pg8::UnitX& x, int wr, int wc, int fr, int fq) const {
        pg8::EpiArgs ea{}; const pg8::Unit uu{x.pm, x.pn};
        if ((x.job & 1) == 0) { ea.O = (bf16_t*)(ws + WS_T); ea.ldc = D; ea.ssp = (const float*)(ws + WS_SSP); ea.rstab = x.k < RS_MAXU ? (const LAS float*)(lds + RS_OFF) + x.k * 256 : nullptr; ea.cscale = 1.f; pg8::Epi<pg8::E_GATE> E{ea}; E(acc, uu, wr, wc, fr, fq); }
        else { ea.O = (bf16_t*)(ws + WS_X2); ea.ldc = D; ea.G = (const bf16_t*)(ws + WS_T);
            if (x.job == 1) { pg8::Epi<pg8::E_BR0> E{ea}; E(acc, uu, wr, wc, fr, fq); } else { pg8::Epi<pg8::E_BRN> E{ea}; E(acc, uu, wr, wc, fr, fq); } }
    }
};
struct ProgA {
    unsigned char* ws; LAS unsigned char* lds; int G, c; int jb, i, njobs, kk;
    DI int rs_base(const pg8::UnitX& x) const { return x.job == 0 ? x.pm * 256 : (x.job == 1 ? x.pn * 256 : -1); }
    DI void init(unsigned char* ws_, int G_, int c_, int l, LAS unsigned char* lds_) { lds = lds_; kk = 0; ws = ws_; G = G_; c = c_; jb = 0; i = 0; njobs = l == 0 ? 4 : 2; }
    DI bool next(pg8::UnitX& x) {
        for (; jb < njobs; ++jb, i = 0) {
            pg8::StaticOrder S; pg8::Unit u;
            if (jb == 0) S.init(M, 3072, G, c); else if (jb == 1) S.init(1024, M, G, c); else if (jb == 2) S.init(1024, D, G, wrapg(c + 64, G)); else S.init(D, 1024, G, wrapg(c + 192, G));
            if (S.next(i, u)) { x.pm = u.pm; x.pn = u.pn; x.job = jb; x.k = kk; ++kk; ++i; return true; }
        }
        return false;
    }
    DI pg8::JobP job(int jj) const { pg8::JobP p; p.lda = D; p.ldb = D; p.nt = D / 64;
        if (jj == 0) { p.A = (const bf16_t*)(ws + WS_XB); p.Bt = (const bf16_t*)(ws + WS_WIN); }
        else if (jj == 1) { p.A = (const bf16_t*)(ws + WS_WIN) + (size_t)3072 * D; p.Bt = (const bf16_t*)(ws + WS_XB); }
        else if (jj == 2) { p.A = (const bf16_t*)(ws + WS_MB); p.Bt = (const bf16_t*)(ws + WS_WK); }
        else { p.A = (const bf16_t*)(ws + WS_WV); p.Bt = (const bf16_t*)(ws + WS_MB); }
        return p; }
    DI void epilogue(const f32x4 (&acc)[2][2][4][2], const pg8::UnitX& x, int wr, int wc, int fr, int fq) const {
        pg8::EpiArgs ea{}; const pg8::Unit uu{x.pm, x.pn};
        const LAS float* rst = x.k < RS_MAXU ? (const LAS float*)(lds + RS_OFF) + x.k * 256 : nullptr;
        if (x.job == 0) { ea.O = (bf16_t*)(ws + WS_P); ea.ldc = PC; ea.ssp = (const float*)(ws + WS_SSP); ea.rstab = rst; ea.cscale = 1.f; pg8::Epi<pg8::E_INPROJ> E{ea}; E(acc, uu, wr, wc, fr, fq); }
        else if (x.job == 2) { ea.O = (bf16_t*)(ws + WS_MEMK); ea.ldc = D; ea.ssp = nullptr; ea.cscale = 1.f; pg8::Epi<pg8::E_ROWSCALE> E{ea}; E(acc, uu, wr, wc, fr, fq); }
        else { if (x.job == 1) { ea.O = (bf16_t*)(ws + WS_T); ea.ldc = M; ea.ssp = (const float*)(ws + WS_SSP); ea.rstab = rst; } else { ea.O = (bf16_t*)(ws + WS_MEMVT); ea.ldc = 1024; ea.ssp = nullptr; }
            pg8::Epi<pg8::E_TRANS> E{ea}; E(acc, uu, wr, wc, fr, fq); }
    }
};
struct ProgJ {
    unsigned char* ws; LAS unsigned char* lds; int G, c; int jb, i, njobs, kk;
    DI int rs_base(const pg8::UnitX& x) const { return x.job == 0 ? x.pm * 256 : -1; }
    DI void init(unsigned char* ws_, int G_, int c_, int l, LAS unsigned char* lds_) { lds = lds_; kk = 0; ws = ws_; G = G_; c = c_; jb = 0; i = 0; njobs = l == 0 ? 3 : 1; }
    DI bool next(pg8::UnitX& x) {
        for (; jb < njobs; ++jb, i = 0) {
            pg8::StaticOrder S; pg8::Unit u;
            if (jb == 0) S.init(M, 2 * FF, G, c); else if (jb == 1) S.init(1024, D, G, wrapg(c + 128, G)); else S.init(D, 1024, G, wrapg(c + 96, G));
            if (S.next(i, u)) { x.pm = u.pm; x.pn = u.pn; x.job = jb; x.k = kk; ++kk; ++i; return true; }
        }
        return false;
    }
    DI pg8::JobP job(int jj) const { pg8::JobP p; p.lda = D; p.ldb = D; p.nt = D / 64;
        if (jj == 0) { p.A = (const bf16_t*)(ws + WS_XB); p.Bt = (const bf16_t*)(ws + WS_WGU); }
        else if (jj == 1) { p.A = (const bf16_t*)(ws + WS_MB1); p.Bt = (const bf16_t*)(ws + WS_WK1); }
        else { p.A = (const bf16_t*)(ws + WS_WV1); p.Bt = (const bf16_t*)(ws + WS_MB1); }
        return p; }
    DI void epilogue(const f32x4 (&acc)[2][2][4][2], const pg8::UnitX& x, int wr, int wc, int fr, int fq) const {
        pg8::EpiArgs ea{}; const pg8::Unit uu{x.pm, x.pn};
        if (x.job == 0) { ea.O = (bf16_t*)(ws + WS_P); ea.ldc = FF; ea.ssp = (const float*)(ws + WS_SSP) + (size_t)2 * M * 16; ea.rstab = x.k < RS_MAXU ? (const LAS float*)(lds + RS_OFF) + x.k * 256 : nullptr; pg8::Epi<pg8::E_SWIGLU> E{ea}; E(acc, uu, wr, wc, fr, fq); }
        else if (x.job == 1) { ea.O = (bf16_t*)(ws + WS_MEMK1); ea.ldc = D; ea.ssp = nullptr; ea.cscale = 1.f; pg8::Epi<pg8::E_ROWSCALE> E{ea}; E(acc, uu, wr, wc, fr, fq); }
        else { ea.O = (bf16_t*)(ws + WS_MEMVT1); ea.ldc = 1024; ea.ssp = nullptr; pg8::Epi<pg8::E_TRANS> E{ea}; E(acc, uu, wr, wc, fr, fq); }
    }
};
#define XB_TMO      128
#define XB_XCNT(j)  (256  + 64 * (j))
#define XB_XSUB(j)  (1280 + 64 * (j))
#define XB_XGEN(j)  (2304 + 64 * (j))
#define XB_TOP      3328
#define XB_TOPGEN   3392
#define XCD_BAR_WORDS 3456
#define XB_SPIN_CAP (1u << 18)

__device__ __forceinline__ unsigned xb_ld(unsigned* p)              { return __hip_atomic_load(p, __ATOMIC_RELAXED, __HIP_MEMORY_SCOPE_AGENT); }
__device__ __forceinline__ unsigned xb_add(unsigned* p, unsigned v) { return __hip_atomic_fetch_add(p, v, __ATOMIC_RELAXED, __HIP_MEMORY_SCOPE_AGENT); }
__device__ __forceinline__ unsigned xb_xcc_id() { return (unsigned)__builtin_amdgcn_s_getreg((3 << 11) | 20) & 0xFu; }
#define XB_SPIN(cond, bar) do { unsigned _sp = 0; while (cond) { __builtin_amdgcn_s_sleep(1); \
    if ((++_sp & 255u) == 0u) { if (xb_ld(&(bar)[XB_TMO])) break; if (_sp > XB_SPIN_CAP) { atomicAdd(&(bar)[XB_TMO], 1u); break; } } } } while (0)

struct XcdBarrier {
    unsigned* bar; unsigned x;
    volatile LAS unsigned* st;
};

__device__ __forceinline__ XcdBarrier xcd_barrier_post(unsigned* bar, volatile LAS unsigned* st) {
    XcdBarrier b; b.bar = bar; b.x = xb_xcc_id(); b.st = st;
    if (threadIdx.x == 0) (void)xb_add(&bar[XB_XCNT(b.x)], 1u);
    return b;
}
__device__ __forceinline__ void xcd_barrier_complete(unsigned* bar, unsigned x, unsigned& nloc, unsigned& nx) {
    const unsigned G = gridDim.x * gridDim.y * gridDim.z;
    unsigned sum, cnt, mine, sp = 0u;
    for (;;) {
        sum = 0u; cnt = 0u; mine = 0u;
#pragma unroll
        for (unsigned j = 0; j < 16; ++j) { const unsigned c = xb_ld(&bar[XB_XCNT(j)]); sum += c; cnt += (c > 0u) ? 1u : 0u; mine = (j == x) ? c : mine; }
        if (sum == G) break;
        __builtin_amdgcn_s_sleep(1);
        if ((++sp & 255u) == 0u) { if (xb_ld(&bar[XB_TMO])) break; if (sp > XB_SPIN_CAP) { atomicAdd(&bar[XB_TMO], 1u); break; } }
    }
    nloc = mine > 0u ? mine : 1u; nx = cnt > 0u ? cnt : 1u;
}

__device__ __forceinline__ void xcd_barrier(const XcdBarrier& b) {
    asm volatile("s_waitcnt vmcnt(0)" ::: "memory");
    __syncthreads();
    if (threadIdx.x == 0) {
        unsigned* bar = b.bar;
        __builtin_amdgcn_s_waitcnt(0);
        unsigned nloc = b.st[0], nx = b.st[1];
        if (nloc == 0u) { xcd_barrier_complete(bar, b.x, nloc, nx); b.st[0] = nloc; b.st[1] = nx; }
        const unsigned old = xb_add(&bar[XB_XSUB(b.x)], 1u);
        const unsigned gen = old / nloc;
        if (old + 1u == (gen + 1u) * nloc) {
            __builtin_amdgcn_fence(__ATOMIC_RELEASE, "agent");
            asm volatile("s_waitcnt vmcnt(0)" ::: "memory");
            const unsigned og = xb_add(&bar[XB_TOP], 1u);
            const unsigned tg = og / nx;
            if (og + 1u == (tg + 1u) * nx) xb_add(&bar[XB_TOPGEN], 1u);
            else XB_SPIN(xb_ld(&bar[XB_TOPGEN]) == tg, bar);
            __builtin_amdgcn_fence(__ATOMIC_ACQUIRE, "agent");
            xb_add(&bar[XB_XGEN(b.x)], 1u);
            asm volatile("s_waitcnt vmcnt(0)" ::: "memory");
        } else {
            XB_SPIN(xb_ld(&bar[XB_XGEN(b.x)]) == gen, bar);
            __builtin_amdgcn_fence(__ATOMIC_ACQUIRE, "agent");
            asm volatile("s_waitcnt vmcnt(0)" ::: "memory");
        }
    }
    __syncthreads();
}

#define WSB(off) ((bf16_t*)(WSP + (off)))
#define WSF(off) ((float*)(WSP + (off)))
__global__ void __launch_bounds__(NTHREADS, 2) fwd_megakernel(Args A_unused) {
    extern __shared__ __attribute__((aligned(16))) unsigned char lds_raw[];
    LAS unsigned char* lds = (LAS unsigned char*)lds_raw;
    cg::grid_group grid = cg::this_grid();
    { const int tid = threadIdx.x;
    if (tid < 24) { const unsigned long long* ka = (const unsigned long long*)__builtin_amdgcn_kernarg_segment_ptr(); *(LAS unsigned long long*)(lds + PTR_OFF + 8 * tid) = ka[tid]; } }
    if (threadIdx.x < 8) ((LAS unsigned*)(lds + PTR_OFF + 256))[threadIdx.x] = 0u;
    __syncthreads();
    if (blockIdx.x == 0) { unsigned* bw = (unsigned*)ldq(lds, 23); for (int w = threadIdx.x; w < XCD_BAR_WORDS; w += NTHREADS) __hip_atomic_store(bw + w, 0u, __ATOMIC_RELAXED, __HIP_MEMORY_SCOPE_AGENT); }
    asm volatile("s_waitcnt vmcnt(0)" ::: "memory");
    __syncthreads();
    grid.sync();
    const XcdBarrier bar = xcd_barrier_post((unsigned*)ldq(lds, 23), (volatile LAS unsigned*)(lds + PTR_OFF + 256));
#define XBAR() do { XcdBarrier b2_ = bar; asm volatile("" : "+s"(b2_.x)); xcd_barrier(b2_); } while (0)
#define FRESH_IDS const int tid = fresh_tid(), lane = tid & 63, wave = __builtin_amdgcn_readfirstlane(tid >> 6); (void)lane; (void)wave
#define GRID_ ((int)gridDim.x)
#define BID_ ((int)blockIdx.x)
#define GW_ (BID_ * NWAVES + wave)
#define NGW_ (GRID_ * NWAVES)
    constexpr size_t SSPB = (size_t)M * 16 * 4;
    using namespace pg8;

    { FRESH_IDS; prep_x(lds, GW_, NGW_, lane); }
    { FRESH_IDS; prep_weights(0, lds, GW_, NGW_, wave, lane, GRID_ == 256 ? 5 : 0); }
    XBAR();
    for (int l = 0; l < DEPTH; ++l) {
        { ProgA PA; PA.init(WSP, GRID_, BID_, l, lds); { FRESH_IDS; fill_rs(lds, PA, WSF(WS_SSP), tid); } gemm_stream(lds, PA); }
        if (l == 0 && GRID_ == 256) { const int c_ = __builtin_amdgcn_readfirstlane(BID_); const bool busy_ = (c_ >= 64 && c_ < 80) || (c_ >= 192 && c_ < 208);
            if (!busy_) { FRESH_IDS; const int idx_ = c_ < 64 ? c_ : (c_ < 192 ? c_ - 16 : c_ - 32); prep_weights(0, lds, idx_ * NWAVES + wave, 224 * NWAVES, wave, lane, 6); } }
        XBAR();
        if (l > 0) { FRESH_IDS; prep_weights(l, lds, GW_, NGW_, wave, lane, 2); __syncthreads(); }
        { FRESH_IDS;
          for (int it0 = BID_; it0 < NBATCH * 32 * 4; it0 += GRID_) { int it = it0;
              if (GRID_ == 256) { const int r = it0 >> 8, bx = it0 & 255, xcd = bx & 7, slot = bx >> 3; it = (r * 64 + xcd * 8 + (slot >> 2)) * 4 + (slot & 3); }
              sgu_item(l, WSB(WS_P), WSB(WS_T), it, lds, tid, wave, lane); } }
        { FRESH_IDS; for (int it = GW_; it < NBATCH * 8 * 128; it += NGW_) sb_attn_item(WSB(WS_P), WSB(WS_T), it, lane); }
        { FRESH_IDS; conv_phase(l, WSB(WS_P), lds, BID_ * NTHREADS + tid, GRID_ * NTHREADS); }
        XBAR();
        { ProgC PCg; PCg.init(WSP, GRID_, BID_, lds); { FRESH_IDS; fill_rs(lds, PCg, WSF(WS_SSP), tid); } gemm_stream(lds, PCg); }
        XBAR();
        {
            StaticOrder S; S.init(M, D, GRID_, BID_);
            EpiArgs ea{}; Gemm g{WSB(WS_X2), WSB(WS_WOUT), M, D, D, D, D}; ea.xb = WSB(WS_XB); ea.sspo = WSF(WS_SSP + SSPB); Epi<E_RESID> E{ea}; gemm_phase(lds, g, S, E);
        }
        XBAR();
        {
            StaticOrder S; S.init(M, D, GRID_, BID_);
            EpiArgs ea{}; Gemm g{WSB(WS_XB), WSB(WS_WQ), M, D, D, D, D}; ea.O = WSB(WS_T); ea.ldc = D; ea.ssp = WSF(WS_SSP + SSPB); ea.cscale = 0.0625f; Epi<E_ROWSCALE> E{ea}; gemm_phase(lds, g, S, E);
            Unit u;
            for (int i = 0; S.next(i, u); ++i) { FRESH_IDS; xattn_wg(WSB(WS_T), WSB(l ? WS_MEMK1 : WS_MEMK), WSB(l ? WS_MEMVT1 : WS_MEMVT), WSB(WS_X2), (u.pm >> 4) * 64 + u.pn * 16 + (u.pm & 15), tid, wave, lane, lds); }
        }
        XBAR();
        {
            StaticOrder S; S.init(M, D, GRID_, BID_);
            EpiArgs ea{}; Gemm g{WSB(WS_X2), WSB(WS_WOX), M, D, D, D, D}; ea.xb = WSB(WS_XB); ea.sspo = WSF(WS_SSP + 2 * SSPB); Epi<E_RESID> E{ea}; gemm_phase(lds, g, S, E);
        }
        XBAR();
        { ProgJ PJ; PJ.init(WSP, GRID_, BID_, l, lds); { FRESH_IDS; fill_rs(lds, PJ, WSF(WS_SSP + 2 * SSPB), tid); } gemm_stream(lds, PJ); }
        if (l + 1 < DEPTH && GRID_ == 256) { const int c_ = __builtin_amdgcn_readfirstlane(BID_); const bool idle_ = (c_ >= 144 && c_ < 160) || c_ >= 176;
            if (idle_) { FRESH_IDS; const int idx_ = c_ < 160 ? c_ - 144 : 16 + (c_ - 176); prep_weights(l + 1, lds, idx_ * NWAVES + wave, 96 * NWAVES, wave, lane, 3); } }
        XBAR();
        {
            StaticOrder S; S.init(M, D, GRID_, BID_);
            EpiArgs ea{}; Gemm g{WSB(WS_P), WSB(WS_WD), M, D, FF, FF, FF}; ea.xb = WSB(WS_XB); ea.sspo = WSF(WS_SSP); Epi<E_RESID> E{ea}; gemm_phase(lds, g, S, E);
        }
        if (l + 1 < DEPTH) { FRESH_IDS; prep_weights(l + 1, lds, GW_, NGW_, wave, lane, GRID_ == 256 ? 4 : 1); }
        XBAR();
    }
    { FRESH_IDS; final_norm(lds, GW_, NGW_, lane); }
}

extern "C" void kernel_launch(void* const* d_in, const int* in_sizes, int n_in, void* d_out, int out_size, void* d_ws, size_t ws_size, hipStream_t stream) {
    static int grid = 0;
    if (grid == 0) {
        if (n_in != 22 || in_sizes[0] != M * D || out_size != M * D || ws_size < WS_END) { fprintf(stderr, "kernel_launch: unexpected shapes (n_in %d, in0 %d, out %d, ws %zu)\n", n_in, n_in > 0 ? in_sizes[0] : -1, out_size, ws_size); grid = -1; return; }
        int dev = 0, cus = 0, per_cu = 0;
        hipGetDevice(&dev); hipDeviceGetAttribute(&cus, hipDeviceAttributeMultiprocessorCount, dev);
        hipFuncSetAttribute((const void*)fwd_megakernel, hipFuncAttributeMaxDynamicSharedMemorySize, LDS_BYTES);
        hipOccupancyMaxActiveBlocksPerMultiprocessor(&per_cu, (const void*)fwd_megakernel, NTHREADS, LDS_BYTES);
        if (per_cu < 1) { fprintf(stderr, "kernel_launch: occupancy query says %d blocks per CU\n", per_cu); per_cu = 1; }
        (void)hipGetLastError();
        grid = cus;
    }
    if (grid < 0) return;
    Args a{};
    for (int i = 0; i < 22; ++i) a.in[i] = (const float*)d_in[i];
    a.out = (float*)d_out; a.ws = (unsigned char*)d_ws;
    void* args[] = {&a};
    hipError_t e = hipLaunchCooperativeKernel((const void*)fwd_megakernel, dim3(grid), dim3(NTHREADS), args, LDS_BYTES, stream);
    if (e != hipSuccess) fprintf(stderr, "cooperative launch failed: %s (grid %d)\n", hipGetErrorString(e), grid);
}
```
